# Optimizing an MI355X kernel written in HIP

```python
import jax, jax.numpy as jnp
from jax import lax
import numpy as np

D_MODEL = 1024
BATCH = 8
SEQ = 4096
DEPTH = 4

CTX_LEN = 256
GRID_W = 64
HEAD_DIM = 64
RET_W = D_MODEL // 4
RET_HEADS = RET_W // HEAD_DIM
RET_CHUNK = 128
ATT_W = D_MODEL // 2
ATT_Q_HEADS = ATT_W // HEAD_DIM
ATT_KV_HEADS = ATT_Q_HEADS // 4
ATT_KV_W = ATT_KV_HEADS * HEAD_DIM
Q_BLOCK = 128
ROPE_THETA = 10000.0
LRU_W = D_MODEL // 4
LRU_BLOCKS = 4
LRU_BLOCK_W = LRU_W // LRU_BLOCKS
CONV_W = 4
LRU_C = 8.0
D_MIX = RET_W + ATT_W + LRU_W
IN_SIZES = (RET_W, RET_W, RET_W, RET_W, ATT_W, ATT_KV_W, ATT_KV_W, LRU_W, LRU_W)
D_IN = sum(IN_SIZES)
D_FF = 4 * D_MODEL
ALPHA = (2.0 * DEPTH) ** 0.25
BETA = (8.0 * DEPTH) ** -0.25
EPS = 1e-6

kernel_name = 'hybrid_retention_gqa_rglru_dit_trunk'


def layer_norm(x, g, b):
    xf = x.astype(jnp.float32)
    mu = xf.mean(-1, keepdims=True)
    var = jnp.square(xf - mu).mean(-1, keepdims=True)
    return ((xf - mu) * lax.rsqrt(var + EPS) * g + b).astype(x.dtype)


def rms_norm(x, g):
    xf = x.astype(jnp.float32)
    return (xf * lax.rsqrt(jnp.mean(xf * xf, -1, keepdims=True) + EPS) * g).astype(x.dtype)


def group_rms(o):
    of = o.astype(jnp.float32)
    return of * lax.rsqrt(jnp.mean(of * of, -1, keepdims=True) + EPS)


def split_cols(p):
    offs = np.cumsum(IN_SIZES)[:-1].tolist()
    return jnp.split(p, offs, axis=-1)


def to_heads(t, n_heads):
    b, n, _ = t.shape
    return t.reshape(b, n, n_heads, HEAD_DIM).transpose(0, 2, 1, 3)


def from_heads(t):
    b, h, n, d = t.shape
    return t.transpose(0, 2, 1, 3).reshape(b, n, h * d)


def axial_rope(rows):
    row = jnp.repeat(jnp.arange(rows, dtype=jnp.float32), GRID_W)
    col = jnp.tile(jnp.arange(GRID_W, dtype=jnp.float32), rows)
    n_freq = HEAD_DIM // 4
    inv = ROPE_THETA ** (-jnp.arange(n_freq, dtype=jnp.float32) / n_freq)
    ang = jnp.concatenate([row[:, None] * inv, col[:, None] * inv], axis=-1)
    return jnp.cos(ang), jnp.sin(ang)


def apply_rope(x, cos, sin):
    half = HEAD_DIM // 2
    x1, x2 = x[..., :half], x[..., half:]
    cb, sb = cos[:, None, :], sin[:, None, :]
    return jnp.concatenate([x1 * cb - x2 * sb, x1 * sb + x2 * cb], axis=-1)


def retention_dir(q, k, v, log_g, s0, include_diag):
    b, h, n, d = q.shape
    nc, cl = n // RET_CHUNK, RET_CHUNK
    qc = q.reshape(b, h, nc, cl, d)
    kc = k.reshape(b, h, nc, cl, d)
    vc = v.reshape(b, h, nc, cl, d)
    idx = jnp.arange(cl, dtype=jnp.float32)
    diff = idx[:, None] - idx[None, :]
    mask = diff >= 0 if include_diag else diff > 0
    lg = log_g[:, None, None]
    decay_mat = jnp.where(mask, jnp.exp(lg * jnp.where(mask, diff, 0.0)), 0.0)
    scores = jnp.einsum('bhcid,bhcjd->bhcij', qc, kc) * decay_mat[:, None]
    intra = jnp.einsum('bhcij,bhcjv->bhciv', scores, vc)
    k_w = jnp.exp(log_g[:, None] * (cl - 1.0 - idx)[None, :])[:, None, :, None]
    contrib = jnp.einsum('bhcjd,bhcjv->cbhdv', kc * k_w, vc)
    chunk_decay = jnp.exp(log_g * cl)[:, None, None]

    def step(s, u):
        return chunk_decay * s + u, s

    _, s_prev = lax.scan(step, s0, contrib)
    q_w = jnp.exp(log_g[:, None] * (idx + 1.0)[None, :])[:, None, :, None]
    inter = jnp.einsum('bhcid,cbhdv->bhciv', qc * q_w, s_prev)
    return (intra + inter).reshape(b, h, n, d)


def retention_final_state(k, v, log_g, reverse):
    n = k.shape[2]
    pos = jnp.arange(n, dtype=jnp.float32)
    expo = pos if reverse else (n - 1.0 - pos)
    w = jnp.exp(log_g[:, None] * expo[None, :])[:, :, None]
    return jnp.einsum('bhnd,bhnv->bhdv', k * w, v)


def retention_bidir(q, k, v, lg_f, lg_b, s_f, s_b):
    fwd = retention_dir(q, k, v, lg_f, s_f, True)
    bwd = retention_dir(jnp.flip(q, 2), jnp.flip(k, 2), jnp.flip(v, 2), lg_b, s_b, False)
    return fwd + jnp.flip(bwd, 2)


def retention_group(q, k, v, g, qc, kc, vc, gc, decay_logit, need_ctx):
    lg_f = jax.nn.log_sigmoid(decay_logit[0].astype(jnp.float32))
    lg_b = jax.nn.log_sigmoid(decay_logit[1].astype(jnp.float32))
    scale = HEAD_DIM ** -0.5
    q, k, v = to_heads(q, RET_HEADS), to_heads(k, RET_HEADS) * scale, to_heads(v, RET_HEADS)
    qc, kc, vc = to_heads(qc, RET_HEADS), to_heads(kc, RET_HEADS) * scale, to_heads(vc, RET_HEADS)
    s_f = retention_final_state(kc, vc, lg_f, False)
    s_b = retention_final_state(kc, vc, lg_b, True)
    o = retention_bidir(q, k, v, lg_f, lg_b, s_f, s_b)
    out = from_heads(group_rms(o)) * jax.nn.silu(g)
    out_c = None
    if need_ctx:
        z = jnp.zeros_like(s_f)
        oc = retention_bidir(qc, kc, vc, lg_f, lg_b, z, z)
        out_c = from_heads(group_rms(oc)) * jax.nn.silu(gc)
    return out, out_c


def block_attention(q, k, v):
    b, n, hq, d = q.shape
    hkv = k.shape[2]
    grp = hq // hkv
    nb = n // Q_BLOCK
    qb = q.reshape(b, nb, Q_BLOCK, hkv, grp, d).transpose(1, 0, 2, 3, 4, 5)
    scale = HEAD_DIM ** -0.5

    def one(qblk):
        s = jnp.einsum('bqhgd,bmhd->bhgqm', qblk, k).astype(jnp.float32) * scale
        p = jax.nn.softmax(s, axis=-1).astype(v.dtype)
        return jnp.einsum('bhgqm,bmhd->bqhgd', p, v)

    o = lax.map(one, qb)
    return o.transpose(1, 0, 2, 3, 4, 5).reshape(b, n, hq * d)


def attention_group(q, k, v, qc, kc, vc, q_gain, k_gain, cos, sin, need_ctx):
    b, n, _ = q.shape
    lc = qc.shape[1]
    q = apply_rope(rms_norm(q.reshape(b, n, ATT_Q_HEADS, HEAD_DIM), q_gain), cos, sin)
    k = apply_rope(rms_norm(k.reshape(b, n, ATT_KV_HEADS, HEAD_DIM), k_gain), cos, sin)
    v = v.reshape(b, n, ATT_KV_HEADS, HEAD_DIM)
    kc = rms_norm(kc.reshape(b, lc, ATT_KV_HEADS, HEAD_DIM), k_gain)
    vc = vc.reshape(b, lc, ATT_KV_HEADS, HEAD_DIM)
    k_all = jnp.concatenate([k, kc.astype(k.dtype)], axis=1)
    v_all = jnp.concatenate([v, vc], axis=1)
    out = block_attention(q, k_all, v_all)
    out_c = None
    if need_ctx:
        qc = rms_norm(qc.reshape(b, lc, ATT_Q_HEADS, HEAD_DIM), q_gain)
        out_c = block_attention(qc, kc, vc)
    return out, out_c


def centred_dwconv(x, w, b):
    n = x.shape[1]
    xp = jnp.pad(x, ((0, 0), (CONV_W // 2, CONV_W - 1 - CONV_W // 2), (0, 0)))
    acc = xp[:, 0:n] * w[0]
    for j in range(1, CONV_W):
        acc = acc + xp[:, j:j + n] * w[j]
    return acc + b


def rglru_coeffs(xr, w_a, b_a, w_x, b_x, lam):
    blocks = xr.reshape(*xr.shape[:-1], LRU_BLOCKS, LRU_BLOCK_W)
    r = jax.nn.sigmoid(jnp.einsum('bnkc,kcd->bnkd', blocks, w_a).reshape(xr.shape) + b_a)
    i = jax.nn.sigmoid(jnp.einsum('bnkc,kcd->bnkd', blocks, w_x).reshape(xr.shape) + b_x)
    log_a = LRU_C * r.astype(jnp.float32) * jax.nn.log_sigmoid(lam.astype(jnp.float32))
    a = jnp.exp(log_a)
    drive = jnp.sqrt(-jnp.expm1(2.0 * log_a)) * (i * xr)
    return a, drive


def linear_scan(a, bdrive, h0):
    bdrive = bdrive.at[:, 0].add(a[:, 0] * h0)

    def comb(lhs, rhs):
        return lhs[0] * rhs[0], rhs[0] * lhs[1] + rhs[1]

    _, h = lax.associative_scan(comb, (a, bdrive), axis=1)
    return h


def rglru_group(xr, gb, xrc, gbc, conv_w, conv_b, w_a, b_a, w_x, b_x, lam, need_ctx):
    xr = centred_dwconv(xr, conv_w, conv_b)
    xrc = centred_dwconv(xrc, conv_w, conv_b)
    a_f, d_f = rglru_coeffs(xr, w_a[0], b_a[0], w_x[0], b_x[0], lam[0])
    a_b, d_b = rglru_coeffs(xr, w_a[1], b_a[1], w_x[1], b_x[1], lam[1])
    ac_f, dc_f = rglru_coeffs(xrc, w_a[0], b_a[0], w_x[0], b_x[0], lam[0])
    ac_b, dc_b = rglru_coeffs(xrc, w_a[1], b_a[1], w_x[1], b_x[1], lam[1])
    h0 = jnp.zeros((xr.shape[0], LRU_W), a_f.dtype)
    hc_f = linear_scan(ac_f, dc_f, h0)
    hc_b = jnp.flip(linear_scan(jnp.flip(ac_b, 1), jnp.flip(dc_b, 1), h0), 1)
    h_f = linear_scan(a_f, d_f, hc_f[:, -1])
    h_b = jnp.flip(linear_scan(jnp.flip(a_b, 1), jnp.flip(d_b, 1), hc_b[:, 0]), 1)
    out = (h_f + h_b) * jax.nn.gelu(gb)
    out_c = (hc_f + hc_b) * jax.nn.gelu(gbc) if need_ctx else None
    return out, out_c


def token_mixers(u, uc, w_in, decay_logit, q_gain, k_gain, conv_w, conv_b,
                 w_a, b_a, w_x, b_x, lam, cos, sin, need_ctx):
    rq, rk, rv, rg, aq, ak, av, lx, lg = split_cols(u @ w_in)
    rqc, rkc, rvc, rgc, aqc, akc, avc, lxc, lgc = split_cols(uc @ w_in)
    ret, ret_c = retention_group(rq, rk, rv, rg, rqc, rkc, rvc, rgc, decay_logit, need_ctx)
    att, att_c = attention_group(aq, ak, av, aqc, akc, avc, q_gain, k_gain, cos, sin, need_ctx)
    lru, lru_c = rglru_group(lx, lg, lxc, lgc, conv_w, conv_b, w_a, b_a, w_x, b_x, lam, need_ctx)
    mix = jnp.concatenate([ret.astype(u.dtype), att.astype(u.dtype), lru.astype(u.dtype)], axis=-1)
    mix_c = None
    if need_ctx:
        mix_c = jnp.concatenate([ret_c.astype(u.dtype), att_c.astype(u.dtype), lru_c.astype(u.dtype)], axis=-1)
    return mix, mix_c


def squared_relu_mlp(u, w1, w2):
    return jnp.square(jax.nn.relu(u @ w1)) @ w2


def setup_inputs(seed: int = 0) -> dict:
    key = jax.random.key(seed)
    ks = jax.random.split(key, 26)

    def nrm(k, shape, s):
        return jax.random.normal(k, shape, jnp.float32) * s

    gam = 1.0 - 2.0 ** (-5.0 - np.arange(RET_HEADS))
    base_logit = jnp.asarray(np.log(gam / (1.0 - gam)).astype(np.float32))
    a0 = jax.random.uniform(ks[10], (DEPTH, 2, LRU_W), jnp.float32, minval=0.9, maxval=0.999)
    sig = a0 ** (1.0 / LRU_C)
    return {
        'x': nrm(ks[0], (BATCH, SEQ, D_MODEL), 1.0),
        'c': nrm(ks[1], (BATCH, D_MODEL), 1.0),
        'ctx': nrm(ks[2], (BATCH, CTX_LEN, D_MODEL), 1.0),
        'c_ctx': nrm(ks[3], (D_MODEL,), 1.0),
        'w_ada': nrm(ks[4], (DEPTH, D_MODEL, 6 * D_MODEL), D_MODEL ** -0.5),
        'b_ada': nrm(ks[5], (DEPTH, 6 * D_MODEL), 0.02),
        'w_in': nrm(ks[6], (DEPTH, D_MODEL, D_IN), D_MODEL ** -0.5),
        'ret_decay_logit': base_logit + nrm(ks[7], (DEPTH, 2, RET_HEADS), 0.01),
        'attn_q_gain': 1.0 + nrm(ks[8], (DEPTH, HEAD_DIM), 0.02),
        'attn_k_gain': 1.0 + nrm(ks[9], (DEPTH, HEAD_DIM), 0.02),
        'lru_conv_w': nrm(ks[11], (DEPTH, CONV_W, LRU_W), CONV_W ** -0.5),
        'lru_conv_b': nrm(ks[12], (DEPTH, LRU_W), 0.02),
        'lru_w_a': nrm(ks[13], (DEPTH, 2, LRU_BLOCKS, LRU_BLOCK_W, LRU_BLOCK_W), LRU_BLOCK_W ** -0.5),
        'lru_b_a': nrm(ks[14], (DEPTH, 2, LRU_W), 0.02),
        'lru_w_x': nrm(ks[15], (DEPTH, 2, LRU_BLOCKS, LRU_BLOCK_W, LRU_BLOCK_W), LRU_BLOCK_W ** -0.5),
        'lru_b_x': nrm(ks[16], (DEPTH, 2, LRU_W), 0.02),
        'lru_lambda': jnp.log(sig) - jnp.log1p(-sig),
        'w_out': nrm(ks[17], (DEPTH, D_MIX, D_MODEL), BETA * D_MIX ** -0.5),
        'ln1_g': 1.0 + nrm(ks[18], (DEPTH, D_MODEL), 0.02),
        'ln1_b': nrm(ks[19], (DEPTH, D_MODEL), 0.02),
        'w_ff1': nrm(ks[20], (DEPTH, D_MODEL, D_FF), D_MODEL ** -0.5),
        'w_ff2': nrm(ks[21], (DEPTH, D_FF, D_MODEL), BETA * D_FF ** -0.5),
        'ln2_g': 1.0 + nrm(ks[22], (DEPTH, D_MODEL), 0.02),
        'ln2_b': nrm(ks[23], (DEPTH, D_MODEL), 0.02),
    }


def reference(x, c, ctx, c_ctx, w_ada, b_ada, w_in, ret_decay_logit, attn_q_gain, attn_k_gain,
              lru_conv_w, lru_conv_b, lru_w_a, lru_b_a, lru_w_x, lru_b_x, lru_lambda,
              w_out, ln1_g, ln1_b, w_ff1, w_ff2, ln2_g, ln2_b):
    n_lat = x.shape[1]
    rows = n_lat // GRID_W
    cos, sin = axial_rope(rows)
    s_c = jax.nn.silu(c)
    s_cc = jax.nn.silu(c_ctx)
    xc = ctx
    for l in range(DEPTH):
        need_ctx = l < DEPTH - 1
        mod = (s_c @ w_ada[l] + b_ada[l])[:, None, :]
        sh1, sc1, g1, sh2, sc2, g2 = jnp.split(mod, 6, axis=-1)
        modc = s_cc @ w_ada[l] + b_ada[l]
        csh1, csc1, cg1, csh2, csc2, cg2 = jnp.split(modc, 6, axis=-1)
        mix, mix_c = token_mixers(x * (1.0 + sc1) + sh1, xc * (1.0 + csc1) + csh1, w_in[l],
                                  ret_decay_logit[l], attn_q_gain[l], attn_k_gain[l],
                                  lru_conv_w[l], lru_conv_b[l], lru_w_a[l], lru_b_a[l],
                                  lru_w_x[l], lru_b_x[l], lru_lambda[l], cos, sin, need_ctx)
        x = layer_norm(ALPHA * x + g1 * (mix @ w_out[l]), ln1_g[l], ln1_b[l])
        ff = squared_relu_mlp(x * (1.0 + sc2) + sh2, w_ff1[l], w_ff2[l])
        x = layer_norm(ALPHA * x + g2 * ff, ln2_g[l], ln2_b[l])
        if need_ctx:
            xc = layer_norm(ALPHA * xc + cg1 * (mix_c @ w_out[l]), ln1_g[l], ln1_b[l])
            ffc = squared_relu_mlp(xc * (1.0 + csc2) + csh2, w_ff1[l], w_ff2[l])
            xc = layer_norm(ALPHA * xc + cg2 * ffc, ln2_g[l], ln2_b[l])
    return x
```

```cpp
#include <hip/hip_runtime.h>
#include <hip/hip_cooperative_groups.h>
#include <hip/hip_bf16.h>
#include <hip/hip_fp16.h>
#include <cstdio>
#include <cstdint>
#include <cmath>
namespace cg = cooperative_groups;

constexpr int DM = 1024, NB = 8, SEQ = 4096, CTXL = 256, DEPTH = 4;
constexpr int ML = NB * SEQ, MC = NB * CTXL, MT = ML + MC;
constexpr int DIN = 2304, DFF = 4096, KVL = SEQ + CTXL;
constexpr float ALPHA = 1.6817928305074290f, EPSN = 1e-6f;
namespace pg8 {
#define PG8_LAS __attribute__((address_space(3)))
typedef unsigned short bf16_t;
typedef short bf16x8 __attribute__((ext_vector_type(8)));
typedef float f32x4 __attribute__((ext_vector_type(4)));
typedef unsigned u32x4 __attribute__((ext_vector_type(4)));
constexpr int BM = 256, BK = 64, HALF = 128, HTB = HALF * BK * 2  , STAGE_BYTES = 8 * HTB, NXCD = 8, WGM = 8;

__host__ __device__ __forceinline__ int lds_byte(int r, int c) { const int st = (r >> 4) * 2 + (c >> 5), rr = r & 15, cc = c & 31, ob = rr * 64 + cc * 2; return st * 1024 + (ob ^ (((ob >> 9) & 1) << 5)); }
__host__ __device__ __forceinline__ void stage_rc(int b, int& R, int& C) { const int st = b / 1024, sb = b % 1024, swz = sb ^ (((sb >> 9) & 1) << 5); R = (st >> 1) * 16 + swz / 64; C = (st & 1) * 32 + (swz % 64) / 2; }
__host__ __device__ __forceinline__ int perm32(int rho) { const int n = rho >> 4, i = rho & 15; return 8 * (i >> 2) + 4 * n + (i & 3); }

struct Unit { int pm, pn, ks; };
struct Gemm { const bf16_t* A; const bf16_t* Bt; int M, N, K; };

struct StaticOrder {
    int nM, nN, nwg, G, c;
    __host__ __device__ void init(int M, int N, int G_, int c_) { nM = M / BM; nN = N / BM; nwg = nM * nN; G = G_; c = c_; }
    __host__ __device__ bool next(int i, Unit& u) const {
        const long L = (long)i * G + c; if (L >= nwg) return false;
        int wgid = (int)L; { const int q = nwg / NXCD, r = nwg % NXCD, xcd = wgid % NXCD, off = wgid / NXCD; wgid = (xcd < r ? xcd * (q + 1) : r * (q + 1) + (xcd - r) * q) + off; }
        const int nig = WGM * nN, gid = wgid / nig, fm = gid * WGM, gsz = (nM - fm) < WGM ? (nM - fm) : WGM;
        u.pm = fm + ((wgid % nig) % gsz); u.pn = (wgid % nig) / gsz; u.ks = -1; return true;
    }
    __device__ __forceinline__ void a_ready(const Unit&) const {}
    __device__ __forceinline__ void done(const Unit&) const {}
};


struct SplitOrder {
    StaticOrder base; int G, c, ksh;
    __host__ __device__ void init(int N, int G_, int c_, int ksh_) { base.init(32768, N, G_, c_); G = G_; c = c_; ksh = ksh_; }
    __host__ __device__ bool next(int i, Unit& u) const {
        if (base.next(i, u)) return true;
        const long L = (long)i * G + c - base.nwg; if (L < 0 || L >= (32 << ksh)) return false;
        u.pm = 128 + (int)(L >> (2 + ksh)); u.pn = (int)(L >> ksh) & 3; u.ks = (int)L & ((1 << ksh) - 1); return true;
    }
    __device__ __forceinline__ void a_ready(const Unit&) const {}
    __device__ __forceinline__ void done(const Unit&) const {}
};
__device__ __forceinline__ unsigned cvt_pk_bf16(float lo, float hi) { unsigned r; asm volatile("v_cvt_pk_bf16_f32 %0, %1, %2" : "=v"(r) : "v"(lo), "v"(hi)); return r; }
typedef unsigned u32x4 __attribute__((ext_vector_type(4)));
__device__ __forceinline__ float fast_sigmoid(float x) { return __builtin_amdgcn_rcpf(1.0f + __expf(-x)); }
__device__ __forceinline__ float act_silu(float x) { return x * fast_sigmoid(x); }
__device__ __forceinline__ float act_gelu_tanh(float x) { const float z = 0.7978845608028654f * (x + 0.044715f * x * x * x); return x * fast_sigmoid(2.0f * z); }
__device__ __forceinline__ u32x4 pack8(const f32x4 a, const f32x4 b) { u32x4 w; w.x = cvt_pk_bf16(a[0], a[1]); w.y = cvt_pk_bf16(a[2], a[3]); w.z = cvt_pk_bf16(b[0], b[1]); w.w = cvt_pk_bf16(b[2], b[3]); return w; }

struct EpiIn {
    static constexpr bool PERM = true, AFTER_DRAIN = false;
    bf16_t* P4;
    bf16_t *AQ, *KB, *VB, *LX, *LG;
    const float *qgain, *kgain, *rope;
    __device__ __forceinline__ void operator()(const f32x4 (&acc)[2][2][4][2], const Unit& u, int wr, int wc, int fr, int fq) const {
        const int pn = u.pn; const int rowb = u.pm * BM + wr * 64 + fr; const bool lat = u.pm < (32768 / BM);
        if (pn < 4 || pn >= 7) {
            bf16_t* base = pn < 4 ? P4 + (size_t)pn * ((size_t)34816 * 256) : (pn == 7 ? LX : LG);
#pragma unroll
            for (int ai = 0; ai < 2; ++ai)
#pragma unroll
                for (int m = 0; m < 4; ++m) { bf16_t* rp = base + (size_t)(rowb + ai * HALF + m * 16) * 256 + 64 * wc + 8 * fq;
#pragma unroll
                    for (int bj = 0; bj < 2; ++bj) { f32x4 v0 = acc[ai][bj][m][0], v1 = acc[ai][bj][m][1];
                        if (pn == 1) { v0 = v0 * 0.125f; v1 = v1 * 0.125f; }
                        else if (pn == 3) {
#pragma unroll
                            for (int e = 0; e < 4; ++e) { v0[e] = act_silu(v0[e]); v1[e] = act_silu(v1[e]); } }
                        else if (pn == 8) {
#pragma unroll
                            for (int e = 0; e < 4; ++e) { v0[e] = act_gelu_tanh(v0[e]); v1[e] = act_gelu_tanh(v1[e]); } }
                        *(u32x4*)(rp + 32 * bj) = pack8(v0, v1); } }
        } else if (pn < 6 || wc < 2) {
            const bool isq = pn < 6; const float* gain = isq ? qgain : kgain;
            const float post = isq ? (0.125f * 1.4426950408889634f) : 1.0f;
#pragma unroll
            for (int ai = 0; ai < 2; ++ai)
#pragma unroll
                for (int m = 0; m < 4; ++m) { const int row = rowb + ai * HALF + m * 16;
                    float ss = 0.f;
#pragma unroll
                    for (int bj = 0; bj < 2; ++bj)
#pragma unroll
                        for (int n = 0; n < 2; ++n) { const f32x4 x = acc[ai][bj][m][n]; ss += (x[0] * x[0] + x[1] * x[1]) + (x[2] * x[2] + x[3] * x[3]); }
                    ss += __shfl_xor(ss, 16); ss += __shfl_xor(ss, 32);
                    const float rs = rsqrtf(ss * (1.0f / 64.0f) + 1e-6f);
                    f32x4 o1[2], o2[2];
#pragma unroll
                    for (int n = 0; n < 2; ++n) { o1[n] = acc[ai][0][m][n] * rs * *(const f32x4*)(gain + 8 * fq + 4 * n); o2[n] = acc[ai][1][m][n] * rs * *(const f32x4*)(gain + 32 + 8 * fq + 4 * n); }
                    if (lat) { const float* rp = rope + ((size_t)(row & 4095) * 32 + 8 * fq) * 2;
#pragma unroll
                        for (int n = 0; n < 2; ++n) { const f32x4 cs0 = *(const f32x4*)(rp + 8 * n), cs1 = *(const f32x4*)(rp + 8 * n + 4);
                            const float c[4] = {cs0[0], cs0[2], cs1[0], cs1[2]}, s[4] = {cs0[1], cs0[3], cs1[1], cs1[3]};
#pragma unroll
                            for (int e = 0; e < 4; ++e) { const float x1 = o1[n][e], x2 = o2[n][e]; o1[n][e] = x1 * c[e] - x2 * s[e]; o2[n][e] = x1 * s[e] + x2 * c[e]; } } }
#pragma unroll
                    for (int n = 0; n < 2; ++n) { o1[n] = o1[n] * post; o2[n] = o2[n] * post; }
                    asm volatile("" ::: "memory");
                    bf16_t* dst;
                    if (isq) dst = AQ + (size_t)row * 512 + ((pn - 4) * 4 + wc) * 64 + 8 * fq;
                    else { const int j = row - 32768; const int kvrow = lat ? (row >> 12) * 4352 + (row & 4095) : (j >> 8) * 4352 + 4096 + (j & 255); dst = KB + (size_t)kvrow * 128 + wc * 64 + 8 * fq; }
                    *(u32x4*)dst = pack8(o1[0], o1[1]); *(u32x4*)(dst + 32) = pack8(o2[0], o2[1]); }
        } else {
#pragma unroll
            for (int ai = 0; ai < 2; ++ai)
#pragma unroll
                for (int m = 0; m < 4; ++m) { const int row = rowb + ai * HALF + m * 16; const int j = row - 32768;
                    const int kvrow = lat ? (row >> 12) * 4352 + (row & 4095) : (j >> 8) * 4352 + 4096 + (j & 255);
                    bf16_t* dst = VB + (size_t)kvrow * 128 + (wc - 2) * 64 + 8 * fq;
#pragma unroll
                    for (int bj = 0; bj < 2; ++bj) *(u32x4*)(dst + 32 * bj) = pack8(acc[ai][bj][m][0], acc[ai][bj][m][1]); }
        }
    }
};

struct EpiFF1 {
    static constexpr bool PERM = true, AFTER_DRAIN = false;
    bf16_t* H;
    __device__ __forceinline__ void operator()(const f32x4 (&acc)[2][2][4][2], const Unit& u, int wr, int wc, int fr, int fq) const {
        const int rowb = u.pm * BM + wr * 64 + fr; const int col0 = u.pn * BM + wc * 64 + 8 * fq;
#pragma unroll
        for (int ai = 0; ai < 2; ++ai)
#pragma unroll
            for (int m = 0; m < 4; ++m) { bf16_t* rp = H + (size_t)(rowb + ai * HALF + m * 16) * 4096 + col0;
#pragma unroll
                for (int bj = 0; bj < 2; ++bj) { f32x4 v0 = acc[ai][bj][m][0], v1 = acc[ai][bj][m][1];
#pragma unroll
                    for (int e = 0; e < 4; ++e) { const float a = fmaxf(v0[e], 0.f), b = fmaxf(v1[e], 0.f); v0[e] = a * a; v1[e] = b * b; }
                    __builtin_nontemporal_store(pack8(v0, v1), (u32x4*)(rp + bj * 32)); } }
    }
};

struct EpiRes {
    static constexpr bool PERM = true, AFTER_DRAIN = false;
    const float *rinL, *rinC; float *routL, *routC; const float* gate;
    float* part;
    const bf16_t* rinB;
    bf16_t* vout;
    __device__ __forceinline__ void operator()(const f32x4 (&acc)[2][2][4][2], const Unit& u, int wr, int wc, int fr, int fq) const {
        const bool lat = u.pm < (32768 / BM); const int bb = lat ? (u.pm >> 4) : 8;
        const int rowb = u.pm * BM + wr * 64 + fr; const int col0 = u.pn * BM + wc * 64 + 8 * fq;
        if (u.ks >= 0) { bf16_t* pb = (bf16_t*)part + ((size_t)u.ks * 2048 - 32768) * 1024;
#pragma unroll
            for (int ai = 0; ai < 2; ++ai)
#pragma unroll
                for (int m = 0; m < 4; ++m) { const size_t off = (size_t)(rowb + ai * HALF + m * 16) * 1024 + col0;
#pragma unroll
                    for (int bj = 0; bj < 2; ++bj) *(u32x4*)(pb + off + bj * 32) = pack8(acc[ai][bj][m][0], acc[ai][bj][m][1]); }
            return; }
        const float* gp = gate + (size_t)bb * 6144 + col0;
        f32x4 gv[2][2];
#pragma unroll
        for (int bj = 0; bj < 2; ++bj)
#pragma unroll
            for (int n = 0; n < 2; ++n) gv[bj][n] = *(const f32x4*)(gp + bj * 32 + n * 4);
        const float* ib = lat ? rinL : rinC - (size_t)32768 * 1024; float* ob = lat ? routL : routC - (size_t)32768 * 1024;
        const bool tobf = lat && vout != nullptr;
#pragma unroll
        for (int ai = 0; ai < 2; ++ai)
#pragma unroll
            for (int m = 0; m < 4; ++m) { const size_t off = (size_t)(rowb + ai * HALF + m * 16) * 1024 + col0;
#pragma unroll
                for (int bj = 0; bj < 2; ++bj) { f32x4 o[2];
                    if (lat && rinB) { const u32x4 w = __builtin_nontemporal_load((const u32x4*)(rinB + off + bj * 32));
                        const f32x4 b0 = {__builtin_bit_cast(float, w.x << 16), __builtin_bit_cast(float, w.x & 0xffff0000u), __builtin_bit_cast(float, w.y << 16), __builtin_bit_cast(float, w.y & 0xffff0000u)};
                        const f32x4 b1 = {__builtin_bit_cast(float, w.z << 16), __builtin_bit_cast(float, w.z & 0xffff0000u), __builtin_bit_cast(float, w.w << 16), __builtin_bit_cast(float, w.w & 0xffff0000u)};
                        o[0] = b0 * 1.6817928305074290f + gv[bj][0] * acc[ai][bj][m][0]; o[1] = b1 * 1.6817928305074290f + gv[bj][1] * acc[ai][bj][m][1]; }
                    else {
#pragma unroll
                    for (int n = 0; n < 2; ++n) { const f32x4 bs = *(const f32x4*)(ib + off + bj * 32 + n * 4); o[n] = bs * 1.6817928305074290f + gv[bj][n] * acc[ai][bj][m][n]; } }
                    if (tobf) *(u32x4*)(vout + off + bj * 32) = pack8(o[0], o[1]);
                    else { *(f32x4*)(ob + off + bj * 32) = o[0]; *(f32x4*)(ob + off + bj * 32 + 4) = o[1]; } }
                if (m == 3) asm volatile("" ::: "memory"); }
    }
};

struct EpiNull {
    static constexpr bool PERM = false, AFTER_DRAIN = false;
    float* sink;
    __device__ __forceinline__ void operator()(const f32x4 (&acc)[2][2][4][2], const Unit& u, int wr, int wc, int fr, int fq) const {
        float s = 0.f;
#pragma unroll
        for (int ai = 0; ai < 2; ++ai)
#pragma unroll
            for (int bj = 0; bj < 2; ++bj)
#pragma unroll
                for (int m = 0; m < 4; ++m)
#pragma unroll
                    for (int n = 0; n < 2; ++n) s += acc[ai][bj][m][n][0] + acc[ai][bj][m][n][1] + acc[ai][bj][m][n][2] + acc[ai][bj][m][n][3];
        if (s == 123.456f) sink[0] = s;
    }
};
template <class Epi, class Sched, bool ALIGN_EPI = false, bool SP2 = false>
__device__ __forceinline__ void gemm_phase(PG8_LAS unsigned char* lds, const Gemm g, const Sched& S, const Epi& E) {
    int tid = threadIdx.x; asm volatile("" : "+v"(tid));
    const int wid = __builtin_amdgcn_readfirstlane(tid >> 6), lane = tid & 63, wr = wid >> 2, wc = wid & 3, fr = lane & 15, fq = lane >> 4;
    const int K = g.K, nt = K / BK;
    const int ksh = (K >= 4096) ? 3 : 2;
#define PG8_NT(u_) ((u_).ks < 0 ? nt : (nt >> ksh))
#define PG8_KOFF(u_) ((u_).ks < 0 ? (size_t)0 : (size_t)(u_).ks * (size_t)(K >> ksh) * 2)
    unsigned voffA[2], voffB[2];
#pragma unroll
    for (int i = 0; i < 2; ++i) { int R, C; stage_rc(tid * 16 + i * 8192, R, C); const int Rb = Epi::PERM ? ((R & ~31) + perm32(R & 31)) : R;
        voffA[i] = (unsigned)(R * K + C) * 2u; voffB[i] = (unsigned)(Rb * K + C) * 2u; }
    const size_t kstep = (size_t)(BK * 2);
    const size_t hstep = (size_t)HALF * K * 2;
    const size_t tstep = 2 * hstep;
    const unsigned ldsw = (unsigned)wid * 1024u;
    const int aoff = lds_byte(wr * 64 + fr, fq * 8), boff = lds_byte(wc * 32 + fr, fq * 8);
#define PG8_SA(b, h) (((b) * 2 + (h)) * HTB)
#define PG8_SB(b, h) ((4 + (b) * 2 + (h)) * HTB)
#define PG8_STAGE(bufoff, gbase, voff) do { _Pragma("unroll") for (int _i = 0; _i < 2; ++_i) \
        __builtin_amdgcn_global_load_lds((const unsigned*)((const char*)(gbase) + (voff)[_i]), (PG8_LAS unsigned*)(lds + (bufoff) + ldsw + _i * 8192), 16, 0, 0); } while (0)
#define PG8_LDA(dst, b, h) do { _Pragma("unroll") for (int m = 0; m < 4; ++m) _Pragma("unroll") for (int k = 0; k < 2; ++k) dst[m][k] = *(const PG8_LAS bf16x8*)(lds + PG8_SA(b, h) + aoff + m * 2048 + k * 1024); } while (0)
#define PG8_LDB(dst, b, h) do { _Pragma("unroll") for (int n = 0; n < 2; ++n) _Pragma("unroll") for (int k = 0; k < 2; ++k) dst[n][k] = *(const PG8_LAS bf16x8*)(lds + PG8_SB(b, h) + boff + n * 2048 + k * 1024); } while (0)
#define PG8_MMA(ai, bj, At, Bt) do { __builtin_amdgcn_s_setprio(1); _Pragma("unroll") for (int m = 0; m < 4; ++m) _Pragma("unroll") for (int n = 0; n < 2; ++n) _Pragma("unroll") for (int k = 0; k < 2; ++k) \
        acc[ai][bj][m][n] = __builtin_amdgcn_mfma_f32_16x16x32_bf16(Bt[n][k], At[m][k], acc[ai][bj][m][n], 0, 0, 0); __builtin_amdgcn_s_setprio(0); } while (0)
#define PG8_WAIT_V(n) asm volatile("s_waitcnt vmcnt(" #n ")" ::: "memory")
#define PG8_WAIT_L(n) asm volatile("s_waitcnt lgkmcnt(" #n ")" ::: "memory")
#define PG8_BAR __builtin_amdgcn_s_barrier()
#define PG8_SCHED __builtin_amdgcn_sched_barrier(0)
    Unit cur, nxt; int ui = 0;
    if (!S.next(0, cur)) return;
    f32x4 acc[2][2][4][2];
#pragma unroll
    for (int a = 0; a < 2; ++a)
#pragma unroll
        for (int b = 0; b < 2; ++b)
#pragma unroll
            for (int m = 0; m < 4; ++m)
#pragma unroll
                for (int n = 0; n < 2; ++n) acc[a][b][m][n] = (f32x4){0.f, 0.f, 0.f, 0.f};
    bf16x8 At[4][2], B0[2][2], B1[2][2];
    const char* cA = (const char*)g.A + (size_t)cur.pm * tstep + PG8_KOFF(cur); const char* cB = (const char*)g.Bt + (size_t)cur.pn * tstep + PG8_KOFF(cur);
    S.a_ready(cur);
    if constexpr (SP2) {
        PG8_STAGE(PG8_SB(0, 0), cB, voffB); PG8_STAGE(PG8_SB(0, 1), cB + hstep, voffB); PG8_STAGE(PG8_SA(0, 0), cA, voffA); PG8_STAGE(PG8_SA(0, 1), cA + hstep, voffA);
        if (wr == 1) PG8_BAR;
        PG8_WAIT_V(2); PG8_BAR;
        PG8_STAGE(PG8_SB(1, 0), cB + kstep, voffB); PG8_STAGE(PG8_SA(1, 0), cA + kstep, voffA); PG8_STAGE(PG8_SB(1, 1), cB + hstep + kstep, voffB);
        PG8_WAIT_V(6); PG8_BAR;
    } else {
        PG8_STAGE(PG8_SB(0, 0), cB, voffB); PG8_STAGE(PG8_SA(0, 0), cA, voffA); PG8_STAGE(PG8_SB(0, 1), cB + hstep, voffB); PG8_STAGE(PG8_SA(0, 1), cA + hstep, voffA);
        if (wr == 1) PG8_BAR;
        PG8_WAIT_V(4); PG8_BAR;
        PG8_STAGE(PG8_SB(1, 0), cB + kstep, voffB); PG8_STAGE(PG8_SA(1, 0), cA + kstep, voffA); PG8_STAGE(PG8_SB(1, 1), cB + hstep + kstep, voffB);
        PG8_WAIT_V(6); PG8_BAR;
    }
    for (;;) {
        const bool has_next = S.next(ui + 1, nxt);
        const char* nA = has_next ? (const char*)g.A + (size_t)nxt.pm * tstep + PG8_KOFF(nxt) : cA; const char* nB = has_next ? (const char*)g.Bt + (size_t)nxt.pn * tstep + PG8_KOFF(nxt) : cB;
        const int ntc = PG8_NT(cur);
        for (int t = 0; t < ntc; t += 2) {
            const bool last = (t == ntc - 2);
            const char* a1 = cA + (size_t)(t + 1) * kstep;
            const char* a2 = last ? nA : cA + (size_t)(t + 2) * kstep; const char* b2 = last ? nB : cB + (size_t)(t + 2) * kstep;
            const char* a3 = a2 + kstep; const char* b3 = b2 + kstep;
            if (last && has_next) S.a_ready(nxt);
            if constexpr (SP2) {
            PG8_LDB(B0, 0, 0); PG8_LDB(B1, 0, 1); PG8_SCHED; PG8_LDA(At, 0, 0); PG8_STAGE(PG8_SA(1, 1), a1 + hstep, voffA);
            PG8_WAIT_V(8); PG8_WAIT_L(0); PG8_BAR; PG8_MMA(0, 0, At, B0); PG8_MMA(0, 1, At, B1); PG8_BAR; PG8_SCHED;
            PG8_LDA(At, 0, 1); PG8_STAGE(PG8_SB(0, 0), b2, voffB); PG8_STAGE(PG8_SB(0, 1), b2 + hstep, voffB); PG8_STAGE(PG8_SA(0, 0), a2, voffA);
            PG8_WAIT_V(8); PG8_WAIT_L(0); PG8_BAR; PG8_MMA(1, 0, At, B0); PG8_MMA(1, 1, At, B1); PG8_BAR; PG8_SCHED;
            PG8_LDB(B0, 1, 0); PG8_LDB(B1, 1, 1); PG8_SCHED; PG8_LDA(At, 1, 0); PG8_STAGE(PG8_SA(0, 1), a2 + hstep, voffA);
            PG8_WAIT_V(8); PG8_WAIT_L(0); PG8_BAR; PG8_MMA(0, 0, At, B0); PG8_MMA(0, 1, At, B1); PG8_BAR; PG8_SCHED;
            PG8_LDA(At, 1, 1); PG8_STAGE(PG8_SB(1, 0), b3, voffB); PG8_STAGE(PG8_SB(1, 1), b3 + hstep, voffB); PG8_STAGE(PG8_SA(1, 0), a3, voffA);
            PG8_WAIT_V(8); PG8_WAIT_L(0); PG8_BAR; PG8_MMA(1, 0, At, B0); PG8_MMA(1, 1, At, B1); PG8_BAR; PG8_SCHED;
            } else {
            PG8_LDB(B0, 0, 0); PG8_SCHED; PG8_LDA(At, 0, 0); PG8_STAGE(PG8_SA(1, 1), a1 + hstep, voffA);
            PG8_WAIT_L(8); PG8_BAR; PG8_WAIT_L(0); PG8_MMA(0, 0, At, B0); PG8_BAR; PG8_SCHED;
            PG8_LDB(B1, 0, 1); PG8_STAGE(PG8_SB(0, 0), b2, voffB);
            PG8_BAR; PG8_WAIT_L(0); PG8_MMA(0, 1, At, B1); PG8_BAR;
            PG8_LDA(At, 0, 1); PG8_STAGE(PG8_SA(0, 0), a2, voffA);
            PG8_BAR; PG8_WAIT_L(0); PG8_MMA(1, 0, At, B0); PG8_BAR; PG8_SCHED;
            PG8_STAGE(PG8_SB(0, 1), b2 + hstep, voffB);
            PG8_WAIT_V(6); PG8_BAR; PG8_MMA(1, 1, At, B1); PG8_BAR;
            PG8_LDB(B0, 1, 0); PG8_SCHED; PG8_LDA(At, 1, 0); PG8_STAGE(PG8_SA(0, 1), a2 + hstep, voffA);
            PG8_WAIT_L(8); PG8_BAR; PG8_WAIT_L(0); PG8_MMA(0, 0, At, B0); PG8_BAR; PG8_SCHED;
            PG8_LDB(B1, 1, 1); PG8_STAGE(PG8_SB(1, 0), b3, voffB);
            PG8_BAR; PG8_WAIT_L(0); PG8_MMA(0, 1, At, B1); PG8_BAR;
            PG8_LDA(At, 1, 1); PG8_STAGE(PG8_SA(1, 0), a3, voffA);
            PG8_BAR; PG8_WAIT_L(0); PG8_MMA(1, 0, At, B0); PG8_BAR; PG8_SCHED;
            PG8_STAGE(PG8_SB(1, 1), b3 + hstep, voffB);
            PG8_WAIT_V(6); PG8_BAR; PG8_MMA(1, 1, At, B1); PG8_BAR;
            }
        }
        if constexpr (ALIGN_EPI) { if (wr == 0) PG8_BAR; }
        if constexpr (!Epi::AFTER_DRAIN) { E(acc, cur, wr, wc, fr, fq); S.done(cur); }
        if (!has_next) break;
#pragma unroll
        for (int a = 0; a < 2; ++a)
#pragma unroll
            for (int b = 0; b < 2; ++b)
#pragma unroll
                for (int m = 0; m < 4; ++m)
#pragma unroll
                    for (int n = 0; n < 2; ++n) acc[a][b][m][n] = (f32x4){0.f, 0.f, 0.f, 0.f};
        cur = nxt; cA = nA; cB = nB; ++ui;
        if constexpr (ALIGN_EPI) { if (wr == 1) PG8_BAR; }
    }
    PG8_WAIT_V(0);
    if constexpr (!ALIGN_EPI) { if (wr == 0) PG8_BAR; }
    PG8_BAR;
    if constexpr (Epi::AFTER_DRAIN) { E.fused(acc, cur, wr, wc, fr, fq, lds, wid, lane); S.done(cur); }
#undef PG8_NT
#undef PG8_KOFF
#undef PG8_SA
#undef PG8_SB
#undef PG8_STAGE
#undef PG8_LDA
#undef PG8_LDB
#undef PG8_MMA
#undef PG8_WAIT_V
#undef PG8_WAIT_L
#undef PG8_BAR
#undef PG8_SCHED
}
}
#include <hip/hip_bf16.h>
namespace attn_body {
using bf16=__hip_bfloat16;
using bf16x8=__attribute__((ext_vector_type(8)))short;
using s16x4=__attribute__((ext_vector_type(4)))short;
using f32x16=__attribute__((ext_vector_type(16)))float;
using u32x4=__attribute__((ext_vector_type(4)))unsigned;
constexpr int D=64,QP=512,KP=128,OP=1024;
constexpr int NW=8,QBLK=32,QB=QBLK*NW,KVBLK=64;
__device__ __forceinline__ int crow(int r,int hi){return (r&3)+8*(r>>2)+4*hi;}
#define SBAR() __builtin_amdgcn_sched_barrier(0)
__device__ __forceinline__ void cmask(f32x16&p0,f32x16&p1,int jb,int qrel,int hi){
  const float NEG=-INFINITY; int kb=64*jb+4*hi;
  #pragma unroll
  for(int r=0;r<16;++r){int kv=kb+(r&3)+8*(r>>2); if(kv>qrel)p0[r]=NEG; if(kv+32>qrel)p1[r]=NEG;}
}

constexpr int NSLOT=3, SLOTB=8192;
constexpr int LDS_K=0, LDS_V=NSLOT*SLOTB, LDS_WS=2*NSLOT*SLOTB, LDS_OST=LDS_WS+NW*64*4, LDS_BYTES=LDS_OST+NW*4096;
constexpr float C2=0.125f*1.4426950408889634f;
__device__ __forceinline__ void glds16(const void*gsrc,unsigned lds_dst){unsigned keep;
  asm volatile("s_mov_b32 %0, m0\n\ts_mov_b32 m0, %2\n\ts_nop 0\n\tglobal_load_lds_dwordx4 %1, off\n\ts_mov_b32 m0, %0":"=&s"(keep):"v"(gsrc),"s"(lds_dst):"memory");}
__device__ __forceinline__ float max3f(float a,float b,float c){float r;asm("v_max3_f32 %0, %1, %2, %3":"=v"(r):"v"(a),"v"(b),"v"(c));return r;}
__device__ __forceinline__ float max2f(float a,float b){float r;asm("v_max_f32_e32 %0, %1, %2":"=v"(r):"v"(a),"v"(b));return r;}
__device__ __forceinline__ float fadd_s(float a,float b){float r;asm("v_add_f32_e32 %0, %1, %2":"=v"(r):"v"(a),"v"(b));return r;}
__device__ __forceinline__ float fsub_s(float a,float b){float r;asm("v_sub_f32_e32 %0, %1, %2":"=v"(r):"v"(a),"v"(b));return r;}
typedef float f32x2_t __attribute__((ext_vector_type(2))); typedef __bf16 bf16x2_t __attribute__((ext_vector_type(2)));
__device__ __forceinline__ unsigned cvtpk_s(float lo,float hi){f32x2_t v={lo,hi};bf16x2_t b=__builtin_convertvector(v,bf16x2_t);return __builtin_bit_cast(unsigned,b);}
#define WAIT_BAR(N) asm volatile("s_waitcnt vmcnt(" #N ") lgkmcnt(0)\n\ts_barrier":::"memory")

__device__ __forceinline__ void qkt(f32x16&p0,f32x16&p1,const char*Kslot,const bf16x8*qr,const f32x16&negm,int r32,int hi){
  const char*kb=Kslot+hi*1024+r32*16;
  #pragma unroll
  for(int d0=0;d0<4;++d0){
    const bf16x8 b0=*reinterpret_cast<const bf16x8*>(kb+d0*2048);
    const bf16x8 b1=*reinterpret_cast<const bf16x8*>(kb+d0*2048+512);
    if(d0==0){p0=__builtin_amdgcn_mfma_f32_32x32x16_bf16(b0,qr[0],negm,0,0,0);p1=__builtin_amdgcn_mfma_f32_32x32x16_bf16(b1,qr[0],negm,0,0,0);}
    else{p0=__builtin_amdgcn_mfma_f32_32x32x16_bf16(b0,qr[d0],p0,0,0,0);p1=__builtin_amdgcn_mfma_f32_32x32x16_bf16(b1,qr[d0],p1,0,0,0);}}
}
typedef __attribute__((address_space(3))) const char* lds_cptr;
typedef short v4i16_t __attribute__((ext_vector_type(4)));
__device__ __forceinline__ void kload8(bf16x8*kf,lds_cptr kp){
  kf[0]=*(const __attribute__((address_space(3))) bf16x8*)(kp);      kf[1]=*(const __attribute__((address_space(3))) bf16x8*)(kp+512);
  kf[2]=*(const __attribute__((address_space(3))) bf16x8*)(kp+2048); kf[3]=*(const __attribute__((address_space(3))) bf16x8*)(kp+2560);
  kf[4]=*(const __attribute__((address_space(3))) bf16x8*)(kp+4096); kf[5]=*(const __attribute__((address_space(3))) bf16x8*)(kp+4608);
  kf[6]=*(const __attribute__((address_space(3))) bf16x8*)(kp+6144); kf[7]=*(const __attribute__((address_space(3))) bf16x8*)(kp+6656);
}
__device__ __forceinline__ void kload2(bf16x8*kf,lds_cptr kp,int j){ kf[2*j]=*(const __attribute__((address_space(3))) bf16x8*)(kp+j*2048); kf[2*j+1]=*(const __attribute__((address_space(3))) bf16x8*)(kp+j*2048+512); }
__device__ __forceinline__ s16x4 vtr(lds_cptr p){ return __builtin_bit_cast(s16x4,__builtin_amdgcn_ds_read_tr16_b64_v4i16((__attribute__((address_space(3))) v4i16_t*)p)); }
__device__ __forceinline__ float rowmax(const f32x16&p0,const f32x16&p1){
  float a=max3f(p0[0],p0[1],p1[0]),b=max3f(p0[2],p0[3],p1[1]);a=max3f(a,p1[2],p1[3]);
  #pragma unroll
  for(int r=4;r<16;r+=4){a=max3f(a,p0[r],p0[r+1]);b=max3f(b,p0[r+2],p0[r+3]);a=max3f(a,p1[r],p1[r+1]);b=max3f(b,p1[r+2],p1[r+3]);}
  const float m=max2f(a,b);
  auto rr=__builtin_amdgcn_permlane32_swap(__float_as_uint(m),__float_as_uint(m),false,false);
  return max2f(__uint_as_float(rr[0]),__uint_as_float(rr[1]));
}
__device__ __forceinline__ void pv(f32x16*o,int vb,bf16x8 pa0,bf16x8 pa1,bf16x8 pa2,bf16x8 pa3){
  #pragma unroll
  for(int d0=0;d0<2;++d0){s16x4 lo[4],hi[4];
    #pragma unroll
    for(int ks=0;ks<4;++ks){
      asm volatile("ds_read_b64_tr_b16 %0,%1 offset:%c2":"=&v"(lo[ks]):"v"(vb),"i"(d0*4096+ks*1024):"memory");
      asm volatile("ds_read_b64_tr_b16 %0,%1 offset:%c2":"=&v"(hi[ks]):"v"(vb),"i"(d0*4096+ks*1024+512):"memory");}
    asm volatile("s_waitcnt lgkmcnt(0)":::"memory");SBAR();
    #define PK(k) (bf16x8){lo[k][0],lo[k][1],lo[k][2],lo[k][3],hi[k][0],hi[k][1],hi[k][2],hi[k][3]}
    o[d0]=__builtin_amdgcn_mfma_f32_32x32x16_bf16(pa0,PK(0),o[d0],0,0,0);
    o[d0]=__builtin_amdgcn_mfma_f32_32x32x16_bf16(pa1,PK(1),o[d0],0,0,0);
    o[d0]=__builtin_amdgcn_mfma_f32_32x32x16_bf16(pa2,PK(2),o[d0],0,0,0);
    o[d0]=__builtin_amdgcn_mfma_f32_32x32x16_bf16(pa3,PK(3),o[d0],0,0,0);
    #undef PK
  }
}
#define ATTN_STORE16(p,v) (*(u32x4*)(p)=(v))
template<int THRL> __device__ __forceinline__ void attn_unit(const bf16*Qu,const bf16*__restrict__ Kh,const bf16*__restrict__ Vh,bf16*Ou,const int NT,char*shm){
  int tid=threadIdx.x; asm volatile("":"+v"(tid)); const int lane=tid&63,r32=lane&31,hi=lane>>5; const int wid=__builtin_amdgcn_readfirstlane(tid>>6);
  const bf16*Qw=Qu+(long)(wid*QBLK)*QP;
  const unsigned lds0=(unsigned)(uintptr_t)shm;
  float*wsf=(float*)(shm+LDS_WS)+wid*64;
  const bf16*ksrc=Kh+(long)lane*KP+wid*8;
  const bf16*vsrc=Vh+(long)(16*(wid&3)+(lane>>2))*KP+(wid>>2)*32+(lane&3)*8;
  const unsigned kdst=lds0+LDS_K+wid*1024, vdst=lds0+LDS_V+wid*1024;
  #define DMA_K(t,slot) glds16(ksrc+(long)(t)*KVBLK*KP,(unsigned)__builtin_amdgcn_readfirstlane(kdst+(slot)))
  #define DMA_V(t,slot) glds16(vsrc+(long)(t)*KVBLK*KP,(unsigned)__builtin_amdgcn_readfirstlane(vdst+(slot)))
  const int vb0=(int)(lds0+LDS_V)+((lane>>4)&1)*32+(lane&3)*8+(4*hi+((lane&15)>>2))*64;
  const char*Kbase=shm+LDS_K; bf16x8 kf[8];
  const lds_cptr shm3=(lds_cptr)shm; const lds_cptr kp0=shm3+LDS_K+hi*1024+r32*16; const lds_cptr vp0=shm3+LDS_V+((lane>>4)&1)*32+(lane&3)*8+(4*hi+((lane&15)>>2))*64;
  DMA_K(0,0);DMA_V(0,0);DMA_K(1,SLOTB);
  bf16x8 qr[4];
  #pragma unroll
  for(int d0=0;d0<4;++d0)qr[d0]=*reinterpret_cast<const bf16x8*>(&Qw[(long)r32*QP+d0*16+hi*8]);
  float mhat=0.f,l_reg=0.f;f32x16 o[2];o[0]=f32x16{};o[1]=f32x16{};f32x16 negm=f32x16{};asm volatile("":"+v"(negm));
  #define CMASK(P0,P1,t) do{}while(0)
  bool resc=false;
  #define START(P0,P1) do{ const float rm=rowmax(P0,P1); resc=false; \
    { const float dl=rm; mhat=fadd_s(mhat,dl); \
      _Pragma("unroll") for(int r=0;r<16;++r){P0[r]=fsub_s(P0[r],dl);P1[r]=fsub_s(P1[r],dl);} \
      _Pragma("unroll") for(int r=0;r<16;++r)negm[r]=-mhat; asm volatile("":"+v"(negm)); } \
    _Pragma("unroll") for(int r=0;r<16;++r)P0[r]=__builtin_amdgcn_exp2f(P0[r]); }while(0)
  #define RESC() do{ if(resc){ asm volatile("s_waitcnt lgkmcnt(0)":::"memory"); \
      _Pragma("unroll") for(int d_=0;d_<2;++d_) _Pragma("unroll") for(int r=0;r<16;++r)o[d_][r]*=wsf[crow(r,hi)]; } }while(0)
  f32x16 pA0,pA1,pB0,pB1;
  int sl_prev=0,sl_cur=0,sl_next=SLOTB;
  #define ROT() do{sl_prev=sl_cur;sl_cur=sl_next;sl_next=(sl_next==(NSLOT-1)*SLOTB)?0:sl_next+SLOTB;}while(0)
  DMA_K(2,2*SLOTB);
  WAIT_BAR(3);
  qkt(pA0,pA1,Kbase,qr,negm,r32,hi);asm volatile("s_nop 15\n\ts_nop 7":"+v"(pA0),"+v"(pA1));CMASK(pA0,pA1,0);
  START(pA0,pA1);
  _Pragma("unroll") for(int r=0;r<16;++r)pA1[r]=__builtin_amdgcn_exp2f(pA1[r]);
  WAIT_BAR(0);
  DMA_K(3,0);DMA_V(1,SLOTB);
  ROT();
  kload8(kf,kp0+sl_cur);
  WAIT_BAR(2);
  s16x4 vlo[8],vhi[8]; u32x4 pw0,pw1,pw2,pw3;
  #define PKW(P,B) cvtpk_s(P[B],P[B+1])
  #define PAF(k) __builtin_bit_cast(bf16x8,pw##k)
  #define VFR(i) (bf16x8){vlo[i][0],vlo[i][1],vlo[i][2],vlo[i][3],vhi[i][0],vhi[i][1],vhi[i][2],vhi[i][3]}
  #define PIN(x) asm volatile("":"+v"(x))
  #define MX3(a,b,c) __builtin_fmaxf(__builtin_fmaxf((a),(b)),(c))
  #define GAPA(MF,A0,A1,A2,A3,W0,W1,PW) do{ MF; sacc+=A0; sacc+=A1; sacc+=A2; sacc+=A3; PIN(sacc); W0; W1; PIN(PW); SBAR(); }while(0)
  #define EX(v) __builtin_amdgcn_exp2f(v)
  #define GAPB(MF,X,B) do{ MF; X[B]=EX(X[B]); X[B+1]=EX(X[B+1]); X[B+2]=EX(X[B+2]); X[B+3]=EX(X[B+3]); PIN(X); SBAR(); }while(0)
  #define VRD(i) do{ vlo[i]=vtr(vp_+(((i)>>2)*4096+((i)&3)*1024)); vhi[i]=vtr(vp_+(((i)>>2)*4096+((i)&3)*1024+512)); }while(0)
  #define KRD(G,j) do{ if(G){ kload2(kf,kp0+sl_next,j); SBAR(); } }while(0)
  #define STEP(C0,C1,P0,P1,t,GK,GV,GL) do{ SBAR(); \
    const lds_cptr vp_=vp0+sl_prev; \
    VRD(0); SBAR(); float sacc=(P0[0]+P0[1]); \
    GAPA(C0=__builtin_amdgcn_mfma_f32_32x32x16_bf16(kf[0],qr[0],negm,0,0,0), P0[2],P0[3],P0[4],P0[5],     pw0[0]=PKW(P0,0), pw0[1]=PKW(P0,2), pw0); \
    VRD(4); SBAR(); GAPA(C1=__builtin_amdgcn_mfma_f32_32x32x16_bf16(kf[1],qr[0],negm,0,0,0), P0[6],P0[7],P0[8],P0[9],     pw0[2]=PKW(P0,4), pw0[3]=PKW(P0,6), pw0); \
    VRD(1); SBAR(); GAPA(C0=__builtin_amdgcn_mfma_f32_32x32x16_bf16(kf[2],qr[1],C0,0,0,0),   P0[10],P0[11],P0[12],P0[13], pw1[0]=PKW(P0,8), pw1[1]=PKW(P0,10), pw1); \
    VRD(5); SBAR(); GAPA(C1=__builtin_amdgcn_mfma_f32_32x32x16_bf16(kf[3],qr[1],C1,0,0,0),   P0[14],P0[15],P1[0],P1[1],   pw1[2]=PKW(P0,12),pw1[3]=PKW(P0,14), pw1); \
    VRD(2); SBAR(); GAPA(C0=__builtin_amdgcn_mfma_f32_32x32x16_bf16(kf[4],qr[2],C0,0,0,0),   P1[2],P1[3],P1[4],P1[5],     pw2[0]=PKW(P1,0), pw2[1]=PKW(P1,2), pw2); \
    VRD(6); SBAR(); GAPA(C1=__builtin_amdgcn_mfma_f32_32x32x16_bf16(kf[5],qr[2],C1,0,0,0),   P1[6],P1[7],P1[8],P1[9],     pw2[2]=PKW(P1,4), pw2[3]=PKW(P1,6), pw2); \
    VRD(3); SBAR(); GAPA(C0=__builtin_amdgcn_mfma_f32_32x32x16_bf16(kf[6],qr[3],C0,0,0,0),   P1[10],P1[11],P1[12],P1[13], pw3[0]=PKW(P1,8), pw3[1]=PKW(P1,10), pw3); \
    VRD(7); SBAR(); GAPA(C1=__builtin_amdgcn_mfma_f32_32x32x16_bf16(kf[7],qr[3],C1,0,0,0),   P1[14],P1[15],0.f,0.f,       pw3[2]=PKW(P1,12),pw3[3]=PKW(P1,14), pw3); \
    l_reg+=sacc; \
    if(GK){DMA_K((t)+3,sl_cur);} if(GV){DMA_V((t)+1,sl_next);} \
    CMASK(C0,C1,t); \
    { float a=MX3(C0[0],C0[1],C1[0]),b=MX3(C0[2],C0[3],C1[1]); a=MX3(a,C1[2],C1[3]); \
      _Pragma("unroll") for(int r=4;r<16;r+=4){a=MX3(a,C0[r],C0[r+1]);b=MX3(b,C0[r+2],C0[r+3]);a=MX3(a,C1[r],C1[r+1]);b=MX3(b,C1[r+2],C1[r+3]);} \
      float rm=__builtin_fmaxf(a,b); { auto rr=__builtin_amdgcn_permlane32_swap(__float_as_uint(rm),__float_as_uint(rm),false,false); rm=__builtin_fmaxf(__uint_as_float(rr[0]),__uint_as_float(rr[1])); } \
      resc=false; \
      if(__builtin_expect(__any(rm>(float)THRL),0)){ const float dl=__builtin_fmaxf(rm,0.f); mhat+=dl; \
        _Pragma("unroll") for(int r=0;r<16;++r){C0[r]-=dl;C1[r]-=dl;} \
        _Pragma("unroll") for(int r=0;r<16;++r)negm[r]=-mhat; asm volatile("":"+v"(negm)); \
        const float f=__builtin_amdgcn_exp2f(-dl); l_reg*=f; if(hi==0)wsf[r32]=f; resc=true; } } \
    SBAR(); \
    GAPB(o[0]=__builtin_amdgcn_mfma_f32_32x32x16_bf16(PAF(0),VFR(0),o[0],0,0,0), C0,0); \
    GAPB(o[1]=__builtin_amdgcn_mfma_f32_32x32x16_bf16(PAF(0),VFR(4),o[1],0,0,0), C0,4); \
    KRD(GL,0); GAPB(o[0]=__builtin_amdgcn_mfma_f32_32x32x16_bf16(PAF(1),VFR(1),o[0],0,0,0), C0,8); \
    KRD(GL,1); GAPB(o[1]=__builtin_amdgcn_mfma_f32_32x32x16_bf16(PAF(1),VFR(5),o[1],0,0,0), C0,12); \
    KRD(GL,2); GAPB(o[0]=__builtin_amdgcn_mfma_f32_32x32x16_bf16(PAF(2),VFR(2),o[0],0,0,0), C1,0); \
    KRD(GL,3); GAPB(o[1]=__builtin_amdgcn_mfma_f32_32x32x16_bf16(PAF(2),VFR(6),o[1],0,0,0), C1,4); \
    GAPB(o[0]=__builtin_amdgcn_mfma_f32_32x32x16_bf16(PAF(3),VFR(3),o[0],0,0,0), C1,8); \
    GAPB(o[1]=__builtin_amdgcn_mfma_f32_32x32x16_bf16(PAF(3),VFR(7),o[1],0,0,0), C1,12); \
    }while(0)
  int t=1;
  #undef CMASK
  #define CMASK(P0,P1,t) do{}while(0)
  for(;t+5<NT;t+=2){
    STEP(pB0,pB1,pA0,pA1,t,true,true,true);     WAIT_BAR(2); RESC(); ROT();
    STEP(pA0,pA1,pB0,pB1,t+1,true,true,true);   WAIT_BAR(2); RESC(); ROT();
  }
  #undef CMASK
  #define CMASK(P0,P1,t) do{}while(0)
  #define ENDW(tt) do{ if((tt)+3<NT){WAIT_BAR(2);} else if((tt)+2<NT){WAIT_BAR(1);} else {WAIT_BAR(0);} }while(0)
  for(;t+1<NT;t+=2){
    STEP(pB0,pB1,pA0,pA1,t,(t+3<NT),(t+1<NT),(t+1<NT));       ENDW(t);   RESC(); ROT();
    STEP(pA0,pA1,pB0,pB1,t+1,(t+4<NT),(t+2<NT),(t+2<NT));     ENDW(t+1); RESC(); ROT();
  }
  STEP(pB0,pB1,pA0,pA1,NT-1,false,false,false); RESC();
  { float sacc=pB0[0]+pB0[1]; _Pragma("unroll") for(int r=2;r<16;++r)sacc+=pB0[r]; _Pragma("unroll") for(int r=0;r<16;++r)sacc+=pB1[r]; l_reg+=sacc;
    pw0=(u32x4){PKW(pB0,0),PKW(pB0,2),PKW(pB0,4),PKW(pB0,6)};pw1=(u32x4){PKW(pB0,8),PKW(pB0,10),PKW(pB0,12),PKW(pB0,14)};pw2=(u32x4){PKW(pB1,0),PKW(pB1,2),PKW(pB1,4),PKW(pB1,6)};pw3=(u32x4){PKW(pB1,8),PKW(pB1,10),PKW(pB1,12),PKW(pB1,14)};
    SBAR(); pv(o,vb0+sl_cur,PAF(0),PAF(1),PAF(2),PAF(3)); }
  #undef PKW
  #undef PAF
  #undef VFR
  #undef PIN
  #undef MX3
  #undef GAPA
  #undef GAPB
  #undef EX
  #undef VRD
  #undef KRD
  #undef STEP
  #undef ENDW
  {auto rr=__builtin_amdgcn_permlane32_swap(__float_as_uint(l_reg),__float_as_uint(l_reg),false,false);l_reg=__uint_as_float(rr[0])+__uint_as_float(rr[1]);}
  if(hi==0)wsf[32+r32]=l_reg;asm volatile("s_waitcnt lgkmcnt(0)":::"memory");
  float rli[16];
  #pragma unroll
  for(int r=0;r<16;++r)rli[r]=__builtin_amdgcn_rcpf(wsf[32+crow(r,hi)]);
  bf16*Ow=Ou+(long)(wid*QBLK)*OP;
  { bf16*stg=(bf16*)(shm+LDS_OST)+wid*2048;
    #pragma unroll
    for(int r=0;r<16;++r){const int orow=crow(r,hi);
      #pragma unroll
      for(int d0=0;d0<2;++d0)stg[orow*64+d0*32+r32]=__float2bfloat16(o[d0][r]*rli[r]);}
    asm volatile("s_waitcnt lgkmcnt(0)":::"memory");
    #pragma unroll
    for(int i=0;i<4;++i){const int row=i*8+(lane>>3),ch=lane&7; const u32x4 v=*(const u32x4*)(stg+row*64+ch*8); ATTN_STORE16(Ow+(long)row*OP+ch*8,v);} }
  asm volatile("s_waitcnt lgkmcnt(0)\n\ts_barrier":::"memory");
  #undef DMA_K
  #undef DMA_V
  #undef CMASK
  #undef START
  #undef RESC
  #undef ROT
}
#undef SBAR
#undef WAIT_BAR
}
#define LAS __attribute__((address_space(3)))
typedef unsigned short bf16;
typedef unsigned v4u __attribute__((ext_vector_type(4)));
typedef unsigned v2u __attribute__((ext_vector_type(2)));
typedef float f32x4 __attribute__((ext_vector_type(4)));
typedef float f32x16 __attribute__((ext_vector_type(16)));
typedef short bf16x8 __attribute__((ext_vector_type(8)));
typedef LAS unsigned char lds_t;
typedef _Float16 h2 __attribute__((ext_vector_type(2)));
constexpr int NWAVES = 8, NTHR = 512;
constexpr int LDS_BYTES = 155648;
constexpr size_t MiB = 1u << 20;
constexpr size_t WS_WIN = 0, WS_WOUT = 18 * MiB, WS_W1 = 26 * MiB, WS_W2 = 58 * MiB;
constexpr size_t WS_MOD = 90 * MiB, WS_ROPE = 91 * MiB, WS_WLRU = 92 * MiB, WS_LCS = 93 * MiB, WS_XC = 96 * MiB, WS_RETC = 104 * MiB, WS_U = 138 * MiB, WS_R = 206 * MiB;
constexpr size_t R_P4 = 0, R_AQ = 68 * MiB, R_KB = 102 * MiB, R_VB = R_KB + (size_t)NB * KVL * 128 * 2, R_LX = 119 * MiB, R_LG = 136 * MiB, R_MIX = 153 * MiB, R_AD = 221 * MiB, R_END = 289 * MiB;
constexpr size_t WS_CTL = WS_R + R_END, CTL_BYTES = 65536;
constexpr size_t WS_LCS4 = WS_CTL + MiB;
constexpr size_t WS_END = WS_CTL + 7 * MiB;
static_assert(R_VB + (size_t)NB * KVL * 128 * 2 <= R_LX, "ws map");

__device__ __forceinline__ unsigned f2bf(float f) { unsigned u = __builtin_bit_cast(unsigned, f); return (u + 0x7fffu + ((u >> 16) & 1u)) >> 16; }
__device__ __forceinline__ unsigned pk2(float lo, float hi) { return f2bf(lo) | (f2bf(hi) << 16); }
__device__ __forceinline__ float bf2f(unsigned short b) { return __builtin_bit_cast(float, (unsigned)b << 16); }
__device__ __forceinline__ float bflo(unsigned w) { return __builtin_bit_cast(float, w << 16); }
__device__ __forceinline__ float bfhi(unsigned w) { return __builtin_bit_cast(float, w & 0xffff0000u); }
__device__ __forceinline__ float wave_sum(float v) {
#pragma unroll
    for (int o = 1; o < 64; o <<= 1) v += __shfl_xor(v, o);
    return v;
}
__device__ __forceinline__ float fsig(float x) { return __builtin_amdgcn_rcpf(1.0f + __expf(-x)); }
__device__ __forceinline__ int crow16(int r, int hi) { return (r & 3) + 8 * (r >> 2) + 4 * hi; }
template <int KSTEPS> __device__ __forceinline__ void mma32(f32x16& acc, const lds_t* A, int lda, const lds_t* B, int ldb, int lane) {
    const lds_t* ap = A + (lane & 31) * lda + (lane >> 5) * 16; const lds_t* bp = B + (lane & 31) * ldb + (lane >> 5) * 16;
#pragma unroll
    for (int k = 0; k < KSTEPS; ++k) acc = __builtin_amdgcn_mfma_f32_32x32x16_bf16(*(const LAS bf16x8*)(ap + 32 * k), *(const LAS bf16x8*)(bp + 32 * k), acc, 0, 0, 0);
}

#define XB_TMO      128
#define XB_XCNT(j)  (256  + 64 * (j))
#define XB_XSUB(j)  (1280 + 64 * (j))
#define XB_XGEN(j)  (2304 + 64 * (j))
#define XB_TOP      3328
#define XB_TOPGEN   3392
#define XCD_BAR_WORDS 3456
#define XB_SPIN_CAP (1u << 18)

__device__ __forceinline__ unsigned xb_ld(unsigned* p)              { return __hip_atomic_load(p, __ATOMIC_RELAXED, __HIP_MEMORY_SCOPE_AGENT); }
__device__ __forceinline__ unsigned xb_add(unsigned* p, unsigned v) { return __hip_atomic_fetch_add(p, v, __ATOMIC_RELAXED, __HIP_MEMORY_SCOPE_AGENT); }
__device__ __forceinline__ unsigned xb_xcc_id() { return (unsigned)__builtin_amdgcn_s_getreg((3 << 11) | 20) & 0xFu; }
#define XB_SPIN(cond, bar) do { unsigned _sp = 0; while (cond) { __builtin_amdgcn_s_sleep(1); \
    if ((++_sp & 255u) == 0u) { if (xb_ld(&(bar)[XB_TMO])) break; if (_sp > XB_SPIN_CAP) { atomicAdd(&(bar)[XB_TMO], 1u); break; } } } } while (0)

struct XcdBarrier {
    unsigned* bar; unsigned x;
    volatile LAS unsigned* st;
};

__device__ __forceinline__ XcdBarrier xcd_barrier_post(unsigned* bar, volatile LAS unsigned* st) {
    XcdBarrier b; b.bar = bar; b.x = xb_xcc_id(); b.st = st;
    if (threadIdx.x == 0) (void)xb_add(&bar[XB_XCNT(b.x)], 1u);
    return b;
}
__device__ __forceinline__ void xcd_barrier_complete(unsigned* bar, unsigned x, unsigned& nloc, unsigned& nx) {
    const unsigned G = gridDim.x * gridDim.y * gridDim.z;
    unsigned sum, cnt, mine, sp = 0u;
    for (;;) {
        sum = 0u; cnt = 0u; mine = 0u;
#pragma unroll
        for (unsigned j = 0; j < 16; ++j) { const unsigned c = xb_ld(&bar[XB_XCNT(j)]); sum += c; cnt += (c > 0u) ? 1u : 0u; mine = (j == x) ? c : mine; }
        if (sum == G) break;
        __builtin_amdgcn_s_sleep(1);
        if ((++sp & 255u) == 0u) { if (xb_ld(&bar[XB_TMO])) break; if (sp > XB_SPIN_CAP) { atomicAdd(&bar[XB_TMO], 1u); break; } }
    }
    nloc = mine > 0u ? mine : 1u; nx = cnt > 0u ? cnt : 1u;
}

__device__ __forceinline__ void xcd_barrier(const XcdBarrier& b) {
    asm volatile("s_waitcnt vmcnt(0)" ::: "memory");
    __syncthreads();
    if (threadIdx.x == 0) {
        unsigned* bar = b.bar;
        __builtin_amdgcn_s_waitcnt(0);
        unsigned nloc = b.st[0], nx = b.st[1];
        if (nloc == 0u) { xcd_barrier_complete(bar, b.x, nloc, nx); b.st[0] = nloc; b.st[1] = nx; }
        const unsigned old = xb_add(&bar[XB_XSUB(b.x)], 1u);
        const unsigned gen = old / nloc;
        if (old + 1u == (gen + 1u) * nloc) {
            __builtin_amdgcn_fence(__ATOMIC_RELEASE, "agent");
            asm volatile("s_waitcnt vmcnt(0)" ::: "memory");
            const unsigned og = xb_add(&bar[XB_TOP], 1u);
            const unsigned tg = og / nx;
            if (og + 1u == (tg + 1u) * nx) xb_add(&bar[XB_TOPGEN], 1u);
            else XB_SPIN(xb_ld(&bar[XB_TOPGEN]) == tg, bar);
            __builtin_amdgcn_fence(__ATOMIC_ACQUIRE, "agent");
            xb_add(&bar[XB_XGEN(b.x)], 1u);
            asm volatile("s_waitcnt vmcnt(0)" ::: "memory");
        } else {
            XB_SPIN(xb_ld(&bar[XB_XGEN(b.x)]) == gen, bar);
            __builtin_amdgcn_fence(__ATOMIC_ACQUIRE, "agent");
            asm volatile("s_waitcnt vmcnt(0)" ::: "memory");
        }
    }
    __syncthreads();
}

struct Args {
    const float *x, *c, *ctx, *c_ctx, *w_ada, *b_ada, *w_in, *ret_decay, *q_gain, *k_gain, *conv_w, *conv_b, *lru_wa, *lru_ba, *lru_wx, *lru_bx, *lru_lam, *w_out, *ln1_g, *ln1_b, *w_ff1, *w_ff2, *ln2_g, *ln2_b;
    float* out; unsigned char* ws;
};

template <bool PERMIN> __device__ __forceinline__ void transpose_item(const float* W, int K, int N, bf16* WT, LAS float* scr, int item, int lane) {
    const int nblk = N / 32, kb = item / nblk, nb = item % nblk, k0 = 64 * kb, n0 = 32 * nb;
#pragma unroll 8
    for (int i = 0; i < 32; ++i) { const int kk = 2 * i + (lane >> 5); scr[kk * 33 + (lane & 31)] = __builtin_nontemporal_load(W + (size_t)(k0 + kk) * N + n0 + (lane & 31)); }
    asm volatile("s_waitcnt lgkmcnt(0)" ::: "memory");
    int r0 = n0;
    if (PERMIN) { const int cl = n0 & 255; r0 = (n0 & ~255) + 128 * ((cl >> 5) & 1) + 32 * (cl >> 6); }
    const int c = lane & 7;
#pragma unroll
    for (int j = 0; j < 4; ++j) { const int n = (lane >> 3) + 8 * j; const LAS float* s = scr + (8 * c) * 33 + n;
        v4u o; o.x = pk2(s[0 * 33], s[1 * 33]); o.y = pk2(s[2 * 33], s[3 * 33]); o.z = pk2(s[4 * 33], s[5 * 33]); o.w = pk2(s[6 * 33], s[7 * 33]);
        *(v4u*)(WT + (size_t)(r0 + n) * K + k0 + 8 * c) = o; }
    asm volatile("s_waitcnt lgkmcnt(0)" ::: "memory");
}

__device__ __forceinline__ void modulate_rows(const Args& a, const float* mod0, bf16* U, int gw, int ngw, int lane) {
    for (int m = gw; m < MT; m += ngw) {
        const bool lat = m < ML; const int bb = lat ? (m >> 12) : 8;
        const float* xr = lat ? a.x + (size_t)m * DM : a.ctx + (size_t)(m - ML) * DM;
        const float* mp = mod0 + (size_t)bb * 6144;
#pragma unroll
        for (int j = 0; j < 4; ++j) { const int col = 4 * (lane + 64 * j); const f32x4 v = *(const f32x4*)(xr + col), sh = *(const f32x4*)(mp + col), sc = *(const f32x4*)(mp + 1024 + col);
            const f32x4 o = v * (sc + 1.0f) + sh; v2u w; w.x = pk2(o[0], o[1]); w.y = pk2(o[2], o[3]); *(v2u*)(U + (size_t)m * DM + col) = w; }
    }
}
template <int NR> __device__ __forceinline__ void ln_lat_body(float* xL, const float* g, const float* b, const float* modp, bf16* U, int m0, int ngw, int lane, float* dummy, const bf16* vin, bf16* xB) {
    {
        f32x4 v[NR][4]; float s[NR], s2[NR];
#pragma unroll
        for (int q = 0; q < NR; ++q)
#pragma unroll
            for (int jj = 0; jj < 2; ++jj) { const size_t o_ = (size_t)(m0 + q * ngw) * DM + 8 * lane + 512 * jj;
                if (vin) { const v4u w = __builtin_nontemporal_load((const v4u*)(vin + o_)); v[q][2 * jj] = (f32x4){bflo(w.x), bfhi(w.x), bflo(w.y), bfhi(w.y)}; v[q][2 * jj + 1] = (f32x4){bflo(w.z), bfhi(w.z), bflo(w.w), bfhi(w.w)}; }
                else { v[q][2 * jj] = *(const f32x4*)(xL + o_); v[q][2 * jj + 1] = *(const f32x4*)(xL + o_ + 4); } }
#pragma unroll
        for (int q = 0; q < NR; ++q) { s[q] = 0.f;
#pragma unroll
            for (int j = 0; j < 4; ++j) s[q] += (v[q][j][0] + v[q][j][1]) + (v[q][j][2] + v[q][j][3]); }
#pragma unroll
        for (int o = 1; o < 64; o <<= 1) {
#pragma unroll
            for (int q = 0; q < NR; ++q) s[q] += __shfl_xor(s[q], o); }
#pragma unroll
        for (int q = 0; q < NR; ++q) { const float mean = s[q] * (1.0f / DM); s2[q] = 0.f;
#pragma unroll
            for (int j = 0; j < 4; ++j) { v[q][j] = v[q][j] - mean; s2[q] += (v[q][j][0] * v[q][j][0] + v[q][j][1] * v[q][j][1]) + (v[q][j][2] * v[q][j][2] + v[q][j][3] * v[q][j][3]); } }
#pragma unroll
        for (int o = 1; o < 64; o <<= 1) {
#pragma unroll
            for (int q = 0; q < NR; ++q) s2[q] += __shfl_xor(s2[q], o); }
#pragma unroll
        for (int jj = 0; jj < 2; ++jj) { const int col = 8 * lane + 512 * jj;
            const f32x4 g0 = *(const f32x4*)(g + col), g1 = *(const f32x4*)(g + col + 4), b0 = *(const f32x4*)(b + col), b1 = *(const f32x4*)(b + col + 4);
#pragma unroll
            for (int q = 0; q < NR; ++q) { const int m = m0 + q * ngw; const float rstd = rsqrtf(s2[q] * (1.0f / DM) + EPSN);
                const f32x4 o0 = v[q][2 * jj] * rstd * g0 + b0, o1 = v[q][2 * jj + 1] * rstd * g1 + b1;
                if (xB) { v4u wx; wx.x = pk2(o0[0], o0[1]); wx.y = pk2(o0[2], o0[3]); wx.z = pk2(o1[0], o1[1]); wx.w = pk2(o1[2], o1[3]); __builtin_nontemporal_store(wx, (v4u*)(xB + (size_t)m * DM + col)); }
                else { float* xo = (dummy ? dummy : xL) + (size_t)m * DM + col; *(f32x4*)xo = o0; *(f32x4*)(xo + 4) = o1; }
                if (modp) { const float* mp = modp + (size_t)(m >> 12) * 6144 + col; const f32x4 u0 = o0 * (*(const f32x4*)(mp + 1024) + 1.0f) + *(const f32x4*)mp, u1 = o1 * (*(const f32x4*)(mp + 1024 + 4) + 1.0f) + *(const f32x4*)(mp + 4);
                    v4u w; w.x = pk2(u0[0], u0[1]); w.y = pk2(u0[2], u0[3]); w.z = pk2(u1[0], u1[1]); w.w = pk2(u1[2], u1[3]); *(v4u*)(U + (size_t)m * DM + col) = w; } } }
    }
}
__device__ __forceinline__ void ln_rows_lat(float* xL, const float* g, const float* b, const float* modp, bf16* U, int gw, int ngw, int lane, float* dummy, const bf16* vin, bf16* xB) {
    int m0 = gw;
    for (; m0 + 3 * ngw < ML; m0 += 4 * ngw) ln_lat_body<4>(xL, g, b, modp, U, m0, ngw, lane, dummy, vin, xB);
    for (; m0 < ML; m0 += ngw) ln_lat_body<1>(xL, g, b, modp, U, m0, ngw, lane, dummy, vin, xB);
}
__device__ __forceinline__ void ln_rows_ctx(float* xC, const float* xCin, const float* g, const float* b, const float* modp, bf16* U, int gw, int ngw, int lane, const float* part, const float* gate8, int nsplit) {
    for (int r = gw; r < MC; r += ngw) {
        f32x4 v[4]; float s = 0.f;
#pragma unroll
        for (int j = 0; j < 4; ++j) { const int col = 4 * (lane + 64 * j); v[j] = *(const f32x4*)(xCin + (size_t)r * DM + col);
            if (part) { const bf16* pp = (const bf16*)part + (size_t)r * DM + col; f32x4 ps = {0.f, 0.f, 0.f, 0.f};
                for (int k = 0; k < nsplit; ++k) { const v2u w = *(const v2u*)(pp + (size_t)k * 2048 * 1024); ps = ps + (f32x4){bflo(w.x), bfhi(w.x), bflo(w.y), bfhi(w.y)}; }
                v[j] = v[j] * ALPHA + *(const f32x4*)(gate8 + col) * ps; }
            s += (v[j][0] + v[j][1]) + (v[j][2] + v[j][3]); }
        const float mean = wave_sum(s) * (1.0f / DM); float s2 = 0.f;
#pragma unroll
        for (int j = 0; j < 4; ++j) { v[j] = v[j] - mean; s2 += (v[j][0] * v[j][0] + v[j][1] * v[j][1]) + (v[j][2] * v[j][2] + v[j][3] * v[j][3]); }
        const float rstd = rsqrtf(wave_sum(s2) * (1.0f / DM) + EPSN);
#pragma unroll
        for (int j = 0; j < 4; ++j) { const int col = 4 * (lane + 64 * j); const f32x4 o = v[j] * rstd * *(const f32x4*)(g + col) + *(const f32x4*)(b + col);
            *(f32x4*)(xC + (size_t)r * DM + col) = o;
            if (modp) { const float* mp = modp + (size_t)8 * 6144; const f32x4 sh = *(const f32x4*)(mp + col), sc = *(const f32x4*)(mp + 1024 + col); const f32x4 uu = o * (sc + 1.0f) + sh;
                v2u w; w.x = pk2(uu[0], uu[1]); w.y = pk2(uu[2], uu[3]); *(v2u*)(U + (size_t)(ML + r) * DM + col) = w; } }
    }
}
__device__ __forceinline__ void ln_rows(float* xL, float* xC, int mrows, const float* g, const float* b, const float* modp, bf16* U, int gw, int ngw, int lane, float* dummy = nullptr, const float* part = nullptr, const float* gate8 = nullptr, const float* xCin = nullptr, const bf16* vin = nullptr, bf16* xB = nullptr, int nsplit = 4) {
    ln_rows_lat(xL, g, b, modp, U, gw, ngw, lane, dummy, vin, xB);
    if (mrows > ML && !dummy) ln_rows_ctx(xC, xCin ? xCin : xC, g, b, modp, U, gw, ngw, lane, part, gate8, nsplit);
}

__device__ __forceinline__ int chunk_row0(int b, int c) { return c < 32 ? b * SEQ + c * 128 : ML + b * CTXL + (c - 32) * 128; }
__device__ __forceinline__ float log_sigmoid(float x) { return fminf(x, 0.f) - log1pf(expf(-fabsf(x))); }
constexpr int RT_LDK = 272;
constexpr int RT_LDD = 144;
__device__ __forceinline__ void ret_contrib_unit(int unit, const bf16* RK, const bf16* RV, const float* decay_l, float* RETC, lds_t* lds, int tid, int lane, int wave) {
    const int c = unit % 34, bh = unit / 34, h = bh & 3, b = bh >> 2; const int m0 = chunk_row0(b, c);
    lds_t* Kft = lds; lds_t* Kbt = lds + 64 * RT_LDK; lds_t* Vt = lds + 128 * RT_LDK;
    const float lgf = log_sigmoid(decay_l[h]), lgb = log_sigmoid(decay_l[4 + h]);
    { const int j = tid >> 2, d0 = (tid & 3) * 16; const float wf = __expf(lgf * (float)(127 - j)), wb = __expf(lgb * (float)j);
        const v4u* kp = (const v4u*)(RK + (size_t)(m0 + j) * 256 + h * 64 + d0); const v4u* vp = (const v4u*)(RV + (size_t)(m0 + j) * 256 + h * 64 + d0);
#pragma unroll
        for (int q = 0; q < 2; ++q) { const v4u kw = kp[q], vw = vp[q];
#pragma unroll
            for (int e = 0; e < 4; ++e) { const unsigned kk = kw[e], vv = vw[e]; const int d = d0 + q * 8 + 2 * e; const float k0 = bflo(kk), k1 = bfhi(kk);
                *(LAS unsigned short*)(Kft + d * RT_LDK + j * 2) = (unsigned short)f2bf(k0 * wf); *(LAS unsigned short*)(Kft + (d + 1) * RT_LDK + j * 2) = (unsigned short)f2bf(k1 * wf);
                *(LAS unsigned short*)(Kbt + d * RT_LDK + j * 2) = (unsigned short)f2bf(k0 * wb); *(LAS unsigned short*)(Kbt + (d + 1) * RT_LDK + j * 2) = (unsigned short)f2bf(k1 * wb);
                *(LAS unsigned short*)(Vt + d * RT_LDK + j * 2) = (unsigned short)(vv & 0xffffu); *(LAS unsigned short*)(Vt + (d + 1) * RT_LDK + j * 2) = (unsigned short)(vv >> 16); } } }
    __syncthreads();
    { const int dir = wave >> 2, dt = (wave >> 1) & 1, vt = wave & 1; f32x16 acc = {};
        mma32<8>(acc, (dir ? Kbt : Kft) + 32 * dt * RT_LDK, RT_LDK, Vt + 32 * vt * RT_LDK, RT_LDK, lane);
        float* dst = RETC + ((size_t)unit * 2 + dir) * 4096 + (32 * vt + (lane & 31));
#pragma unroll
        for (int r = 0; r < 16; ++r) dst[(size_t)(32 * dt + crow16(r, lane >> 5)) * 64] = acc[r]; }
    __syncthreads();
}
__device__ __forceinline__ void ret_prefix_phase(float* RETC, const float* decay_l, int gt, int ngt) {
    for (int i = gt; i < 32 * 2 * 4096; i += ngt) { const int e = i & 4095, dir = (i >> 12) & 1, bh = i >> 13, h = bh & 3;
        const float G = __expf(log_sigmoid(decay_l[dir * 4 + h]) * 128.f); float* base = RETC + (size_t)bh * 34 * 8192 + dir * 4096 + e;
        float cv[34];
#pragma unroll
        for (int x = 0; x < 34; ++x) cv[x] = base[(size_t)x * 8192];
        float s = 0.f;
        if (dir == 0) {
#pragma unroll
            for (int k = 0; k < 34; ++k) { const int x = k < 2 ? 32 + k : k - 2; base[(size_t)x * 8192] = s; s = s * G + cv[x]; } }
        else {
#pragma unroll
            for (int k = 0; k < 34; ++k) { const int x = 33 - k; base[(size_t)x * 8192] = s; s = s * G + cv[x]; } }
    }
}
__device__ __forceinline__ void ret_out_unit(int unit, const bf16* RQ, const bf16* RK, const bf16* RV, const bf16* RG, const float* decay_l, const float* RETC, bf16* MIX, lds_t* lds, int tid, int lane, int wave) {
    const int c = unit % 34, bh = unit / 34, h = bh & 3, b = bh >> 2; const int m0 = chunk_row0(b, c);
    lds_t* Qs = lds; lds_t* Ks = Qs + 128 * RT_LDD; lds_t* Vt = Ks + 128 * RT_LDD; lds_t* Sft = Vt + 64 * RT_LDK; lds_t* Sbt = Sft + 64 * RT_LDD; lds_t* Ws = Sbt + 64 * RT_LDD;
    const float lgf = log_sigmoid(decay_l[h]), lgb = log_sigmoid(decay_l[4 + h]);
    { const float* base = RETC + ((size_t)bh * 34 + c) * 2 * 4096 + tid * 8;
        const f32x4 sf0 = *(const f32x4*)base, sf1 = *(const f32x4*)(base + 4), sb0 = *(const f32x4*)(base + 4096), sb1 = *(const f32x4*)(base + 4096 + 4);
        const int d = tid >> 3, v0 = (tid & 7) * 8;
#pragma unroll
        for (int e = 0; e < 4; ++e) { *(LAS unsigned short*)(Sft + (v0 + e) * RT_LDD + d * 2) = (unsigned short)f2bf(sf0[e]); *(LAS unsigned short*)(Sft + (v0 + 4 + e) * RT_LDD + d * 2) = (unsigned short)f2bf(sf1[e]);
            *(LAS unsigned short*)(Sbt + (v0 + e) * RT_LDD + d * 2) = (unsigned short)f2bf(sb0[e]); *(LAS unsigned short*)(Sbt + (v0 + 4 + e) * RT_LDD + d * 2) = (unsigned short)f2bf(sb1[e]); } }
    { const int j = tid >> 2, d0 = (tid & 3) * 16; const size_t go = (size_t)(m0 + j) * 256 + h * 64 + d0;
        const v4u* qp = (const v4u*)(RQ + go); const v4u* kp = (const v4u*)(RK + go); const v4u* vp = (const v4u*)(RV + go);
#pragma unroll
        for (int q = 0; q < 2; ++q) { *(LAS v4u*)(Qs + j * RT_LDD + (d0 + 8 * q) * 2) = qp[q]; *(LAS v4u*)(Ks + j * RT_LDD + (d0 + 8 * q) * 2) = kp[q]; const v4u vw = vp[q];
#pragma unroll
            for (int e = 0; e < 4; ++e) { const unsigned vv = vw[e]; const int d = d0 + q * 8 + 2 * e;
                *(LAS unsigned short*)(Vt + d * RT_LDK + j * 2) = (unsigned short)(vv & 0xffffu); *(LAS unsigned short*)(Vt + (d + 1) * RT_LDK + j * 2) = (unsigned short)(vv >> 16); } } }
    __syncthreads();
#pragma unroll
    for (int tt = 0; tt < 2; ++tt) { const int tile = wave * 2 + tt, it = tile >> 2, jt = tile & 3; f32x16 acc = {};
        mma32<4>(acc, Qs + 32 * it * RT_LDD, RT_LDD, Ks + 32 * jt * RT_LDD, RT_LDD, lane);
        const int j = 32 * jt + (lane & 31);
#pragma unroll
        for (int r = 0; r < 16; ++r) { const int i = 32 * it + crow16(r, lane >> 5); const float dd = (float)(i - j); const float w = acc[r] * __expf(dd >= 0.f ? lgf * dd : -lgb * dd);
            *(LAS unsigned short*)(Ws + i * RT_LDK + j * 2) = (unsigned short)f2bf(w); } }
    __syncthreads();
    f32x16 o;
    { const int it = wave >> 1, vt = wave & 1; f32x16 a1 = {}, a2 = {}, a3 = {};
        mma32<8>(a1, Ws + 32 * it * RT_LDK, RT_LDK, Vt + 32 * vt * RT_LDK, RT_LDK, lane);
        mma32<4>(a2, Qs + 32 * it * RT_LDD, RT_LDD, Sft + 32 * vt * RT_LDD, RT_LDD, lane);
        mma32<4>(a3, Qs + 32 * it * RT_LDD, RT_LDD, Sbt + 32 * vt * RT_LDD, RT_LDD, lane);
#pragma unroll
        for (int r = 0; r < 16; ++r) { const int i = 32 * it + crow16(r, lane >> 5); o[r] = a1[r] + __expf(lgf * (float)(i + 1)) * a2[r] + __expf(lgb * (float)(128 - i)) * a3[r]; } }
    __syncthreads();
    { const int it = wave >> 1, vt = wave & 1; LAS float* Os = (LAS float*)Ws;
#pragma unroll
        for (int r = 0; r < 16; ++r) Os[(32 * it + crow16(r, lane >> 5)) * 65 + 32 * vt + (lane & 31)] = o[r]; }
    __syncthreads();
    { const int i = tid >> 2, c0 = (tid & 3) * 16; const LAS float* Os = (const LAS float*)Ws + i * 65 + c0; float vals[16]; float ss = 0.f;
#pragma unroll
        for (int e = 0; e < 16; ++e) { vals[e] = Os[e]; ss += vals[e] * vals[e]; }
        ss += __shfl_xor(ss, 1); ss += __shfl_xor(ss, 2);
        const float rs = rsqrtf(ss * (1.0f / 64.0f) + EPSN);
        const v4u* gp = (const v4u*)(RG + (size_t)(m0 + i) * 256 + h * 64 + c0); bf16* dst = MIX + (size_t)(m0 + i) * DM + h * 64 + c0;
#pragma unroll
        for (int q = 0; q < 2; ++q) { const v4u gw = gp[q]; v4u ow;
#pragma unroll
            for (int e = 0; e < 4; ++e) ow[e] = pk2(vals[q * 8 + 2 * e] * rs * bflo(gw[e]), vals[q * 8 + 2 * e + 1] * rs * bfhi(gw[e]));
            *(v4u*)(dst + 8 * q) = ow; } }
    __syncthreads();
}

constexpr int LR_LDX = 528;
__device__ __forceinline__ void lru_pass1_unit(int cu4, const Args& a, int l, const bf16* LX, const bf16* WLRU, h2* AD, float2* LCS4, lds_t* lds, int tid, int lane, int wave) {
    const int cu = cu4 >> 2, rt0 = cu4 & 3;
    const int b = cu < 256 ? cu >> 5 : (cu - 256) >> 1, c = cu < 256 ? cu & 31 : 32 + ((cu - 256) & 1);
    const int m0 = chunk_row0(b, c), ms = c < 32 ? b * SEQ : ML + b * CTXL, me = ms + (c < 32 ? SEQ : CTXL);
    lds_t* XR = lds; LAS h2* ADL = (LAS h2*)(lds + 128 * LR_LDX);
    { const int w8 = (tid & 31) * 8, tr = tid >> 5; float cw[4][8], cb[8];
#pragma unroll
        for (int j = 0; j < 4; ++j)
#pragma unroll
            for (int e = 0; e < 8; ++e) cw[j][e] = a.conv_w[(size_t)l * 1024 + j * 256 + w8 + e];
#pragma unroll
        for (int e = 0; e < 8; ++e) cb[e] = a.conv_b[l * 256 + w8 + e];
        for (int i = 0; i < 2; ++i) { const int t = 32 * rt0 + tr + 16 * i; float acc[8];
#pragma unroll
            for (int e = 0; e < 8; ++e) acc[e] = cb[e];
#pragma unroll
            for (int j = 0; j < 4; ++j) { const int m = m0 + t + j - 2;
                if (m >= ms && m < me) { const v4u xv = *(const v4u*)(LX + (size_t)m * 256 + w8);
#pragma unroll
                    for (int e = 0; e < 4; ++e) { acc[2 * e] += bflo(xv[e]) * cw[j][2 * e]; acc[2 * e + 1] += bfhi(xv[e]) * cw[j][2 * e + 1]; } } }
            v4u ow;
#pragma unroll
            for (int e = 0; e < 4; ++e) ow[e] = pk2(acc[2 * e], acc[2 * e + 1]);
            *(LAS v4u*)(XR + (t & 31) * LR_LDX + w8 * 2) = ow; } }
    __syncthreads();
    const int k = wave & 3, dir = wave >> 2;
    float ba[2], bx[2], lsl[2];
#pragma unroll
    for (int ct = 0; ct < 2; ++ct) { const int ch = 64 * k + 32 * ct + (lane & 31); ba[ct] = a.lru_ba[(l * 2 + dir) * 256 + ch]; bx[ct] = a.lru_bx[(l * 2 + dir) * 256 + ch]; lsl[ct] = 8.0f * log_sigmoid(a.lru_lam[(l * 2 + dir) * 256 + ch]); }
    float At = 1.f, Ht = 0.f;
    for (int rt = rt0; rt < rt0 + 1; ++rt) {
        bf16x8 af[4];
#pragma unroll
        for (int ks = 0; ks < 4; ++ks) af[ks] = *(const LAS bf16x8*)(XR + (lane & 31) * LR_LDX + (64 * k + 16 * ks + 8 * (lane >> 5)) * 2);
#pragma unroll
        for (int ct = 0; ct < 2; ++ct) { f32x16 ga = {}, gx = {};
#pragma unroll
            for (int ks = 0; ks < 4; ++ks) { const bf16* wb = WLRU + (((size_t)(l * 2 + dir) * 2 * 4 + k) * 64 + 32 * ct + (lane & 31)) * 64 + 16 * ks + 8 * (lane >> 5);
                ga = __builtin_amdgcn_mfma_f32_32x32x16_bf16(af[ks], *(const bf16x8*)wb, ga, 0, 0, 0); gx = __builtin_amdgcn_mfma_f32_32x32x16_bf16(af[ks], *(const bf16x8*)(wb + 4 * 4096), gx, 0, 0, 0); }
            const int ch = 64 * k + 32 * ct + (lane & 31);
#pragma unroll
            for (int r = 0; r < 16; ++r) { const int row = crow16(r, lane >> 5);
                const float rg = fsig(ga[r] + ba[ct]), ig = fsig(gx[r] + bx[ct]); const float la = lsl[ct] * rg;
                const float a_ = __expf(la); const float oma = 1.0f - a_, dr = __builtin_amdgcn_sqrtf(oma * (1.0f + a_)) * ig * bf2f(*(const LAS unsigned short*)(XR + row * LR_LDX + ch * 2));
                h2 hv; hv[0] = (_Float16)oma; hv[1] = (_Float16)dr;
                ADL[row * 512 + dir * 256 + ch] = hv; AD[((size_t)(m0 + 32 * rt + row) * 2 + dir) * 256 + ch] = hv; } }
        __syncthreads();
        { const int sd = tid >> 8, sc = tid & 255; float A = 1.f, H = 0.f;
            h2 fr_[32];
#pragma unroll
            for (int r = 0; r < 32; ++r) fr_[r] = ADL[r * 512 + sd * 256 + sc];
            if (sd == 0) {
#pragma unroll
                for (int r = 0; r < 32; ++r) { const float aa = 1.0f - (float)fr_[r][0]; H = aa * H + (float)fr_[r][1]; A *= aa; }
                Ht = A * Ht + H; At = A * At; }
            else {
#pragma unroll
                for (int r = 31; r >= 0; --r) { const float aa = 1.0f - (float)fr_[r][0]; H = aa * H + (float)fr_[r][1]; A *= aa; }
                Ht = At * H + Ht; At = At * A; } }
        __syncthreads();
    }
    LCS4[(((size_t)(b * 34 + c) * 4 + rt0) * 2 + (tid >> 8)) * 256 + (tid & 255)] = make_float2(At, Ht);
}
__device__ __forceinline__ void lru_compose_phase(const float2* LCS4, float2* LCS, int gt, int ngt) {
    for (int i = gt; i < NB * 34 * 2 * 256; i += ngt) { const int ch = i & 255, dir = (i >> 8) & 1, bc = i >> 9; float2 s[4];
#pragma unroll
        for (int rt = 0; rt < 4; ++rt) s[rt] = LCS4[(((size_t)bc * 4 + rt) * 2 + dir) * 256 + ch];
        float A = 1.f, h = 0.f;
#pragma unroll
        for (int k = 0; k < 4; ++k) { const float2 t = s[dir ? 3 - k : k]; h = t.x * h + t.y; A *= t.x; }
        LCS[i] = make_float2(A, h); }
}
__device__ __forceinline__ void lru_pass2_unit(int cu, const h2* AD, const float2* LCS, const bf16* LG, bf16* MIX, lds_t* lds, int tid) {
    const int b = cu < 256 ? cu >> 5 : (cu - 256) >> 1, c = cu < 256 ? cu & 31 : 32 + ((cu - 256) & 1);
    const int m0 = chunk_row0(b, c); const int dir = tid >> 8, ch = tid & 255;
    LAS _Float16* HS = (LAS _Float16*)lds;
    float h = 0.f;
    const float2* cs = LCS + (size_t)b * 34 * 512 + dir * 256 + ch;
    const int n = dir == 0 ? (c < 32 ? c + 2 : c - 32) : 33 - c;
    for (int i0 = 0; i0 < n; i0 += 8) { float2 s[8];
#pragma unroll
        for (int j = 0; j < 8; ++j) { const int ii = (i0 + j < n) ? i0 + j : 0; const int cc = dir == 0 ? (ii < 2 ? 32 + ii : ii - 2) : 33 - ii; s[j] = cs[(size_t)cc * 512]; }
#pragma unroll
        for (int j = 0; j < 8; ++j) if (i0 + j < n) h = s[j].x * h + s[j].y; }
    const h2* ad = AD + ((size_t)m0 * 2 + dir) * 256 + ch;
#pragma unroll 1
    for (int r0 = 0; r0 < 128; r0 += 16) { h2 f[16];
#pragma unroll
        for (int j = 0; j < 16; ++j) { const int r = dir == 0 ? r0 + j : 127 - (r0 + j); f[j] = ad[(size_t)r * 512]; }
#pragma unroll
        for (int j = 0; j < 16; ++j) { const int r = dir == 0 ? r0 + j : 127 - (r0 + j); h = (1.0f - (float)f[j][0]) * h + (float)f[j][1]; HS[r * 512 + dir * 256 + ch] = (_Float16)h; } }
    __syncthreads();
    { typedef _Float16 h8 __attribute__((ext_vector_type(8))); const int c8 = (tid & 31) * 8;
#pragma unroll 4
        for (int i = 0; i < 8; ++i) { const int r = (tid >> 5) + 16 * i; const h8 hf = *(const LAS h8*)(HS + r * 512 + c8), hb = *(const LAS h8*)(HS + r * 512 + 256 + c8);
            const v4u g = *(const v4u*)(LG + (size_t)(m0 + r) * 256 + c8); v4u o;
#pragma unroll
            for (int e = 0; e < 4; ++e) o[e] = pk2(((float)hf[2 * e] + (float)hb[2 * e]) * bflo(g[e]), ((float)hf[2 * e + 1] + (float)hb[2 * e + 1]) * bfhi(g[e]));
            *(v4u*)(MIX + (size_t)(m0 + r) * DM + 768 + c8) = o; } }
    __syncthreads();
}
#ifndef REP_G1N
#define REP_G1N 1
#endif
#ifndef REP_G4E
#define REP_G4E 1
#endif
#ifndef REP_P0
#define REP_P0 1
#endif
#ifndef REP_G4
#define REP_G4 1
#endif
#ifndef REP_G7
#define REP_G7 1
#endif
#ifndef REP_LN
#define REP_LN 1
#endif
#ifndef REP_SYNC
#define REP_SYNC 0
#endif
#ifndef REP_G1
#define REP_G1 1
#endif
#ifndef REP_S2
#define REP_S2 1
#endif
#ifndef REP_ATT
#define REP_ATT 1
#endif
#ifndef REP_R2
#define REP_R2 1
#endif
#ifndef REP_L2
#define REP_L2 1
#endif
#ifndef REP_G6
#define REP_G6 1
#endif
__global__ void __launch_bounds__(NTHR, 2) trunk_fwd(Args a) {
    extern __shared__ __attribute__((aligned(16))) unsigned char lds_raw[];
    cg::grid_group grid = cg::this_grid();
    lds_t* lds = (lds_t*)lds_raw;
    const int tid = threadIdx.x;
    const int G = gridDim.x, bx = blockIdx.x;
    const int vcu = (G % 8 == 0) ? (bx % 8) * (G / 8) + bx / 8 : bx;
    const int ngw = G * NWAVES;
    unsigned char* ws = a.ws;
    volatile LAS unsigned* bst = (volatile LAS unsigned*)(lds + LDS_BYTES - 64);
    if (threadIdx.x == 0) { bst[0] = 0u; bst[1] = 0u; }
    __syncthreads();
    (void)xcd_barrier_post((unsigned*)(ws + WS_CTL), bst);
#define GRID_BAR() do { XcdBarrier b_; b_.bar = (unsigned*)(a.ws + WS_CTL); b_.x = xb_xcc_id(); b_.st = (volatile LAS unsigned*)(lds + LDS_BYTES - 64); xcd_barrier(b_); } while (0)
    bf16* WT_IN = (bf16*)(ws + WS_WIN); bf16* WT_OUT = (bf16*)(ws + WS_WOUT); bf16* WT_1 = (bf16*)(ws + WS_W1); bf16* WT_2 = (bf16*)(ws + WS_W2);
    float* MOD = (float*)(ws + WS_MOD); float* ROPE = (float*)(ws + WS_ROPE); bf16* WLRU = (bf16*)(ws + WS_WLRU); float2* LCS = (float2*)(ws + WS_LCS);
    float* XC = (float*)(ws + WS_XC); float* RETC = (float*)(ws + WS_RETC); bf16* U = (bf16*)(ws + WS_U);
    unsigned char* R = ws + WS_R;
    float2* LCS4 = (float2*)(ws + WS_LCS4);
    bf16* P4 = (bf16*)(R + R_P4); bf16* RQ = P4; bf16* RK = P4 + (size_t)MT * 256; bf16* RV = P4 + (size_t)2 * MT * 256; bf16* RG = P4 + (size_t)3 * MT * 256;
    bf16* AQ = (bf16*)(R + R_AQ); bf16* KB = (bf16*)(R + R_KB); bf16* VB = (bf16*)(R + R_VB); bf16* LX = (bf16*)(R + R_LX); bf16* LG = (bf16*)(R + R_LG);
    bf16* MIX = (bf16*)(R + R_MIX); h2* AD = (h2*)(R + R_AD); bf16* H = (bf16*)R;

#define IDS() int tid_ = threadIdx.x; asm volatile("" : "+v"(tid_)); const int lane_ = tid_ & 63, wave_ = __builtin_amdgcn_readfirstlane(tid_ >> 6); const int gw_ = vcu * NWAVES + wave_; (void)lane_; (void)gw_
    for (int rep_ = 0; rep_ < REP_P0; ++rep_)
    {
        IDS(); const int tid = tid_, lane = lane_, wave = wave_, gw = gw_;
        LAS float* sS = (LAS float*)lds;
        LAS float* part = (LAS float*)(lds + 9 * 1024 * 4);
        for (int i = tid; i < 9 * 1024; i += NTHR) { const float v = i < 8192 ? a.c[i] : a.c_ctx[i - 8192]; sS[i] = v / (1.0f + expf(-v)); }
        __syncthreads();
        for (int unit = bx; unit < DEPTH * 48; unit += G) { const int l = unit / 48, n = (unit % 48) * 128 + 2 * lane;
            const float* wp = a.w_ada + ((size_t)l * 1024 + wave * 128) * 6144 + n; float acc0[9], acc1[9];
#pragma unroll
            for (int q = 0; q < 9; ++q) { acc0[q] = 0.f; acc1[q] = 0.f; }
#pragma unroll 1
            for (int k0 = 0; k0 < 128; k0 += 8) { float2 wv[8];
#pragma unroll
                for (int k = 0; k < 8; ++k) { typedef float f2v __attribute__((ext_vector_type(2))); const f2v t_ = __builtin_nontemporal_load((const f2v*)(wp + (size_t)(k0 + k) * 6144)); wv[k] = make_float2(t_[0], t_[1]); }
#pragma unroll
                for (int k = 0; k < 8; ++k)
#pragma unroll
                    for (int q = 0; q < 9; ++q) { const float sv = sS[q * 1024 + wave * 128 + k0 + k]; acc0[q] += sv * wv[k].x; acc1[q] += sv * wv[k].y; } }
#pragma unroll
            for (int q = 0; q < 9; ++q) { part[(wave * 9 + q) * 128 + 2 * lane] = acc0[q]; part[(wave * 9 + q) * 128 + 2 * lane + 1] = acc1[q]; }
            __syncthreads();
            for (int i = tid; i < 9 * 128; i += NTHR) { float s = 0.f;
#pragma unroll
                for (int w = 0; w < 8; ++w) s += part[w * 1152 + i];
                const int q = i >> 7, nn = (unit % 48) * 128 + (i & 127); MOD[((size_t)l * 9 + q) * 6144 + nn] = s + a.b_ada[(size_t)l * 6144 + nn]; }
            __syncthreads(); }
        __syncthreads();
        LAS float* scr = (LAS float*)(lds + wave * 16384);
        constexpr int I_IN = 16 * 72, I_OUT = 16 * 32, I_1 = 16 * 128, I_2 = 64 * 32, I_L = I_IN + I_OUT + I_1 + I_2;
        for (int it = gw; it < DEPTH * I_L; it += ngw) { const int l = it / I_L; int r = it % I_L;
            if (r < I_IN) { transpose_item<true>(a.w_in + (size_t)l * DM * DIN, DM, DIN, WT_IN + (size_t)l * DIN * DM, scr, r, lane); continue; } r -= I_IN;
            if (r < I_OUT) { transpose_item<true>(a.w_out + (size_t)l * DM * DM, DM, DM, WT_OUT + (size_t)l * DM * DM, scr, r, lane); continue; } r -= I_OUT;
            if (r < I_1) { transpose_item<true>(a.w_ff1 + (size_t)l * DM * DFF, DM, DFF, WT_1 + (size_t)l * DFF * DM, scr, r, lane); continue; } r -= I_1;
            transpose_item<true>(a.w_ff2 + (size_t)l * DFF * DM, DFF, DM, WT_2 + (size_t)l * DM * DFF, scr, r, lane); }
        const int gt = bx * NTHR + tid, ngt = G * NTHR;
        for (int i = gt; i < SEQ * 32; i += ngt) { const int t = i >> 5, d = i & 31; const float inv = powf(10000.0f, -(float)(d & 15) / 16.0f); const float ang = (float)(d < 16 ? (t >> 6) : (t & 63)) * inv;
            ROPE[2 * i] = cosf(ang); ROPE[2 * i + 1] = sinf(ang); }
        for (int i = gt; i < DEPTH * 2 * 2 * 4 * 4096; i += ngt) { const int cin = i & 63, dout = (i >> 6) & 63, k = (i >> 12) & 3, ty = (i >> 14) & 1, ld = i >> 15;
            const float* src = ty ? a.lru_wx : a.lru_wa; WLRU[i] = (bf16)f2bf(src[(((size_t)ld * 4 + k) * 64 + cin) * 64 + dout]); }
        __syncthreads();
    }
    grid.sync();
    { IDS(); modulate_rows(a, MOD, U, gw_, ngw, lane_); }
    GRID_BAR();

    for (int l = 0; l < DEPTH; ++l) {
        const bool need_ctx = l < DEPTH - 1; const int mrows = need_ctx ? MT : ML;
        const float* modl = MOD + (size_t)l * 9 * 6144;
#ifndef SKIP_G1
        for (int rep_ = 1; rep_ < REP_G1N; ++rep_) { pg8::Gemm g{U, WT_IN + (size_t)l * DIN * DM, MT, DIN, DM}; pg8::StaticOrder S; S.init(MT, DIN, G, bx); pg8::EpiNull E{XC}; pg8::gemm_phase<pg8::EpiNull, pg8::StaticOrder, true, true>(lds, g, S, E); }
        for (int rep_ = 0; rep_ < REP_G1; ++rep_)
        {   pg8::Gemm g{U, WT_IN + (size_t)l * DIN * DM, MT, DIN, DM}; pg8::StaticOrder S; S.init(MT, DIN, G, bx);
            pg8::EpiIn E{P4, AQ, KB, VB, LX, LG, a.q_gain + l * 64, a.k_gain + l * 64, ROPE};
            pg8::gemm_phase<pg8::EpiIn, pg8::StaticOrder, true, true>(lds, g, S, E); }
#endif
        GRID_BAR();
        for (int rep_ = 0; rep_ < REP_SYNC; ++rep_) GRID_BAR();
#ifndef SKIP_R1
        for (int rep_ = 0; rep_ < REP_S2; ++rep_) {
        { IDS();
            if (G == 256) { if (bx < 64) { for (int k = 0; k < 2; ++k) ret_contrib_unit(2 * bx + k, RK, RV, a.ret_decay + l * 8, RETC, lds, tid_, lane_, wave_); }
                            else for (int u = 128 + (bx - 64); u < 32 * 34; u += 192) ret_contrib_unit(u, RK, RV, a.ret_decay + l * 8, RETC, lds, tid_, lane_, wave_); }
            else for (int u = (bx + G - 64) % G; u < 32 * 34; u += G) ret_contrib_unit(u, RK, RV, a.ret_decay + l * 8, RETC, lds, tid_, lane_, wave_); }
#endif
#ifndef SKIP_L1
        { IDS(); for (int u = bx; u < 272 * 4; u += G) lru_pass1_unit(u, a, l, LX, WLRU, AD, LCS4, lds, tid_, lane_, wave_); }
#endif
        }
        GRID_BAR();
        { IDS(); ret_prefix_phase(RETC, a.ret_decay + l * 8, bx * NTHR + tid_, G * NTHR); lru_compose_phase(LCS4, LCS, bx * NTHR + tid_, G * NTHR); }
        GRID_BAR();
#ifndef SKIP_ATT
        for (int rep_ = 0; rep_ < REP_ATT; ++rep_)
        {   const int nlat = NB * 8 * 16, natt = nlat + (need_ctx ? NB * 8 : 0);
            for (int u = vcu; u < natt; u += G) {
                if (u < nlat) { const int qb = u & 15, h = (u >> 4) & 3, kvh = (u >> 6) & 1, b = u >> 7; const int hq = kvh * 4 + h;
                    const size_t row0 = (size_t)b * SEQ + qb * 256;
                    attn_body::attn_unit<8>((const attn_body::bf16*)(AQ + row0 * 512 + hq * 64), (const attn_body::bf16*)(KB + (size_t)b * KVL * 128 + kvh * 64), (const attn_body::bf16*)(VB + (size_t)b * KVL * 128 + kvh * 64),
                                            (attn_body::bf16*)(MIX + row0 * DM + 256 + hq * 64), KVL / 64, (char*)lds_raw);
                } else { const int j = u - nlat, hq = j & 7, b = j >> 3, kvh = hq >> 2; const size_t row0 = (size_t)ML + b * CTXL;
                    attn_body::attn_unit<8>((const attn_body::bf16*)(AQ + row0 * 512 + hq * 64), (const attn_body::bf16*)(KB + ((size_t)b * KVL + SEQ) * 128 + kvh * 64), (const attn_body::bf16*)(VB + ((size_t)b * KVL + SEQ) * 128 + kvh * 64),
                                            (attn_body::bf16*)(MIX + row0 * DM + 256 + hq * 64), CTXL / 64, (char*)lds_raw); } }
            asm volatile("s_waitcnt vmcnt(0) lgkmcnt(0)" ::: "memory"); __syncthreads(); }
#endif
#ifndef SKIP_R2
        for (int rep_ = 0; rep_ < REP_R2; ++rep_)
            { IDS(); for (int u = (vcu + G - 64) % G; u < 32 * 34; u += G) { if (!need_ctx && (u % 34) >= 32) continue; ret_out_unit(u, RQ, RK, RV, RG, a.ret_decay + l * 8, RETC, MIX, lds, tid_, lane_, wave_); } }
#endif
#ifndef SKIP_L2
        for (int rep_ = 0; rep_ < REP_L2; ++rep_)
            { IDS(); for (int u = (vcu + G - 128) % G; u < 272; u += G) { if (!need_ctx && u >= 256) continue; lru_pass2_unit(u, AD, LCS, LG, MIX, lds, tid_); } }
#endif
        GRID_BAR();
#ifndef SKIP_G4
        for (int rep_ = 1; rep_ < REP_G4; ++rep_) { pg8::Gemm g{MIX, WT_OUT + (size_t)l * DM * DM, mrows, DM, DM}; pg8::StaticOrder S; S.init(mrows, DM, G, bx); pg8::EpiNull E{XC}; pg8::gemm_phase<pg8::EpiNull, pg8::StaticOrder, true, true>(lds, g, S, E); }
        for (int rep_ = 1; rep_ < REP_G4E; ++rep_) { pg8::Gemm g{MIX, WT_OUT + (size_t)l * DM * DM, mrows, DM, DM}; pg8::StaticOrder S; S.init(mrows, DM, G, bx); pg8::EpiRes E{l == 0 ? a.x : a.out, l == 0 ? a.ctx : XC, (float*)R, (float*)R + (size_t)ML * DM, modl + 2 * 1024, RETC, nullptr, nullptr}; pg8::gemm_phase<pg8::EpiRes, pg8::StaticOrder, true, true>(lds, g, S, E); }
        {   pg8::Gemm g{MIX, WT_OUT + (size_t)l * DM * DM, mrows, DM, DM};
            pg8::EpiRes E{a.x, l == 0 ? a.ctx : XC, a.out, XC, modl + 2 * 1024, RETC, l ? (const bf16*)a.out : nullptr, U};
            if (need_ctx) { pg8::SplitOrder S; S.init(DM, G, bx, 2); pg8::gemm_phase<pg8::EpiRes, pg8::SplitOrder, true, true>(lds, g, S, E); }
            else { pg8::StaticOrder S; S.init(mrows, DM, G, bx); pg8::gemm_phase<pg8::EpiRes, pg8::StaticOrder, true, true>(lds, g, S, E); } }
#endif
        GRID_BAR();
        for (int rep_ = 1; rep_ < REP_LN; ++rep_) { IDS(); ln_rows(a.out, XC, mrows, a.ln1_g + l * DM, a.ln1_b + l * DM, modl + 3 * 1024, (bf16*)AD, gw_, ngw, lane_, (float*)H); }
        { IDS(); ln_rows(a.out, XC, mrows, a.ln1_g + l * DM, a.ln1_b + l * DM, modl + 3 * 1024, U, gw_, ngw, lane_, nullptr, need_ctx ? RETC : nullptr, modl + 2 * 1024 + 8 * 6144, l == 0 ? a.ctx : nullptr, U, (bf16*)a.out); }
        GRID_BAR();
#ifndef SKIP_G6
        for (int rep_ = 0; rep_ < REP_G6; ++rep_)
        {   pg8::Gemm g{U, WT_1 + (size_t)l * DFF * DM, mrows, DFF, DM}; pg8::StaticOrder S; S.init(mrows, DFF, G, bx);
            pg8::EpiFF1 E{H};
            pg8::gemm_phase<pg8::EpiFF1, pg8::StaticOrder, true, true>(lds, g, S, E); }
#endif
        GRID_BAR();
#ifndef SKIP_G4
        for (int rep_ = 1; rep_ < REP_G7; ++rep_) { pg8::Gemm g{H, WT_2 + (size_t)l * DM * DFF, mrows, DM, DFF}; pg8::StaticOrder S; S.init(mrows, DM, G, bx); pg8::EpiNull E{XC}; pg8::gemm_phase<pg8::EpiNull, pg8::StaticOrder, true, true>(lds, g, S, E); }
        {   pg8::Gemm g{H, WT_2 + (size_t)l * DM * DFF, mrows, DM, DFF};
            pg8::EpiRes E{a.out, XC, a.out, XC, modl + 5 * 1024, RETC, (const bf16*)a.out, U};
            if (need_ctx) { pg8::SplitOrder S; S.init(DM, G, bx, 3); pg8::gemm_phase<pg8::EpiRes, pg8::SplitOrder, true, true>(lds, g, S, E); }
            else { pg8::StaticOrder S; S.init(mrows, DM, G, bx); pg8::gemm_phase<pg8::EpiRes, pg8::StaticOrder, true, true>(lds, g, S, E); } }
#endif
        GRID_BAR();
        { IDS(); ln_rows(a.out, XC, mrows, a.ln2_g + l * DM, a.ln2_b + l * DM, need_ctx ? modl + 9 * 6144 : nullptr, U, gw_, ngw, lane_, nullptr, need_ctx ? RETC : nullptr, modl + 5 * 1024 + 8 * 6144, nullptr, U, need_ctx ? (bf16*)a.out : nullptr, 8); }
        if (need_ctx) GRID_BAR();
    }
}

extern "C" void kernel_launch(void* const* d_in, const int* in_sizes, int n_in, void* d_out, int out_size, void* d_ws, size_t ws_size, hipStream_t stream) {
    static int grid = 0;
    if (grid == 0) {
        if (n_in != 24 || in_sizes[0] != ML * DM || out_size != ML * DM || ws_size < WS_END) { fprintf(stderr, "kernel_launch: unexpected shapes (n_in %d, in0 %d, out %d, ws %zu < %zu)\n", n_in, n_in > 0 ? in_sizes[0] : -1, out_size, ws_size, (size_t)WS_END); grid = -1; return; }
        int dev = 0, cus = 0, per_cu = 0;
        (void)hipGetDevice(&dev); (void)hipDeviceGetAttribute(&cus, hipDeviceAttributeMultiprocessorCount, dev);
        if (hipFuncSetAttribute((const void*)trunk_fwd, hipFuncAttributeMaxDynamicSharedMemorySize, LDS_BYTES) != hipSuccess) { fprintf(stderr, "kernel_launch: hipFuncSetAttribute failed\n"); grid = -1; return; }
        if (hipOccupancyMaxActiveBlocksPerMultiprocessor(&per_cu, (const void*)trunk_fwd, NTHR, LDS_BYTES) != hipSuccess || per_cu < 1) { fprintf(stderr, "kernel_launch: occupancy query says %d\n", per_cu); per_cu = 1; }
        (void)hipGetLastError();
        grid = cus * 1;
        if (grid <= 0) grid = 256;
    }
    if (grid < 0) return;
    Args a{};
    const float** f = (const float**)&a;
    for (int i = 0; i < 24; ++i) f[i] = (const float*)d_in[i];
    a.out = (float*)d_out; a.ws = (unsigned char*)d_ws;
    (void)hipMemsetAsync((unsigned char*)d_ws + WS_CTL, 0, CTL_BYTES, stream);
    void* args[] = {&a};
    hipError_t e = hipLaunchCooperativeKernel((const void*)trunk_fwd, dim3(grid), dim3(NTHR), args, LDS_BYTES, stream);
    if (e != hipSuccess) fprintf(stderr, "kernel_launch: cooperative launch failed: %s (grid %d)\n", hipGetErrorString(e), grid);
}
```

```cpp
#include <hip/hip_runtime.h>
#include <hip/hip_cooperative_groups.h>
#include <hip/hip_bf16.h>
#include <hip/hip_fp16.h>
#include <cstdio>
#include <cstdint>
#include <cmath>
namespace cg = cooperative_groups;

constexpr int DM = 1024, NB = 8, SEQ = 4096, CTXL = 256, DEPTH = 4;
constexpr int ML = NB * SEQ, MC = NB * CTXL, MT = ML + MC;
constexpr int DIN = 2304, DFF = 4096, KVL = SEQ + CTXL;
constexpr float ALPHA = 1.6817928305074290f, EPSN = 1e-6f;
namespace pg8 {
#define PG8_LAS __attribute__((address_space(3)))
typedef unsigned short bf16_t;
typedef short bf16x8 __attribute__((ext_vector_type(8)));
typedef float f32x4 __attribute__((ext_vector_type(4)));
typedef unsigned u32x4 __attribute__((ext_vector_type(4)));
constexpr int BM = 256, BK = 64, HALF = 128, HTB = HALF * BK * 2  , STAGE_BYTES = 8 * HTB, NXCD = 8, WGM = 8;

__host__ __device__ __forceinline__ int lds_byte(int r, int c) { const int st = (r >> 4) * 2 + (c >> 5), rr = r & 15, cc = c & 31, ob = rr * 64 + cc * 2; return st * 1024 + (ob ^ (((ob >> 9) & 1) << 5)); }
__host__ __device__ __forceinline__ void stage_rc(int b, int& R, int& C) { const int st = b / 1024, sb = b % 1024, swz = sb ^ (((sb >> 9) & 1) << 5); R = (st >> 1) * 16 + swz / 64; C = (st & 1) * 32 + (swz % 64) / 2; }
__host__ __device__ __forceinline__ int perm32(int rho) { const int n = rho >> 4, i = rho & 15; return 8 * (i >> 2) + 4 * n + (i & 3); }

struct Unit { int pm, pn, ks; };
struct Gemm { const bf16_t* A; const bf16_t* Bt; int M, N, K; };

struct StaticOrder {
    int nM, nN, nwg, G, c;
    __host__ __device__ void init(int M, int N, int G_, int c_) { nM = M / BM; nN = N / BM; nwg = nM * nN; G = G_; c = c_; }
    __host__ __device__ bool next(int i, Unit& u) const {
        const long L = (long)i * G + c; if (L >= nwg) return false;
        int wgid = (int)L; { const int q = nwg / NXCD, r = nwg % NXCD, xcd = wgid % NXCD, off = wgid / NXCD; wgid = (xcd < r ? xcd * (q + 1) : r * (q + 1) + (xcd - r) * q) + off; }
        const int nig = WGM * nN, gid = wgid / nig, fm = gid * WGM, gsz = (nM - fm) < WGM ? (nM - fm) : WGM;
        u.pm = fm + ((wgid % nig) % gsz); u.pn = (wgid % nig) / gsz; u.ks = -1; return true;
    }
    __device__ __forceinline__ void a_ready(const Unit&) const {}
    __device__ __forceinline__ void done(const Unit&) const {}
};


struct SplitOrder {
    StaticOrder base; int G, c, ksh;
    __host__ __device__ void init(int N, int G_, int c_, int ksh_) { base.init(32768, N, G_, c_); G = G_; c = c_; ksh = ksh_; }
    __host__ __device__ bool next(int i, Unit& u) const {
        if (base.next(i, u)) return true;
        const long L = (long)i * G + c - base.nwg; if (L < 0 || L >= (32 << ksh)) return false;
        u.pm = 128 + (int)(L >> (2 + ksh)); u.pn = (int)(L >> ksh) & 3; u.ks = (int)L & ((1 << ksh) - 1); return true;
    }
    __device__ __forceinline__ void a_ready(const Unit&) const {}
    __device__ __forceinline__ void done(const Unit&) const {}
};
__device__ __forceinline__ unsigned cvt_pk_bf16(float lo, float hi) { unsigned r; asm volatile("v_cvt_pk_bf16_f32 %0, %1, %2" : "=v"(r) : "v"(lo), "v"(hi)); return r; }
typedef unsigned u32x4 __attribute__((ext_vector_type(4)));
__device__ __forceinline__ float fast_sigmoid(float x) { return __builtin_amdgcn_rcpf(1.0f + __expf(-x)); }
__device__ __forceinline__ float act_silu(float x) { return x * fast_sigmoid(x); }
__device__ __forceinline__ float act_gelu_tanh(float x) { const float z = 0.7978845608028654f * (x + 0.044715f * x * x * x); return x * fast_sigmoid(2.0f * z); }
__device__ __forceinline__ u32x4 pack8(const f32x4 a, const f32x4 b) { u32x4 w; w.x = cvt_pk_bf16(a[0], a[1]); w.y = cvt_pk_bf16(a[2], a[3]); w.z = cvt_pk_bf16(b[0], b[1]); w.w = cvt_pk_bf16(b[2], b[3]); return w; }

struct EpiIn {
    static constexpr bool PERM = true, AFTER_DRAIN = false;
    bf16_t* P4;
    bf16_t *AQ, *KB, *VB, *LX, *LG;
    const float *qgain, *kgain, *rope;
    __device__ __forceinline__ void operator()(const f32x4 (&acc)[2][2][4][2], const Unit& u, int wr, int wc, int fr, int fq) const {
        const int pn = u.pn; const int rowb = u.pm * BM + wr * 64 + fr; const bool lat = u.pm < (32768 / BM);
        if (pn < 4 || pn >= 7) {
            bf16_t* base = pn < 4 ? P4 + (size_t)pn * ((size_t)34816 * 256) : (pn == 7 ? LX : LG);
#pragma unroll
            for (int ai = 0; ai < 2; ++ai)
#pragma unroll
                for (int m = 0; m < 4; ++m) { bf16_t* rp = base + (size_t)(rowb + ai * HALF + m * 16) * 256 + 64 * wc + 8 * fq;
#pragma unroll
                    for (int bj = 0; bj < 2; ++bj) { f32x4 v0 = acc[ai][bj][m][0], v1 = acc[ai][bj][m][1];
                        if (pn == 1) { v0 = v0 * 0.125f; v1 = v1 * 0.125f; }
                        else if (pn == 3) {
#pragma unroll
                            for (int e = 0; e < 4; ++e) { v0[e] = act_silu(v0[e]); v1[e] = act_silu(v1[e]); } }
                        else if (pn == 8) {
#pragma unroll
                            for (int e = 0; e < 4; ++e) { v0[e] = act_gelu_tanh(v0[e]); v1[e] = act_gelu_tanh(v1[e]); } }
                        *(u32x4*)(rp + 32 * bj) = pack8(v0, v1); } }
        } else if (pn < 6 || wc < 2) {
            const bool isq = pn < 6; const float* gain = isq ? qgain : kgain;
            const float post = isq ? (0.125f * 1.4426950408889634f) : 1.0f;
#pragma unroll
            for (int ai = 0; ai < 2; ++ai)
#pragma unroll
                for (int m = 0; m < 4; ++m) { const int row = rowb + ai * HALF + m * 16;
                    float ss = 0.f;
#pragma unroll
                    for (int bj = 0; bj < 2; ++bj)
#pragma unroll
                        for (int n = 0; n < 2; ++n) { const f32x4 x = acc[ai][bj][m][n]; ss += (x[0] * x[0] + x[1] * x[1]) + (x[2] * x[2] + x[3] * x[3]); }
                    ss += __shfl_xor(ss, 16); ss += __shfl_xor(ss, 32);
                    const float rs = rsqrtf(ss * (1.0f / 64.0f) + 1e-6f);
                    f32x4 o1[2], o2[2];
#pragma unroll
                    for (int n = 0; n < 2; ++n) { o1[n] = acc[ai][0][m][n] * rs * *(const f32x4*)(gain + 8 * fq + 4 * n); o2[n] = acc[ai][1][m][n] * rs * *(const f32x4*)(gain + 32 + 8 * fq + 4 * n); }
                    if (lat) { const float* rp = rope + ((size_t)(row & 4095) * 32 + 8 * fq) * 2;
#pragma unroll
                        for (int n = 0; n < 2; ++n) { const f32x4 cs0 = *(const f32x4*)(rp + 8 * n), cs1 = *(const f32x4*)(rp + 8 * n + 4);
                            const float c[4] = {cs0[0], cs0[2], cs1[0], cs1[2]}, s[4] = {cs0[1], cs0[3], cs1[1], cs1[3]};
#pragma unroll
                            for (int e = 0; e < 4; ++e) { const float x1 = o1[n][e], x2 = o2[n][e]; o1[n][e] = x1 * c[e] - x2 * s[e]; o2[n][e] = x1 * s[e] + x2 * c[e]; } } }
#pragma unroll
                    for (int n = 0; n < 2; ++n) { o1[n] = o1[n] * post; o2[n] = o2[n] * post; }
                    asm volatile("" ::: "memory");
                    bf16_t* dst;
                    if (isq) dst = AQ + (size_t)row * 512 + ((pn - 4) * 4 + wc) * 64 + 8 * fq;
                    else { const int j = row - 32768; const int kvrow = lat ? (row >> 12) * 4352 + (row & 4095) : (j >> 8) * 4352 + 4096 + (j & 255); dst = KB + (size_t)kvrow * 128 + wc * 64 + 8 * fq; }
                    *(u32x4*)dst = pack8(o1[0], o1[1]); *(u32x4*)(dst + 32) = pack8(o2[0], o2[1]); }
        } else {
#pragma unroll
            for (int ai = 0; ai < 2; ++ai)
#pragma unroll
                for (int m = 0; m < 4; ++m) { const int row = rowb + ai * HALF + m * 16; const int j = row - 32768;
                    const int kvrow = lat ? (row >> 12) * 4352 + (row & 4095) : (j >> 8) * 4352 + 4096 + (j & 255);
                    bf16_t* dst = VB + (size_t)kvrow * 128 + (wc - 2) * 64 + 8 * fq;
#pragma unroll
                    for (int bj = 0; bj < 2; ++bj) *(u32x4*)(dst + 32 * bj) = pack8(acc[ai][bj][m][0], acc[ai][bj][m][1]); }
        }
    }
};

struct EpiFF1 {
    static constexpr bool PERM = true, AFTER_DRAIN = false;
    bf16_t* H;
    __device__ __forceinline__ void operator()(const f32x4 (&acc)[2][2][4][2], const Unit& u, int wr, int wc, int fr, int fq) const {
        const int rowb = u.pm * BM + wr * 64 + fr; const int col0 = u.pn * BM + wc * 64 + 8 * fq;
#pragma unroll
        for (int ai = 0; ai < 2; ++ai)
#pragma unroll
            for (int m = 0; m < 4; ++m) { bf16_t* rp = H + (size_t)(rowb + ai * HALF + m * 16) * 4096 + col0;
#pragma unroll
                for (int bj = 0; bj < 2; ++bj) { f32x4 v0 = acc[ai][bj][m][0], v1 = acc[ai][bj][m][1];
#pragma unroll
                    for (int e = 0; e < 4; ++e) { const float a = fmaxf(v0[e], 0.f), b = fmaxf(v1[e], 0.f); v0[e] = a * a; v1[e] = b * b; }
                    __builtin_nontemporal_store(pack8(v0, v1), (u32x4*)(rp + bj * 32)); } }
    }
};

struct EpiRes {
    static constexpr bool PERM = true, AFTER_DRAIN = false;
    const float *rinL, *rinC; float *routL, *routC; const float* gate;
    float* part;
    const bf16_t* rinB;
    bf16_t* vout;
    __device__ __forceinline__ void operator()(const f32x4 (&acc)[2][2][4][2], const Unit& u, int wr, int wc, int fr, int fq) const {
        const bool lat = u.pm < (32768 / BM); const int bb = lat ? (u.pm >> 4) : 8;
        const int rowb = u.pm * BM + wr * 64 + fr; const int col0 = u.pn * BM + wc * 64 + 8 * fq;
        if (u.ks >= 0) { bf16_t* pb = (bf16_t*)part + ((size_t)u.ks * 2048 - 32768) * 1024;
#pragma unroll
            for (int ai = 0; ai < 2; ++ai)
#pragma unroll
                for (int m = 0; m < 4; ++m) { const size_t off = (size_t)(rowb + ai * HALF + m * 16) * 1024 + col0;
#pragma unroll
                    for (int bj = 0; bj < 2; ++bj) *(u32x4*)(pb + off + bj * 32) = pack8(acc[ai][bj][m][0], acc[ai][bj][m][1]); }
            return; }
        const float* gp = gate + (size_t)bb * 6144 + col0;
        f32x4 gv[2][2];
#pragma unroll
        for (int bj = 0; bj < 2; ++bj)
#pragma unroll
            for (int n = 0; n < 2; ++n) gv[bj][n] = *(const f32x4*)(gp + bj * 32 + n * 4);
        const float* ib = lat ? rinL : rinC - (size_t)32768 * 1024; float* ob = lat ? routL : routC - (size_t)32768 * 1024;
        const bool tobf = lat && vout != nullptr;
#pragma unroll
        for (int ai = 0; ai < 2; ++ai)
#pragma unroll
            for (int m = 0; m < 4; ++m) { const size_t off = (size_t)(rowb + ai * HALF + m * 16) * 1024 + col0;
#pragma unroll
                for (int bj = 0; bj < 2; ++bj) { f32x4 o[2];
                    if (lat && rinB) { const u32x4 w = *(const u32x4*)(rinB + off + bj * 32);
                        const f32x4 b0 = {__builtin_bit_cast(float, w.x << 16), __builtin_bit_cast(float, w.x & 0xffff0000u), __builtin_bit_cast(float, w.y << 16), __builtin_bit_cast(float, w.y & 0xffff0000u)};
                        const f32x4 b1 = {__builtin_bit_cast(float, w.z << 16), __builtin_bit_cast(float, w.z & 0xffff0000u), __builtin_bit_cast(float, w.w << 16), __builtin_bit_cast(float, w.w & 0xffff0000u)};
                        o[0] = b0 * 1.6817928305074290f + gv[bj][0] * acc[ai][bj][m][0]; o[1] = b1 * 1.6817928305074290f + gv[bj][1] * acc[ai][bj][m][1]; }
                    else {
#pragma unroll
                    for (int n = 0; n < 2; ++n) { const f32x4 bs = *(const f32x4*)(ib + off + bj * 32 + n * 4); o[n] = bs * 1.6817928305074290f + gv[bj][n] * acc[ai][bj][m][n]; } }
                    if (tobf) *(u32x4*)(vout + off + bj * 32) = pack8(o[0], o[1]);
                    else { *(f32x4*)(ob + off + bj * 32) = o[0]; *(f32x4*)(ob + off + bj * 32 + 4) = o[1]; } }
                if (m == 3) asm volatile("" ::: "memory"); }
    }
};

struct EpiNull {
    static constexpr bool PERM = false, AFTER_DRAIN = false;
    float* sink;
    __device__ __forceinline__ void operator()(const f32x4 (&acc)[2][2][4][2], const Unit& u, int wr, int wc, int fr, int fq) const {
        float s = 0.f;
#pragma unroll
        for (int ai = 0; ai < 2; ++ai)
#pragma unroll
            for (int bj = 0; bj < 2; ++bj)
#pragma unroll
                for (int m = 0; m < 4; ++m)
#pragma unroll
                    for (int n = 0; n < 2; ++n) s += acc[ai][bj][m][n][0] + acc[ai][bj][m][n][1] + acc[ai][bj][m][n][2] + acc[ai][bj][m][n][3];
        if (s == 123.456f) sink[0] = s;
    }
};
template <class Epi, class Sched, bool ALIGN_EPI = false, bool SP2 = false>
__device__ __forceinline__ void gemm_phase(PG8_LAS unsigned char* lds, const Gemm g, const Sched& S, const Epi& E) {
    int tid = threadIdx.x; asm volatile("" : "+v"(tid));
    const int wid = __builtin_amdgcn_readfirstlane(tid >> 6), lane = tid & 63, wr = wid >> 2, wc = wid & 3, fr = lane & 15, fq = lane >> 4;
    const int K = g.K, nt = K / BK;
    const int ksh = (K >= 4096) ? 3 : 2;
#define PG8_NT(u_) ((u_).ks < 0 ? nt : (nt >> ksh))
#define PG8_KOFF(u_) ((u_).ks < 0 ? (size_t)0 : (size_t)(u_).ks * (size_t)(K >> ksh) * 2)
    unsigned voffA[2], voffB[2];
#pragma unroll
    for (int i = 0; i < 2; ++i) { int R, C; stage_rc(tid * 16 + i * 8192, R, C); const int Rb = Epi::PERM ? ((R & ~31) + perm32(R & 31)) : R;
        voffA[i] = (unsigned)(R * K + C) * 2u; voffB[i] = (unsigned)(Rb * K + C) * 2u; }
    const size_t kstep = (size_t)(BK * 2);
    const size_t hstep = (size_t)HALF * K * 2;
    const size_t tstep = 2 * hstep;
    const unsigned ldsw = (unsigned)wid * 1024u;
    const int aoff = lds_byte(wr * 64 + fr, fq * 8), boff = lds_byte(wc * 32 + fr, fq * 8);
#define PG8_SA(b, h) (((b) * 2 + (h)) * HTB)
#define PG8_SB(b, h) ((4 + (b) * 2 + (h)) * HTB)
#define PG8_STAGE(bufoff, gbase, voff) do { _Pragma("unroll") for (int _i = 0; _i < 2; ++_i) \
        __builtin_amdgcn_global_load_lds((const unsigned*)((const char*)(gbase) + (voff)[_i]), (PG8_LAS unsigned*)(lds + (bufoff) + ldsw + _i * 8192), 16, 0, 0); } while (0)
#define PG8_LDA(dst, b, h) do { _Pragma("unroll") for (int m = 0; m < 4; ++m) _Pragma("unroll") for (int k = 0; k < 2; ++k) dst[m][k] = *(const PG8_LAS bf16x8*)(lds + PG8_SA(b, h) + aoff + m * 2048 + k * 1024); } while (0)
#define PG8_LDB(dst, b, h) do { _Pragma("unroll") for (int n = 0; n < 2; ++n) _Pragma("unroll") for (int k = 0; k < 2; ++k) dst[n][k] = *(const PG8_LAS bf16x8*)(lds + PG8_SB(b, h) + boff + n * 2048 + k * 1024); } while (0)
#define PG8_MMA(ai, bj, At, Bt) do { __builtin_amdgcn_s_setprio(1); _Pragma("unroll") for (int m = 0; m < 4; ++m) _Pragma("unroll") for (int n = 0; n < 2; ++n) _Pragma("unroll") for (int k = 0; k < 2; ++k) \
        acc[ai][bj][m][n] = __builtin_amdgcn_mfma_f32_16x16x32_bf16(Bt[n][k], At[m][k], acc[ai][bj][m][n], 0, 0, 0); __builtin_amdgcn_s_setprio(0); } while (0)
#define PG8_WAIT_V(n) asm volatile("s_waitcnt vmcnt(" #n ")" ::: "memory")
#define PG8_WAIT_L(n) asm volatile("s_waitcnt lgkmcnt(" #n ")" ::: "memory")
#define PG8_BAR __builtin_amdgcn_s_barrier()
#define PG8_SCHED __builtin_amdgcn_sched_barrier(0)
    Unit cur, nxt; int ui = 0;
    if (!S.next(0, cur)) return;
    f32x4 acc[2][2][4][2];
#pragma unroll
    for (int a = 0; a < 2; ++a)
#pragma unroll
        for (int b = 0; b < 2; ++b)
#pragma unroll
            for (int m = 0; m < 4; ++m)
#pragma unroll
                for (int n = 0; n < 2; ++n) acc[a][b][m][n] = (f32x4){0.f, 0.f, 0.f, 0.f};
    bf16x8 At[4][2], B0[2][2], B1[2][2];
    const char* cA = (const char*)g.A + (size_t)cur.pm * tstep + PG8_KOFF(cur); const char* cB = (const char*)g.Bt + (size_t)cur.pn * tstep + PG8_KOFF(cur);
    S.a_ready(cur);
    if constexpr (SP2) {
        PG8_STAGE(PG8_SB(0, 0), cB, voffB); PG8_STAGE(PG8_SB(0, 1), cB + hstep, voffB); PG8_STAGE(PG8_SA(0, 0), cA, voffA); PG8_STAGE(PG8_SA(0, 1), cA + hstep, voffA);
        if (wr == 1) PG8_BAR;
        PG8_WAIT_V(2); PG8_BAR;
        PG8_STAGE(PG8_SB(1, 0), cB + kstep, voffB); PG8_STAGE(PG8_SA(1, 0), cA + kstep, voffA); PG8_STAGE(PG8_SB(1, 1), cB + hstep + kstep, voffB);
        PG8_WAIT_V(6); PG8_BAR;
    } else {
        PG8_STAGE(PG8_SB(0, 0), cB, voffB); PG8_STAGE(PG8_SA(0, 0), cA, voffA); PG8_STAGE(PG8_SB(0, 1), cB + hstep, voffB); PG8_STAGE(PG8_SA(0, 1), cA + hstep, voffA);
        if (wr == 1) PG8_BAR;
        PG8_WAIT_V(4); PG8_BAR;
        PG8_STAGE(PG8_SB(1, 0), cB + kstep, voffB); PG8_STAGE(PG8_SA(1, 0), cA + kstep, voffA); PG8_STAGE(PG8_SB(1, 1), cB + hstep + kstep, voffB);
        PG8_WAIT_V(6); PG8_BAR;
    }
    for (;;) {
        const bool has_next = S.next(ui + 1, nxt);
        const char* nA = has_next ? (const char*)g.A + (size_t)nxt.pm * tstep + PG8_KOFF(nxt) : cA; const char* nB = has_next ? (const char*)g.Bt + (size_t)nxt.pn * tstep + PG8_KOFF(nxt) : cB;
        const int ntc = PG8_NT(cur);
        for (int t = 0; t < ntc; t += 2) {
            const bool last = (t == ntc - 2);
            const char* a1 = cA + (size_t)(t + 1) * kstep;
            const char* a2 = last ? nA : cA + (size_t)(t + 2) * kstep; const char* b2 = last ? nB : cB + (size_t)(t + 2) * kstep;
            const char* a3 = a2 + kstep; const char* b3 = b2 + kstep;
            if (last && has_next) S.a_ready(nxt);
            if constexpr (SP2) {
            PG8_LDB(B0, 0, 0); PG8_LDB(B1, 0, 1); PG8_SCHED; PG8_LDA(At, 0, 0); PG8_STAGE(PG8_SA(1, 1), a1 + hstep, voffA);
            PG8_WAIT_V(8); PG8_WAIT_L(0); PG8_BAR; PG8_MMA(0, 0, At, B0); PG8_MMA(0, 1, At, B1); PG8_BAR; PG8_SCHED;
            PG8_LDA(At, 0, 1); PG8_STAGE(PG8_SB(0, 0), b2, voffB); PG8_STAGE(PG8_SB(0, 1), b2 + hstep, voffB); PG8_STAGE(PG8_SA(0, 0), a2, voffA);
            PG8_WAIT_V(8); PG8_WAIT_L(0); PG8_BAR; PG8_MMA(1, 0, At, B0); PG8_MMA(1, 1, At, B1); PG8_BAR; PG8_SCHED;
            PG8_LDB(B0, 1, 0); PG8_LDB(B1, 1, 1); PG8_SCHED; PG8_LDA(At, 1, 0); PG8_STAGE(PG8_SA(0, 1), a2 + hstep, voffA);
            PG8_WAIT_V(8); PG8_WAIT_L(0); PG8_BAR; PG8_MMA(0, 0, At, B0); PG8_MMA(0, 1, At, B1); PG8_BAR; PG8_SCHED;
            PG8_LDA(At, 1, 1); PG8_STAGE(PG8_SB(1, 0), b3, voffB); PG8_STAGE(PG8_SB(1, 1), b3 + hstep, voffB); PG8_STAGE(PG8_SA(1, 0), a3, voffA);
            PG8_WAIT_V(8); PG8_WAIT_L(0); PG8_BAR; PG8_MMA(1, 0, At, B0); PG8_MMA(1, 1, At, B1); PG8_BAR; PG8_SCHED;
            } else {
            PG8_LDB(B0, 0, 0); PG8_SCHED; PG8_LDA(At, 0, 0); PG8_STAGE(PG8_SA(1, 1), a1 + hstep, voffA);
            PG8_WAIT_L(8); PG8_BAR; PG8_WAIT_L(0); PG8_MMA(0, 0, At, B0); PG8_BAR; PG8_SCHED;
            PG8_LDB(B1, 0, 1); PG8_STAGE(PG8_SB(0, 0), b2, voffB);
            PG8_BAR; PG8_WAIT_L(0); PG8_MMA(0, 1, At, B1); PG8_BAR;
            PG8_LDA(At, 0, 1); PG8_STAGE(PG8_SA(0, 0), a2, voffA);
            PG8_BAR; PG8_WAIT_L(0); PG8_MMA(1, 0, At, B0); PG8_BAR; PG8_SCHED;
            PG8_STAGE(PG8_SB(0, 1), b2 + hstep, voffB);
            PG8_WAIT_V(6); PG8_BAR; PG8_MMA(1, 1, At, B1); PG8_BAR;
            PG8_LDB(B0, 1, 0); PG8_SCHED; PG8_LDA(At, 1, 0); PG8_STAGE(PG8_SA(0, 1), a2 + hstep, voffA);
            PG8_WAIT_L(8); PG8_BAR; PG8_WAIT_L(0); PG8_MMA(0, 0, At, B0); PG8_BAR; PG8_SCHED;
            PG8_LDB(B1, 1, 1); PG8_STAGE(PG8_SB(1, 0), b3, voffB);
            PG8_BAR; PG8_WAIT_L(0); PG8_MMA(0, 1, At, B1); PG8_BAR;
            PG8_LDA(At, 1, 1); PG8_STAGE(PG8_SA(1, 0), a3, voffA);
            PG8_BAR; PG8_WAIT_L(0); PG8_MMA(1, 0, At, B0); PG8_BAR; PG8_SCHED;
            PG8_STAGE(PG8_SB(1, 1), b3 + hstep, voffB);
            PG8_WAIT_V(6); PG8_BAR; PG8_MMA(1, 1, At, B1); PG8_BAR;
            }
        }
        if constexpr (ALIGN_EPI) { if (wr == 0) PG8_BAR; }
        if constexpr (!Epi::AFTER_DRAIN) { E(acc, cur, wr, wc, fr, fq); S.done(cur); }
        if (!has_next) break;
#pragma unroll
        for (int a = 0; a < 2; ++a)
#pragma unroll
            for (int b = 0; b < 2; ++b)
#pragma unroll
                for (int m = 0; m < 4; ++m)
#pragma unroll
                    for (int n = 0; n < 2; ++n) acc[a][b][m][n] = (f32x4){0.f, 0.f, 0.f, 0.f};
        cur = nxt; cA = nA; cB = nB; ++ui;
        if constexpr (ALIGN_EPI) { if (wr == 1) PG8_BAR; }
    }
    PG8_WAIT_V(0);
    if constexpr (!ALIGN_EPI) { if (wr == 0) PG8_BAR; }
    PG8_BAR;
    if constexpr (Epi::AFTER_DRAIN) { E.fused(acc, cur, wr, wc, fr, fq, lds, wid, lane); S.done(cur); }
#undef PG8_NT
#undef PG8_KOFF
#undef PG8_SA
#undef PG8_SB
#undef PG8_STAGE
#undef PG8_LDA
#undef PG8_LDB
#undef PG8_MMA
#undef PG8_WAIT_V
#undef PG8_WAIT_L
#undef PG8_BAR
#undef PG8_SCHED
}
}
#include <hip/hip_bf16.h>
namespace attn_body {
using bf16=__hip_bfloat16;
using bf16x8=__attribute__((ext_vector_type(8)))short;
using s16x4=__attribute__((ext_vector_type(4)))short;
using f32x16=__attribute__((ext_vector_type(16)))float;
using u32x4=__attribute__((ext_vector_type(4)))unsigned;
constexpr int D=64,QP=512,KP=128,OP=1024;
constexpr int NW=8,QBLK=32,QB=QBLK*NW,KVBLK=64;
__device__ __forceinline__ int crow(int r,int hi){return (r&3)+8*(r>>2)+4*hi;}
#define SBAR() __builtin_amdgcn_sched_barrier(0)
__device__ __forceinline__ void cmask(f32x16&p0,f32x16&p1,int jb,int qrel,int hi){
  const float NEG=-INFINITY; int kb=64*jb+4*hi;
  #pragma unroll
  for(int r=0;r<16;++r){int kv=kb+(r&3)+8*(r>>2); if(kv>qrel)p0[r]=NEG; if(kv+32>qrel)p1[r]=NEG;}
}

constexpr int NSLOT=3, SLOTB=8192;
constexpr int LDS_K=0, LDS_V=NSLOT*SLOTB, LDS_WS=2*NSLOT*SLOTB, LDS_OST=LDS_WS+NW*64*4, LDS_BYTES=LDS_OST+NW*4096;
constexpr float C2=0.125f*1.4426950408889634f;
__device__ __forceinline__ void glds16(const void*gsrc,unsigned lds_dst){unsigned keep;
  asm volatile("s_mov_b32 %0, m0\n\ts_mov_b32 m0, %2\n\ts_nop 0\n\tglobal_load_lds_dwordx4 %1, off\n\ts_mov_b32 m0, %0":"=&s"(keep):"v"(gsrc),"s"(lds_dst):"memory");}
__device__ __forceinline__ float max3f(float a,float b,float c){float r;asm("v_max3_f32 %0, %1, %2, %3":"=v"(r):"v"(a),"v"(b),"v"(c));return r;}
__device__ __forceinline__ float max2f(float a,float b){float r;asm("v_max_f32_e32 %0, %1, %2":"=v"(r):"v"(a),"v"(b));return r;}
__device__ __forceinline__ float fadd_s(float a,float b){float r;asm("v_add_f32_e32 %0, %1, %2":"=v"(r):"v"(a),"v"(b));return r;}
__device__ __forceinline__ float fsub_s(float a,float b){float r;asm("v_sub_f32_e32 %0, %1, %2":"=v"(r):"v"(a),"v"(b));return r;}
typedef float f32x2_t __attribute__((ext_vector_type(2))); typedef __bf16 bf16x2_t __attribute__((ext_vector_type(2)));
__device__ __forceinline__ unsigned cvtpk_s(float lo,float hi){f32x2_t v={lo,hi};bf16x2_t b=__builtin_convertvector(v,bf16x2_t);return __builtin_bit_cast(unsigned,b);}
#define WAIT_BAR(N) asm volatile("s_waitcnt vmcnt(" #N ") lgkmcnt(0)\n\ts_barrier":::"memory")

__device__ __forceinline__ void qkt(f32x16&p0,f32x16&p1,const char*Kslot,const bf16x8*qr,const f32x16&negm,int r32,int hi){
  const char*kb=Kslot+hi*1024+r32*16;
  #pragma unroll
  for(int d0=0;d0<4;++d0){
    const bf16x8 b0=*reinterpret_cast<const bf16x8*>(kb+d0*2048);
    const bf16x8 b1=*reinterpret_cast<const bf16x8*>(kb+d0*2048+512);
    if(d0==0){p0=__builtin_amdgcn_mfma_f32_32x32x16_bf16(b0,qr[0],negm,0,0,0);p1=__builtin_amdgcn_mfma_f32_32x32x16_bf16(b1,qr[0],negm,0,0,0);}
    else{p0=__builtin_amdgcn_mfma_f32_32x32x16_bf16(b0,qr[d0],p0,0,0,0);p1=__builtin_amdgcn_mfma_f32_32x32x16_bf16(b1,qr[d0],p1,0,0,0);}}
}
typedef __attribute__((address_space(3))) const char* lds_cptr;
typedef short v4i16_t __attribute__((ext_vector_type(4)));
__device__ __forceinline__ void kload8(bf16x8*kf,lds_cptr kp){
  kf[0]=*(const __attribute__((address_space(3))) bf16x8*)(kp);      kf[1]=*(const __attribute__((address_space(3))) bf16x8*)(kp+512);
  kf[2]=*(const __attribute__((address_space(3))) bf16x8*)(kp+2048); kf[3]=*(const __attribute__((address_space(3))) bf16x8*)(kp+2560);
  kf[4]=*(const __attribute__((address_space(3))) bf16x8*)(kp+4096); kf[5]=*(const __attribute__((address_space(3))) bf16x8*)(kp+4608);
  kf[6]=*(const __attribute__((address_space(3))) bf16x8*)(kp+6144); kf[7]=*(const __attribute__((address_space(3))) bf16x8*)(kp+6656);
}
__device__ __forceinline__ void kload2(bf16x8*kf,lds_cptr kp,int j){ kf[2*j]=*(const __attribute__((address_space(3))) bf16x8*)(kp+j*2048); kf[2*j+1]=*(const __attribute__((address_space(3))) bf16x8*)(kp+j*2048+512); }
__device__ __forceinline__ s16x4 vtr(lds_cptr p){ return __builtin_bit_cast(s16x4,__builtin_amdgcn_ds_read_tr16_b64_v4i16((__attribute__((address_space(3))) v4i16_t*)p)); }
__device__ __forceinline__ float rowmax(const f32x16&p0,const f32x16&p1){
  float a=max3f(p0[0],p0[1],p1[0]),b=max3f(p0[2],p0[3],p1[1]);a=max3f(a,p1[2],p1[3]);
  #pragma unroll
  for(int r=4;r<16;r+=4){a=max3f(a,p0[r],p0[r+1]);b=max3f(b,p0[r+2],p0[r+3]);a=max3f(a,p1[r],p1[r+1]);b=max3f(b,p1[r+2],p1[r+3]);}
  const float m=max2f(a,b);
  auto rr=__builtin_amdgcn_permlane32_swap(__float_as_uint(m),__float_as_uint(m),false,false);
  return max2f(__uint_as_float(rr[0]),__uint_as_float(rr[1]));
}
__device__ __forceinline__ void pv(f32x16*o,int vb,bf16x8 pa0,bf16x8 pa1,bf16x8 pa2,bf16x8 pa3){
  #pragma unroll
  for(int d0=0;d0<2;++d0){s16x4 lo[4],hi[4];
    #pragma unroll
    for(int ks=0;ks<4;++ks){
      asm volatile("ds_read_b64_tr_b16 %0,%1 offset:%c2":"=&v"(lo[ks]):"v"(vb),"i"(d0*4096+ks*1024):"memory");
      asm volatile("ds_read_b64_tr_b16 %0,%1 offset:%c2":"=&v"(hi[ks]):"v"(vb),"i"(d0*4096+ks*1024+512):"memory");}
    asm volatile("s_waitcnt lgkmcnt(0)":::"memory");SBAR();
    #define PK(k) (bf16x8){lo[k][0],lo[k][1],lo[k][2],lo[k][3],hi[k][0],hi[k][1],hi[k][2],hi[k][3]}
    o[d0]=__builtin_amdgcn_mfma_f32_32x32x16_bf16(pa0,PK(0),o[d0],0,0,0);
    o[d0]=__builtin_amdgcn_mfma_f32_32x32x16_bf16(pa1,PK(1),o[d0],0,0,0);
    o[d0]=__builtin_amdgcn_mfma_f32_32x32x16_bf16(pa2,PK(2),o[d0],0,0,0);
    o[d0]=__builtin_amdgcn_mfma_f32_32x32x16_bf16(pa3,PK(3),o[d0],0,0,0);
    #undef PK
  }
}
#define ATTN_STORE16(p,v) (*(u32x4*)(p)=(v))
template<int THRL> __device__ __forceinline__ void attn_unit(const bf16*Qu,const bf16*__restrict__ Kh,const bf16*__restrict__ Vh,bf16*Ou,const int NT,char*shm){
  int tid=threadIdx.x; asm volatile("":"+v"(tid)); const int lane=tid&63,r32=lane&31,hi=lane>>5; const int wid=__builtin_amdgcn_readfirstlane(tid>>6);
  const bf16*Qw=Qu+(long)(wid*QBLK)*QP;
  const unsigned lds0=(unsigned)(uintptr_t)shm;
  float*wsf=(float*)(shm+LDS_WS)+wid*64;
  const bf16*ksrc=Kh+(long)lane*KP+wid*8;
  const bf16*vsrc=Vh+(long)(16*(wid&3)+(lane>>2))*KP+(wid>>2)*32+(lane&3)*8;
  const unsigned kdst=lds0+LDS_K+wid*1024, vdst=lds0+LDS_V+wid*1024;
  #define DMA_K(t,slot) glds16(ksrc+(long)(t)*KVBLK*KP,(unsigned)__builtin_amdgcn_readfirstlane(kdst+(slot)))
  #define DMA_V(t,slot) glds16(vsrc+(long)(t)*KVBLK*KP,(unsigned)__builtin_amdgcn_readfirstlane(vdst+(slot)))
  const int vb0=(int)(lds0+LDS_V)+((lane>>4)&1)*32+(lane&3)*8+(4*hi+((lane&15)>>2))*64;
  const char*Kbase=shm+LDS_K; bf16x8 kf[8];
  const lds_cptr shm3=(lds_cptr)shm; const lds_cptr kp0=shm3+LDS_K+hi*1024+r32*16; const lds_cptr vp0=shm3+LDS_V+((lane>>4)&1)*32+(lane&3)*8+(4*hi+((lane&15)>>2))*64;
  DMA_K(0,0);DMA_V(0,0);DMA_K(1,SLOTB);
  bf16x8 qr[4];
  #pragma unroll
  for(int d0=0;d0<4;++d0)qr[d0]=*reinterpret_cast<const bf16x8*>(&Qw[(long)r32*QP+d0*16+hi*8]);
  float mhat=0.f,l_reg=0.f;f32x16 o[2];o[0]=f32x16{};o[1]=f32x16{};f32x16 negm=f32x16{};asm volatile("":"+v"(negm));
  #define CMASK(P0,P1,t) do{}while(0)
  bool resc=false;
  #define START(P0,P1) do{ const float rm=rowmax(P0,P1); resc=false; \
    { const float dl=rm; mhat=fadd_s(mhat,dl); \
      _Pragma("unroll") for(int r=0;r<16;++r){P0[r]=fsub_s(P0[r],dl);P1[r]=fsub_s(P1[r],dl);} \
      _Pragma("unroll") for(int r=0;r<16;++r)negm[r]=-mhat; asm volatile("":"+v"(negm)); } \
    _Pragma("unroll") for(int r=0;r<16;++r)P0[r]=__builtin_amdgcn_exp2f(P0[r]); }while(0)
  #define RESC() do{ if(resc){ asm volatile("s_waitcnt lgkmcnt(0)":::"memory"); \
      _Pragma("unroll") for(int d_=0;d_<2;++d_) _Pragma("unroll") for(int r=0;r<16;++r)o[d_][r]*=wsf[crow(r,hi)]; } }while(0)
  f32x16 pA0,pA1,pB0,pB1;
  int sl_prev=0,sl_cur=0,sl_next=SLOTB;
  #define ROT() do{sl_prev=sl_cur;sl_cur=sl_next;sl_next=(sl_next==(NSLOT-1)*SLOTB)?0:sl_next+SLOTB;}while(0)
  DMA_K(2,2*SLOTB);
  WAIT_BAR(3);
  qkt(pA0,pA1,Kbase,qr,negm,r32,hi);asm volatile("s_nop 15\n\ts_nop 7":"+v"(pA0),"+v"(pA1));CMASK(pA0,pA1,0);
  START(pA0,pA1);
  _Pragma("unroll") for(int r=0;r<16;++r)pA1[r]=__builtin_amdgcn_exp2f(pA1[r]);
  WAIT_BAR(0);
  DMA_K(3,0);DMA_V(1,SLOTB);
  ROT();
  kload8(kf,kp0+sl_cur);
  WAIT_BAR(2);
  s16x4 vlo[8],vhi[8]; u32x4 pw0,pw1,pw2,pw3;
  #define PKW(P,B) cvtpk_s(P[B],P[B+1])
  #define PAF(k) __builtin_bit_cast(bf16x8,pw##k)
  #define VFR(i) (bf16x8){vlo[i][0],vlo[i][1],vlo[i][2],vlo[i][3],vhi[i][0],vhi[i][1],vhi[i][2],vhi[i][3]}
  #define PIN(x) asm volatile("":"+v"(x))
  #define MX3(a,b,c) __builtin_fmaxf(__builtin_fmaxf((a),(b)),(c))
  #define GAPA(MF,A0,A1,A2,A3,W0,W1,PW) do{ MF; sacc+=A0; sacc+=A1; sacc+=A2; sacc+=A3; PIN(sacc); W0; W1; PIN(PW); SBAR(); }while(0)
  #define EX(v) __builtin_amdgcn_exp2f(v)
  #define GAPB(MF,X,B) do{ MF; X[B]=EX(X[B]); X[B+1]=EX(X[B+1]); X[B+2]=EX(X[B+2]); X[B+3]=EX(X[B+3]); PIN(X); SBAR(); }while(0)
  #define VRD(i) do{ vlo[i]=vtr(vp_+(((i)>>2)*4096+((i)&3)*1024)); vhi[i]=vtr(vp_+(((i)>>2)*4096+((i)&3)*1024+512)); }while(0)
  #define KRD(G,j) do{ if(G){ kload2(kf,kp0+sl_next,j); SBAR(); } }while(0)
  #define STEP(C0,C1,P0,P1,t,GK,GV,GL) do{ SBAR(); \
    const lds_cptr vp_=vp0+sl_prev; \
    VRD(0); SBAR(); float sacc=(P0[0]+P0[1]); \
    GAPA(C0=__builtin_amdgcn_mfma_f32_32x32x16_bf16(kf[0],qr[0],negm,0,0,0), P0[2],P0[3],P0[4],P0[5],     pw0[0]=PKW(P0,0), pw0[1]=PKW(P0,2), pw0); \
    VRD(4); SBAR(); GAPA(C1=__builtin_amdgcn_mfma_f32_32x32x16_bf16(kf[1],qr[0],negm,0,0,0), P0[6],P0[7],P0[8],P0[9],     pw0[2]=PKW(P0,4), pw0[3]=PKW(P0,6), pw0); \
    VRD(1); SBAR(); GAPA(C0=__builtin_amdgcn_mfma_f32_32x32x16_bf16(kf[2],qr[1],C0,0,0,0),   P0[10],P0[11],P0[12],P0[13], pw1[0]=PKW(P0,8), pw1[1]=PKW(P0,10), pw1); \
    VRD(5); SBAR(); GAPA(C1=__builtin_amdgcn_mfma_f32_32x32x16_bf16(kf[3],qr[1],C1,0,0,0),   P0[14],P0[15],P1[0],P1[1],   pw1[2]=PKW(P0,12),pw1[3]=PKW(P0,14), pw1); \
    VRD(2); SBAR(); GAPA(C0=__builtin_amdgcn_mfma_f32_32x32x16_bf16(kf[4],qr[2],C0,0,0,0),   P1[2],P1[3],P1[4],P1[5],     pw2[0]=PKW(P1,0), pw2[1]=PKW(P1,2), pw2); \
    VRD(6); SBAR(); GAPA(C1=__builtin_amdgcn_mfma_f32_32x32x16_bf16(kf[5],qr[2],C1,0,0,0),   P1[6],P1[7],P1[8],P1[9],     pw2[2]=PKW(P1,4), pw2[3]=PKW(P1,6), pw2); \
    VRD(3); SBAR(); GAPA(C0=__builtin_amdgcn_mfma_f32_32x32x16_bf16(kf[6],qr[3],C0,0,0,0),   P1[10],P1[11],P1[12],P1[13], pw3[0]=PKW(P1,8), pw3[1]=PKW(P1,10), pw3); \
    VRD(7); SBAR(); GAPA(C1=__builtin_amdgcn_mfma_f32_32x32x16_bf16(kf[7],qr[3],C1,0,0,0),   P1[14],P1[15],0.f,0.f,       pw3[2]=PKW(P1,12),pw3[3]=PKW(P1,14), pw3); \
    l_reg+=sacc; \
    if(GK){DMA_K((t)+3,sl_cur);} if(GV){DMA_V((t)+1,sl_next);} \
    CMASK(C0,C1,t); \
    { float a=MX3(C0[0],C0[1],C1[0]),b=MX3(C0[2],C0[3],C1[1]); a=MX3(a,C1[2],C1[3]); \
      _Pragma("unroll") for(int r=4;r<16;r+=4){a=MX3(a,C0[r],C0[r+1]);b=MX3(b,C0[r+2],C0[r+3]);a=MX3(a,C1[r],C1[r+1]);b=MX3(b,C1[r+2],C1[r+3]);} \
      float rm=__builtin_fmaxf(a,b); { auto rr=__builtin_amdgcn_permlane32_swap(__float_as_uint(rm),__float_as_uint(rm),false,false); rm=__builtin_fmaxf(__uint_as_float(rr[0]),__uint_as_float(rr[1])); } \
      resc=false; \
      if(__builtin_expect(__any(rm>(float)THRL),0)){ const float dl=__builtin_fmaxf(rm,0.f); mhat+=dl; \
        _Pragma("unroll") for(int r=0;r<16;++r){C0[r]-=dl;C1[r]-=dl;} \
        _Pragma("unroll") for(int r=0;r<16;++r)negm[r]=-mhat; asm volatile("":"+v"(negm)); \
        const float f=__builtin_amdgcn_exp2f(-dl); l_reg*=f; if(hi==0)wsf[r32]=f; resc=true; } } \
    SBAR(); \
    GAPB(o[0]=__builtin_amdgcn_mfma_f32_32x32x16_bf16(PAF(0),VFR(0),o[0],0,0,0), C0,0); \
    GAPB(o[1]=__builtin_amdgcn_mfma_f32_32x32x16_bf16(PAF(0),VFR(4),o[1],0,0,0), C0,4); \
    KRD(GL,0); GAPB(o[0]=__builtin_amdgcn_mfma_f32_32x32x16_bf16(PAF(1),VFR(1),o[0],0,0,0), C0,8); \
    KRD(GL,1); GAPB(o[1]=__builtin_amdgcn_mfma_f32_32x32x16_bf16(PAF(1),VFR(5),o[1],0,0,0), C0,12); \
    KRD(GL,2); GAPB(o[0]=__builtin_amdgcn_mfma_f32_32x32x16_bf16(PAF(2),VFR(2),o[0],0,0,0), C1,0); \
    KRD(GL,3); GAPB(o[1]=__builtin_amdgcn_mfma_f32_32x32x16_bf16(PAF(2),VFR(6),o[1],0,0,0), C1,4); \
    GAPB(o[0]=__builtin_amdgcn_mfma_f32_32x32x16_bf16(PAF(3),VFR(3),o[0],0,0,0), C1,8); \
    GAPB(o[1]=__builtin_amdgcn_mfma_f32_32x32x16_bf16(PAF(3),VFR(7),o[1],0,0,0), C1,12); \
    }while(0)
  int t=1;
  #undef CMASK
  #define CMASK(P0,P1,t) do{}while(0)
  for(;t+5<NT;t+=2){
    STEP(pB0,pB1,pA0,pA1,t,true,true,true);     WAIT_BAR(2); RESC(); ROT();
    STEP(pA0,pA1,pB0,pB1,t+1,true,true,true);   WAIT_BAR(2); RESC(); ROT();
  }
  #undef CMASK
  #define CMASK(P0,P1,t) do{}while(0)
  #define ENDW(tt) do{ if((tt)+3<NT){WAIT_BAR(2);} else if((tt)+2<NT){WAIT_BAR(1);} else {WAIT_BAR(0);} }while(0)
  for(;t+1<NT;t+=2){
    STEP(pB0,pB1,pA0,pA1,t,(t+3<NT),(t+1<NT),(t+1<NT));       ENDW(t);   RESC(); ROT();
    STEP(pA0,pA1,pB0,pB1,t+1,(t+4<NT),(t+2<NT),(t+2<NT));     ENDW(t+1); RESC(); ROT();
  }
  STEP(pB0,pB1,pA0,pA1,NT-1,false,false,false); RESC();
  { float sacc=pB0[0]+pB0[1]; _Pragma("unroll") for(int r=2;r<16;++r)sacc+=pB0[r]; _Pragma("unroll") for(int r=0;r<16;++r)sacc+=pB1[r]; l_reg+=sacc;
    pw0=(u32x4){PKW(pB0,0),PKW(pB0,2),PKW(pB0,4),PKW(pB0,6)};pw1=(u32x4){PKW(pB0,8),PKW(pB0,10),PKW(pB0,12),PKW(pB0,14)};pw2=(u32x4){PKW(pB1,0),PKW(pB1,2),PKW(pB1,4),PKW(pB1,6)};pw3=(u32x4){PKW(pB1,8),PKW(pB1,10),PKW(pB1,12),PKW(pB1,14)};
    SBAR(); pv(o,vb0+sl_cur,PAF(0),PAF(1),PAF(2),PAF(3)); }
  #undef PKW
  #undef PAF
  #undef VFR
  #undef PIN
  #undef MX3
  #undef GAPA
  #undef GAPB
  #undef EX
  #undef VRD
  #undef KRD
  #undef STEP
  #undef ENDW
  {auto rr=__builtin_amdgcn_permlane32_swap(__float_as_uint(l_reg),__float_as_uint(l_reg),false,false);l_reg=__uint_as_float(rr[0])+__uint_as_float(rr[1]);}
  if(hi==0)wsf[32+r32]=l_reg;asm volatile("s_waitcnt lgkmcnt(0)":::"memory");
  float rli[16];
  #pragma unroll
  for(int r=0;r<16;++r)rli[r]=__builtin_amdgcn_rcpf(wsf[32+crow(r,hi)]);
  bf16*Ow=Ou+(long)(wid*QBLK)*OP;
  { bf16*stg=(bf16*)(shm+LDS_OST)+wid*2048;
    #pragma unroll
    for(int r=0;r<16;++r){const int orow=crow(r,hi);
      #pragma unroll
      for(int d0=0;d0<2;++d0)stg[orow*64+d0*32+r32]=__float2bfloat16(o[d0][r]*rli[r]);}
    asm volatile("s_waitcnt lgkmcnt(0)":::"memory");
    #pragma unroll
    for(int i=0;i<4;++i){const int row=i*8+(lane>>3),ch=lane&7; const u32x4 v=*(const u32x4*)(stg+row*64+ch*8); ATTN_STORE16(Ow+(long)row*OP+ch*8,v);} }
  asm volatile("s_waitcnt lgkmcnt(0)\n\ts_barrier":::"memory");
  #undef DMA_K
  #undef DMA_V
  #undef CMASK
  #undef START
  #undef RESC
  #undef ROT
}
#undef SBAR
#undef WAIT_BAR
}
#define LAS __attribute__((address_space(3)))
typedef unsigned short bf16;
typedef unsigned v4u __attribute__((ext_vector_type(4)));
typedef unsigned v2u __attribute__((ext_vector_type(2)));
typedef float f32x4 __attribute__((ext_vector_type(4)));
typedef float f32x16 __attribute__((ext_vector_type(16)));
typedef short bf16x8 __attribute__((ext_vector_type(8)));
typedef LAS unsigned char lds_t;
typedef _Float16 h2 __attribute__((ext_vector_type(2)));
constexpr int NWAVES = 8, NTHR = 512;
constexpr int LDS_BYTES = 155648;
constexpr size_t MiB = 1u << 20;
constexpr size_t WS_WIN = 0, WS_WOUT = 18 * MiB, WS_W1 = 26 * MiB, WS_W2 = 58 * MiB;
constexpr size_t WS_MOD = 90 * MiB, WS_ROPE = 91 * MiB, WS_WLRU = 92 * MiB, WS_LCS = 93 * MiB, WS_XC = 96 * MiB, WS_RETC = 104 * MiB, WS_U = 138 * MiB, WS_R = 206 * MiB;
constexpr size_t R_P4 = 0, R_AQ = 68 * MiB, R_KB = 102 * MiB, R_VB = R_KB + (size_t)NB * KVL * 128 * 2, R_LX = 119 * MiB, R_LG = 136 * MiB, R_MIX = 153 * MiB, R_AD = 221 * MiB, R_END = 289 * MiB;
constexpr size_t WS_CTL = WS_R + R_END, CTL_BYTES = 65536;
constexpr size_t WS_LCS4 = WS_CTL + MiB;
constexpr size_t WS_END = WS_CTL + 7 * MiB;
static_assert(R_VB + (size_t)NB * KVL * 128 * 2 <= R_LX, "ws map");

__device__ __forceinline__ unsigned f2bf(float f) { unsigned u = __builtin_bit_cast(unsigned, f); return (u + 0x7fffu + ((u >> 16) & 1u)) >> 16; }
__device__ __forceinline__ unsigned pk2(float lo, float hi) { return f2bf(lo) | (f2bf(hi) << 16); }
__device__ __forceinline__ float bf2f(unsigned short b) { return __builtin_bit_cast(float, (unsigned)b << 16); }
__device__ __forceinline__ float bflo(unsigned w) { return __builtin_bit_cast(float, w << 16); }
__device__ __forceinline__ float bfhi(unsigned w) { return __builtin_bit_cast(float, w & 0xffff0000u); }
__device__ __forceinline__ float wave_sum(float v) {
#pragma unroll
    for (int o = 1; o < 64; o <<= 1) v += __shfl_xor(v, o);
    return v;
}
__device__ __forceinline__ float fsig(float x) { return __builtin_amdgcn_rcpf(1.0f + __expf(-x)); }
__device__ __forceinline__ int crow16(int r, int hi) { return (r & 3) + 8 * (r >> 2) + 4 * hi; }
template <int KSTEPS> __device__ __forceinline__ void mma32(f32x16& acc, const lds_t* A, int lda, const lds_t* B, int ldb, int lane) {
    const lds_t* ap = A + (lane & 31) * lda + (lane >> 5) * 16; const lds_t* bp = B + (lane & 31) * ldb + (lane >> 5) * 16;
#pragma unroll
    for (int k = 0; k < KSTEPS; ++k) acc = __builtin_amdgcn_mfma_f32_32x32x16_bf16(*(const LAS bf16x8*)(ap + 32 * k), *(const LAS bf16x8*)(bp + 32 * k), acc, 0, 0, 0);
}

#define XB_TMO      128
#define XB_XCNT(j)  (256  + 64 * (j))
#define XB_XSUB(j)  (1280 + 64 * (j))
#define XB_XGEN(j)  (2304 + 64 * (j))
#define XB_TOP      3328
#define XB_TOPGEN   3392
#define XCD_BAR_WORDS 3456
#define XB_SPIN_CAP (1u << 18)

__device__ __forceinline__ unsigned xb_ld(unsigned* p)              { return __hip_atomic_load(p, __ATOMIC_RELAXED, __HIP_MEMORY_SCOPE_AGENT); }
__device__ __forceinline__ unsigned xb_add(unsigned* p, unsigned v) { return __hip_atomic_fetch_add(p, v, __ATOMIC_RELAXED, __HIP_MEMORY_SCOPE_AGENT); }
__device__ __forceinline__ unsigned xb_xcc_id() { return (unsigned)__builtin_amdgcn_s_getreg((3 << 11) | 20) & 0xFu; }
#define XB_SPIN(cond, bar) do { unsigned _sp = 0; while (cond) { __builtin_amdgcn_s_sleep(1); \
    if ((++_sp & 255u) == 0u) { if (xb_ld(&(bar)[XB_TMO])) break; if (_sp > XB_SPIN_CAP) { atomicAdd(&(bar)[XB_TMO], 1u); break; } } } } while (0)

struct XcdBarrier {
    unsigned* bar; unsigned x;
    volatile LAS unsigned* st;
};

__device__ __forceinline__ XcdBarrier xcd_barrier_post(unsigned* bar, volatile LAS unsigned* st) {
    XcdBarrier b; b.bar = bar; b.x = xb_xcc_id(); b.st = st;
    if (threadIdx.x == 0) (void)xb_add(&bar[XB_XCNT(b.x)], 1u);
    return b;
}
__device__ __forceinline__ void xcd_barrier_complete(unsigned* bar, unsigned x, unsigned& nloc, unsigned& nx) {
    const unsigned G = gridDim.x * gridDim.y * gridDim.z;
    unsigned sum, cnt, mine, sp = 0u;
    for (;;) {
        sum = 0u; cnt = 0u; mine = 0u;
#pragma unroll
        for (unsigned j = 0; j < 16; ++j) { const unsigned c = xb_ld(&bar[XB_XCNT(j)]); sum += c; cnt += (c > 0u) ? 1u : 0u; mine = (j == x) ? c : mine; }
        if (sum == G) break;
        __builtin_amdgcn_s_sleep(1);
        if ((++sp & 255u) == 0u) { if (xb_ld(&bar[XB_TMO])) break; if (sp > XB_SPIN_CAP) { atomicAdd(&bar[XB_TMO], 1u); break; } }
    }
    nloc = mine > 0u ? mine : 1u; nx = cnt > 0u ? cnt : 1u;
}

__device__ __forceinline__ void xcd_barrier(const XcdBarrier& b) {
    asm volatile("s_waitcnt vmcnt(0)" ::: "memory");
    __syncthreads();
    if (threadIdx.x == 0) {
        unsigned* bar = b.bar;
        __builtin_amdgcn_s_waitcnt(0);
        unsigned nloc = b.st[0], nx = b.st[1];
        if (nloc == 0u) { xcd_barrier_complete(bar, b.x, nloc, nx); b.st[0] = nloc; b.st[1] = nx; }
        const unsigned old = xb_add(&bar[XB_XSUB(b.x)], 1u);
        const unsigned gen = old / nloc;
        if (old + 1u == (gen + 1u) * nloc) {
            __builtin_amdgcn_fence(__ATOMIC_RELEASE, "agent");
            asm volatile("s_waitcnt vmcnt(0)" ::: "memory");
            const unsigned og = xb_add(&bar[XB_TOP], 1u);
            const unsigned tg = og / nx;
            if (og + 1u == (tg + 1u) * nx) xb_add(&bar[XB_TOPGEN], 1u);
            else XB_SPIN(xb_ld(&bar[XB_TOPGEN]) == tg, bar);
            __builtin_amdgcn_fence(__ATOMIC_ACQUIRE, "agent");
            xb_add(&bar[XB_XGEN(b.x)], 1u);
            asm volatile("s_waitcnt vmcnt(0)" ::: "memory");
        } else {
            XB_SPIN(xb_ld(&bar[XB_XGEN(b.x)]) == gen, bar);
            __builtin_amdgcn_fence(__ATOMIC_ACQUIRE, "agent");
            asm volatile("s_waitcnt vmcnt(0)" ::: "memory");
        }
    }
    __syncthreads();
}

struct Args {
    const float *x, *c, *ctx, *c_ctx, *w_ada, *b_ada, *w_in, *ret_decay, *q_gain, *k_gain, *conv_w, *conv_b, *lru_wa, *lru_ba, *lru_wx, *lru_bx, *lru_lam, *w_out, *ln1_g, *ln1_b, *w_ff1, *w_ff2, *ln2_g, *ln2_b;
    float* out; unsigned char* ws;
};

template <bool PERMIN> __device__ __forceinline__ void transpose_item(const float* W, int K, int N, bf16* WT, LAS float* scr, int item, int lane) {
    const int nblk = N / 32, kb = item / nblk, nb = item % nblk, k0 = 64 * kb, n0 = 32 * nb;
#pragma unroll 8
    for (int i = 0; i < 32; ++i) { const int kk = 2 * i + (lane >> 5); scr[kk * 33 + (lane & 31)] = W[(size_t)(k0 + kk) * N + n0 + (lane & 31)]; }
    asm volatile("s_waitcnt lgkmcnt(0)" ::: "memory");
    int r0 = n0;
    if (PERMIN) { const int cl = n0 & 255; r0 = (n0 & ~255) + 128 * ((cl >> 5) & 1) + 32 * (cl >> 6); }
    const int c = lane & 7;
#pragma unroll
    for (int j = 0; j < 4; ++j) { const int n = (lane >> 3) + 8 * j; const LAS float* s = scr + (8 * c) * 33 + n;
        v4u o; o.x = pk2(s[0 * 33], s[1 * 33]); o.y = pk2(s[2 * 33], s[3 * 33]); o.z = pk2(s[4 * 33], s[5 * 33]); o.w = pk2(s[6 * 33], s[7 * 33]);
        *(v4u*)(WT + (size_t)(r0 + n) * K + k0 + 8 * c) = o; }
    asm volatile("s_waitcnt lgkmcnt(0)" ::: "memory");
}

__device__ __forceinline__ void modulate_rows(const Args& a, const float* mod0, bf16* U, int gw, int ngw, int lane) {
    for (int m = gw; m < MT; m += ngw) {
        const bool lat = m < ML; const int bb = lat ? (m >> 12) : 8;
        const float* xr = lat ? a.x + (size_t)m * DM : a.ctx + (size_t)(m - ML) * DM;
        const float* mp = mod0 + (size_t)bb * 6144;
#pragma unroll
        for (int j = 0; j < 4; ++j) { const int col = 4 * (lane + 64 * j); const f32x4 v = *(const f32x4*)(xr + col), sh = *(const f32x4*)(mp + col), sc = *(const f32x4*)(mp + 1024 + col);
            const f32x4 o = v * (sc + 1.0f) + sh; v2u w; w.x = pk2(o[0], o[1]); w.y = pk2(o[2], o[3]); *(v2u*)(U + (size_t)m * DM + col) = w; }
    }
}
template <int NR> __device__ __forceinline__ void ln_lat_body(float* xL, const float* g, const float* b, const float* modp, bf16* U, int m0, int ngw, int lane, float* dummy, const bf16* vin, bf16* xB) {
    {
        f32x4 v[NR][4]; float s[NR], s2[NR];
#pragma unroll
        for (int q = 0; q < NR; ++q)
#pragma unroll
            for (int jj = 0; jj < 2; ++jj) { const size_t o_ = (size_t)(m0 + q * ngw) * DM + 8 * lane + 512 * jj;
                if (vin) { const v4u w = *(const v4u*)(vin + o_); v[q][2 * jj] = (f32x4){bflo(w.x), bfhi(w.x), bflo(w.y), bfhi(w.y)}; v[q][2 * jj + 1] = (f32x4){bflo(w.z), bfhi(w.z), bflo(w.w), bfhi(w.w)}; }
                else { v[q][2 * jj] = *(const f32x4*)(xL + o_); v[q][2 * jj + 1] = *(const f32x4*)(xL + o_ + 4); } }
#pragma unroll
        for (int q = 0; q < NR; ++q) { s[q] = 0.f;
#pragma unroll
            for (int j = 0; j < 4; ++j) s[q] += (v[q][j][0] + v[q][j][1]) + (v[q][j][2] + v[q][j][3]); }
#pragma unroll
        for (int o = 1; o < 64; o <<= 1) {
#pragma unroll
            for (int q = 0; q < NR; ++q) s[q] += __shfl_xor(s[q], o); }
#pragma unroll
        for (int q = 0; q < NR; ++q) { const float mean = s[q] * (1.0f / DM); s2[q] = 0.f;
#pragma unroll
            for (int j = 0; j < 4; ++j) { v[q][j] = v[q][j] - mean; s2[q] += (v[q][j][0] * v[q][j][0] + v[q][j][1] * v[q][j][1]) + (v[q][j][2] * v[q][j][2] + v[q][j][3] * v[q][j][3]); } }
#pragma unroll
        for (int o = 1; o < 64; o <<= 1) {
#pragma unroll
            for (int q = 0; q < NR; ++q) s2[q] += __shfl_xor(s2[q], o); }
#pragma unroll
        for (int jj = 0; jj < 2; ++jj) { const int col = 8 * lane + 512 * jj;
            const f32x4 g0 = *(const f32x4*)(g + col), g1 = *(const f32x4*)(g + col + 4), b0 = *(const f32x4*)(b + col), b1 = *(const f32x4*)(b + col + 4);
#pragma unroll
            for (int q = 0; q < NR; ++q) { const int m = m0 + q * ngw; const float rstd = rsqrtf(s2[q] * (1.0f / DM) + EPSN);
                const f32x4 o0 = v[q][2 * jj] * rstd * g0 + b0, o1 = v[q][2 * jj + 1] * rstd * g1 + b1;
                if (xB) { v4u wx; wx.x = pk2(o0[0], o0[1]); wx.y = pk2(o0[2], o0[3]); wx.z = pk2(o1[0], o1[1]); wx.w = pk2(o1[2], o1[3]); __builtin_nontemporal_store(wx, (v4u*)(xB + (size_t)m * DM + col)); }
                else { float* xo = (dummy ? dummy : xL) + (size_t)m * DM + col; *(f32x4*)xo = o0; *(f32x4*)(xo + 4) = o1; }
                if (modp) { const float* mp = modp + (size_t)(m >> 12) * 6144 + col; const f32x4 u0 = o0 * (*(const f32x4*)(mp + 1024) + 1.0f) + *(const f32x4*)mp, u1 = o1 * (*(const f32x4*)(mp + 1024 + 4) + 1.0f) + *(const f32x4*)(mp + 4);
                    v4u w; w.x = pk2(u0[0], u0[1]); w.y = pk2(u0[2], u0[3]); w.z = pk2(u1[0], u1[1]); w.w = pk2(u1[2], u1[3]); *(v4u*)(U + (size_t)m * DM + col) = w; } } }
    }
}
__device__ __forceinline__ void ln_rows_lat(float* xL, const float* g, const float* b, const float* modp, bf16* U, int gw, int ngw, int lane, float* dummy, const bf16* vin, bf16* xB) {
    int m0 = gw;
    for (; m0 + 3 * ngw < ML; m0 += 4 * ngw) ln_lat_body<4>(xL, g, b, modp, U, m0, ngw, lane, dummy, vin, xB);
    for (; m0 < ML; m0 += ngw) ln_lat_body<1>(xL, g, b, modp, U, m0, ngw, lane, dummy, vin, xB);
}
__device__ __forceinline__ void ln_rows_ctx(float* xC, const float* xCin, const float* g, const float* b, const float* modp, bf16* U, int gw, int ngw, int lane, const float* part, const float* gate8, int nsplit) {
    for (int r = gw; r < MC; r += ngw) {
        f32x4 v[4]; float s = 0.f;
#pragma unroll
        for (int j = 0; j < 4; ++j) { const int col = 4 * (lane + 64 * j); v[j] = *(const f32x4*)(xCin + (size_t)r * DM + col);
            if (part) { const bf16* pp = (const bf16*)part + (size_t)r * DM + col; f32x4 ps = {0.f, 0.f, 0.f, 0.f};
                for (int k = 0; k < nsplit; ++k) { const v2u w = *(const v2u*)(pp + (size_t)k * 2048 * 1024); ps = ps + (f32x4){bflo(w.x), bfhi(w.x), bflo(w.y), bfhi(w.y)}; }
                v[j] = v[j] * ALPHA + *(const f32x4*)(gate8 + col) * ps; }
            s += (v[j][0] + v[j][1]) + (v[j][2] + v[j][3]); }
        const float mean = wave_sum(s) * (1.0f / DM); float s2 = 0.f;
#pragma unroll
        for (int j = 0; j < 4; ++j) { v[j] = v[j] - mean; s2 += (v[j][0] * v[j][0] + v[j][1] * v[j][1]) + (v[j][2] * v[j][2] + v[j][3] * v[j][3]); }
        const float rstd = rsqrtf(wave_sum(s2) * (1.0f / DM) + EPSN);
#pragma unroll
        for (int j = 0; j < 4; ++j) { const int col = 4 * (lane + 64 * j); const f32x4 o = v[j] * rstd * *(const f32x4*)(g + col) + *(const f32x4*)(b + col);
            *(f32x4*)(xC + (size_t)r * DM + col) = o;
            if (modp) { const float* mp = modp + (size_t)8 * 6144; const f32x4 sh = *(const f32x4*)(mp + col), sc = *(const f32x4*)(mp + 1024 + col); const f32x4 uu = o * (sc + 1.0f) + sh;
                v2u w; w.x = pk2(uu[0], uu[1]); w.y = pk2(uu[2], uu[3]); *(v2u*)(U + (size_t)(ML + r) * DM + col) = w; } }
    }
}
__device__ __forceinline__ void ln_rows(float* xL, float* xC, int mrows, const float* g, const float* b, const float* modp, bf16* U, int gw, int ngw, int lane, float* dummy = nullptr, const float* part = nullptr, const float* gate8 = nullptr, const float* xCin = nullptr, const bf16* vin = nullptr, bf16* xB = nullptr, int nsplit = 4) {
    ln_rows_lat(xL, g, b, modp, U, gw, ngw, lane, dummy, vin, xB);
    if (mrows > ML && !dummy) ln_rows_ctx(xC, xCin ? xCin : xC, g, b, modp, U, gw, ngw, lane, part, gate8, nsplit);
}

__device__ __forceinline__ int chunk_row0(int b, int c) { return c < 32 ? b * SEQ + c * 128 : ML + b * CTXL + (c - 32) * 128; }
__device__ __forceinline__ float log_sigmoid(float x) { return fminf(x, 0.f) - log1pf(expf(-fabsf(x))); }
constexpr int RT_LDK = 272;
constexpr int RT_LDD = 144;
__device__ __forceinline__ void ret_contrib_unit(int unit, const bf16* RK, const bf16* RV, const float* decay_l, float* RETC, lds_t* lds, int tid, int lane, int wave) {
    const int c = unit % 34, bh = unit / 34, h = bh & 3, b = bh >> 2; const int m0 = chunk_row0(b, c);
    lds_t* Kft = lds; lds_t* Kbt = lds + 64 * RT_LDK; lds_t* Vt = lds + 128 * RT_LDK;
    const float lgf = log_sigmoid(decay_l[h]), lgb = log_sigmoid(decay_l[4 + h]);
    { const int j = tid >> 2, d0 = (tid & 3) * 16; const float wf = __expf(lgf * (float)(127 - j)), wb = __expf(lgb * (float)j);
        const v4u* kp = (const v4u*)(RK + (size_t)(m0 + j) * 256 + h * 64 + d0); const v4u* vp = (const v4u*)(RV + (size_t)(m0 + j) * 256 + h * 64 + d0);
#pragma unroll
        for (int q = 0; q < 2; ++q) { const v4u kw = kp[q], vw = vp[q];
#pragma unroll
            for (int e = 0; e < 4; ++e) { const unsigned kk = kw[e], vv = vw[e]; const int d = d0 + q * 8 + 2 * e; const float k0 = bflo(kk), k1 = bfhi(kk);
                *(LAS unsigned short*)(Kft + d * RT_LDK + j * 2) = (unsigned short)f2bf(k0 * wf); *(LAS unsigned short*)(Kft + (d + 1) * RT_LDK + j * 2) = (unsigned short)f2bf(k1 * wf);
                *(LAS unsigned short*)(Kbt + d * RT_LDK + j * 2) = (unsigned short)f2bf(k0 * wb); *(LAS unsigned short*)(Kbt + (d + 1) * RT_LDK + j * 2) = (unsigned short)f2bf(k1 * wb);
                *(LAS unsigned short*)(Vt + d * RT_LDK + j * 2) = (unsigned short)(vv & 0xffffu); *(LAS unsigned short*)(Vt + (d + 1) * RT_LDK + j * 2) = (unsigned short)(vv >> 16); } } }
    __syncthreads();
    { const int dir = wave >> 2, dt = (wave >> 1) & 1, vt = wave & 1; f32x16 acc = {};
        mma32<8>(acc, (dir ? Kbt : Kft) + 32 * dt * RT_LDK, RT_LDK, Vt + 32 * vt * RT_LDK, RT_LDK, lane);
        float* dst = RETC + ((size_t)unit * 2 + dir) * 4096 + (32 * vt + (lane & 31));
#pragma unroll
        for (int r = 0; r < 16; ++r) dst[(size_t)(32 * dt + crow16(r, lane >> 5)) * 64] = acc[r]; }
    __syncthreads();
}
__device__ __forceinline__ void ret_prefix_phase(float* RETC, const float* decay_l, int gt, int ngt) {
    for (int i = gt; i < 32 * 2 * 4096; i += ngt) { const int e = i & 4095, dir = (i >> 12) & 1, bh = i >> 13, h = bh & 3;
        const float G = __expf(log_sigmoid(decay_l[dir * 4 + h]) * 128.f); float* base = RETC + (size_t)bh * 34 * 8192 + dir * 4096 + e;
        float cv[34];
#pragma unroll
        for (int x = 0; x < 34; ++x) cv[x] = base[(size_t)x * 8192];
        float s = 0.f;
        if (dir == 0) {
#pragma unroll
            for (int k = 0; k < 34; ++k) { const int x = k < 2 ? 32 + k : k - 2; base[(size_t)x * 8192] = s; s = s * G + cv[x]; } }
        else {
#pragma unroll
            for (int k = 0; k < 34; ++k) { const int x = 33 - k; base[(size_t)x * 8192] = s; s = s * G + cv[x]; } }
    }
}
__device__ __forceinline__ void ret_out_unit(int unit, const bf16* RQ, const bf16* RK, const bf16* RV, const bf16* RG, const float* decay_l, const float* RETC, bf16* MIX, lds_t* lds, int tid, int lane, int wave) {
    const int c = unit % 34, bh = unit / 34, h = bh & 3, b = bh >> 2; const int m0 = chunk_row0(b, c);
    lds_t* Qs = lds; lds_t* Ks = Qs + 128 * RT_LDD; lds_t* Vt = Ks + 128 * RT_LDD; lds_t* Sft = Vt + 64 * RT_LDK; lds_t* Sbt = Sft + 64 * RT_LDD; lds_t* Ws = Sbt + 64 * RT_LDD;
    const float lgf = log_sigmoid(decay_l[h]), lgb = log_sigmoid(decay_l[4 + h]);
    { const float* base = RETC + ((size_t)bh * 34 + c) * 2 * 4096 + tid * 8;
        const f32x4 sf0 = *(const f32x4*)base, sf1 = *(const f32x4*)(base + 4), sb0 = *(const f32x4*)(base + 4096), sb1 = *(const f32x4*)(base + 4096 + 4);
        const int d = tid >> 3, v0 = (tid & 7) * 8;
#pragma unroll
        for (int e = 0; e < 4; ++e) { *(LAS unsigned short*)(Sft + (v0 + e) * RT_LDD + d * 2) = (unsigned short)f2bf(sf0[e]); *(LAS unsigned short*)(Sft + (v0 + 4 + e) * RT_LDD + d * 2) = (unsigned short)f2bf(sf1[e]);
            *(LAS unsigned short*)(Sbt + (v0 + e) * RT_LDD + d * 2) = (unsigned short)f2bf(sb0[e]); *(LAS unsigned short*)(Sbt + (v0 + 4 + e) * RT_LDD + d * 2) = (unsigned short)f2bf(sb1[e]); } }
    { const int j = tid >> 2, d0 = (tid & 3) * 16; const size_t go = (size_t)(m0 + j) * 256 + h * 64 + d0;
        const v4u* qp = (const v4u*)(RQ + go); const v4u* kp = (const v4u*)(RK + go); const v4u* vp = (const v4u*)(RV + go);
#pragma unroll
        for (int q = 0; q < 2; ++q) { *(LAS v4u*)(Qs + j * RT_LDD + (d0 + 8 * q) * 2) = qp[q]; *(LAS v4u*)(Ks + j * RT_LDD + (d0 + 8 * q) * 2) = kp[q]; const v4u vw = vp[q];
#pragma unroll
            for (int e = 0; e < 4; ++e) { const unsigned vv = vw[e]; const int d = d0 + q * 8 + 2 * e;
                *(LAS unsigned short*)(Vt + d * RT_LDK + j * 2) = (unsigned short)(vv & 0xffffu); *(LAS unsigned short*)(Vt + (d + 1) * RT_LDK + j * 2) = (unsigned short)(vv >> 16); } } }
    __syncthreads();
#pragma unroll
    for (int tt = 0; tt < 2; ++tt) { const int tile = wave * 2 + tt, it = tile >> 2, jt = tile & 3; f32x16 acc = {};
        mma32<4>(acc, Qs + 32 * it * RT_LDD, RT_LDD, Ks + 32 * jt * RT_LDD, RT_LDD, lane);
        const int j = 32 * jt + (lane & 31);
#pragma unroll
        for (int r = 0; r < 16; ++r) { const int i = 32 * it + crow16(r, lane >> 5); const float dd = (float)(i - j); const float w = acc[r] * __expf(dd >= 0.f ? lgf * dd : -lgb * dd);
            *(LAS unsigned short*)(Ws + i * RT_LDK + j * 2) = (unsigned short)f2bf(w); } }
    __syncthreads();
    f32x16 o;
    { const int it = wave >> 1, vt = wave & 1; f32x16 a1 = {}, a2 = {}, a3 = {};
        mma32<8>(a1, Ws + 32 * it * RT_LDK, RT_LDK, Vt + 32 * vt * RT_LDK, RT_LDK, lane);
        mma32<4>(a2, Qs + 32 * it * RT_LDD, RT_LDD, Sft + 32 * vt * RT_LDD, RT_LDD, lane);
        mma32<4>(a3, Qs + 32 * it * RT_LDD, RT_LDD, Sbt + 32 * vt * RT_LDD, RT_LDD, lane);
#pragma unroll
        for (int r = 0; r < 16; ++r) { const int i = 32 * it + crow16(r, lane >> 5); o[r] = a1[r] + __expf(lgf * (float)(i + 1)) * a2[r] + __expf(lgb * (float)(128 - i)) * a3[r]; } }
    __syncthreads();
    { const int it = wave >> 1, vt = wave & 1; LAS float* Os = (LAS float*)Ws;
#pragma unroll
        for (int r = 0; r < 16; ++r) Os[(32 * it + crow16(r, lane >> 5)) * 65 + 32 * vt + (lane & 31)] = o[r]; }
    __syncthreads();
    { const int i = tid >> 2, c0 = (tid & 3) * 16; const LAS float* Os = (const LAS float*)Ws + i * 65 + c0; float vals[16]; float ss = 0.f;
#pragma unroll
        for (int e = 0; e < 16; ++e) { vals[e] = Os[e]; ss += vals[e] * vals[e]; }
        ss += __shfl_xor(ss, 1); ss += __shfl_xor(ss, 2);
        const float rs = rsqrtf(ss * (1.0f / 64.0f) + EPSN);
        const v4u* gp = (const v4u*)(RG + (size_t)(m0 + i) * 256 + h * 64 + c0); bf16* dst = MIX + (size_t)(m0 + i) * DM + h * 64 + c0;
#pragma unroll
        for (int q = 0; q < 2; ++q) { const v4u gw = gp[q]; v4u ow;
#pragma unroll
            for (int e = 0; e < 4; ++e) ow[e] = pk2(vals[q * 8 + 2 * e] * rs * bflo(gw[e]), vals[q * 8 + 2 * e + 1] * rs * bfhi(gw[e]));
            *(v4u*)(dst + 8 * q) = ow; } }
    __syncthreads();
}

constexpr int LR_LDX = 528;
__device__ __forceinline__ void lru_pass1_unit(int cu4, const Args& a, int l, const bf16* LX, const bf16* WLRU, h2* AD, float2* LCS4, lds_t* lds, int tid, int lane, int wave) {
    const int cu = cu4 >> 2, rt0 = cu4 & 3;
    const int b = cu < 256 ? cu >> 5 : (cu - 256) >> 1, c = cu < 256 ? cu & 31 : 32 + ((cu - 256) & 1);
    const int m0 = chunk_row0(b, c), ms = c < 32 ? b * SEQ : ML + b * CTXL, me = ms + (c < 32 ? SEQ : CTXL);
    lds_t* XR = lds; LAS h2* ADL = (LAS h2*)(lds + 128 * LR_LDX);
    { const int w8 = (tid & 31) * 8, tr = tid >> 5; float cw[4][8], cb[8];
#pragma unroll
        for (int j = 0; j < 4; ++j)
#pragma unroll
            for (int e = 0; e < 8; ++e) cw[j][e] = a.conv_w[(size_t)l * 1024 + j * 256 + w8 + e];
#pragma unroll
        for (int e = 0; e < 8; ++e) cb[e] = a.conv_b[l * 256 + w8 + e];
        for (int i = 0; i < 2; ++i) { const int t = 32 * rt0 + tr + 16 * i; float acc[8];
#pragma unroll
            for (int e = 0; e < 8; ++e) acc[e] = cb[e];
#pragma unroll
            for (int j = 0; j < 4; ++j) { const int m = m0 + t + j - 2;
                if (m >= ms && m < me) { const v4u xv = *(const v4u*)(LX + (size_t)m * 256 + w8);
#pragma unroll
                    for (int e = 0; e < 4; ++e) { acc[2 * e] += bflo(xv[e]) * cw[j][2 * e]; acc[2 * e + 1] += bfhi(xv[e]) * cw[j][2 * e + 1]; } } }
            v4u ow;
#pragma unroll
            for (int e = 0; e < 4; ++e) ow[e] = pk2(acc[2 * e], acc[2 * e + 1]);
            *(LAS v4u*)(XR + (t & 31) * LR_LDX + w8 * 2) = ow; } }
    __syncthreads();
    const int k = wave & 3, dir = wave >> 2;
    float ba[2], bx[2], lsl[2];
#pragma unroll
    for (int ct = 0; ct < 2; ++ct) { const int ch = 64 * k + 32 * ct + (lane & 31); ba[ct] = a.lru_ba[(l * 2 + dir) * 256 + ch]; bx[ct] = a.lru_bx[(l * 2 + dir) * 256 + ch]; lsl[ct] = 8.0f * log_sigmoid(a.lru_lam[(l * 2 + dir) * 256 + ch]); }
    float At = 1.f, Ht = 0.f;
    for (int rt = rt0; rt < rt0 + 1; ++rt) {
        bf16x8 af[4];
#pragma unroll
        for (int ks = 0; ks < 4; ++ks) af[ks] = *(const LAS bf16x8*)(XR + (lane & 31) * LR_LDX + (64 * k + 16 * ks + 8 * (lane >> 5)) * 2);
#pragma unroll
        for (int ct = 0; ct < 2; ++ct) { f32x16 ga = {}, gx = {};
#pragma unroll
            for (int ks = 0; ks < 4; ++ks) { const bf16* wb = WLRU + (((size_t)(l * 2 + dir) * 2 * 4 + k) * 64 + 32 * ct + (lane & 31)) * 64 + 16 * ks + 8 * (lane >> 5);
                ga = __builtin_amdgcn_mfma_f32_32x32x16_bf16(af[ks], *(const bf16x8*)wb, ga, 0, 0, 0); gx = __builtin_amdgcn_mfma_f32_32x32x16_bf16(af[ks], *(const bf16x8*)(wb + 4 * 4096), gx, 0, 0, 0); }
            const int ch = 64 * k + 32 * ct + (lane & 31);
#pragma unroll
            for (int r = 0; r < 16; ++r) { const int row = crow16(r, lane >> 5);
                const float rg = fsig(ga[r] + ba[ct]), ig = fsig(gx[r] + bx[ct]); const float la = lsl[ct] * rg;
                const float a_ = __expf(la); const float oma = 1.0f - a_, dr = __builtin_amdgcn_sqrtf(oma * (1.0f + a_)) * ig * bf2f(*(const LAS unsigned short*)(XR + row * LR_LDX + ch * 2));
                h2 hv; hv[0] = (_Float16)oma; hv[1] = (_Float16)dr;
                ADL[row * 512 + dir * 256 + ch] = hv; AD[((size_t)(m0 + 32 * rt + row) * 2 + dir) * 256 + ch] = hv; } }
        __syncthreads();
        { const int sd = tid >> 8, sc = tid & 255; float A = 1.f, H = 0.f;
            h2 fr_[32];
#pragma unroll
            for (int r = 0; r < 32; ++r) fr_[r] = ADL[r * 512 + sd * 256 + sc];
            if (sd == 0) {
#pragma unroll
                for (int r = 0; r < 32; ++r) { const float aa = 1.0f - (float)fr_[r][0]; H = aa * H + (float)fr_[r][1]; A *= aa; }
                Ht = A * Ht + H; At = A * At; }
            else {
#pragma unroll
                for (int r = 31; r >= 0; --r) { const float aa = 1.0f - (float)fr_[r][0]; H = aa * H + (float)fr_[r][1]; A *= aa; }
                Ht = At * H + Ht; At = At * A; } }
        __syncthreads();
    }
    LCS4[(((size_t)(b * 34 + c) * 4 + rt0) * 2 + (tid >> 8)) * 256 + (tid & 255)] = make_float2(At, Ht);
}
__device__ __forceinline__ void lru_compose_phase(const float2* LCS4, float2* LCS, int gt, int ngt) {
    for (int i = gt; i < NB * 34 * 2 * 256; i += ngt) { const int ch = i & 255, dir = (i >> 8) & 1, bc = i >> 9; float2 s[4];
#pragma unroll
        for (int rt = 0; rt < 4; ++rt) s[rt] = LCS4[(((size_t)bc * 4 + rt) * 2 + dir) * 256 + ch];
        float A = 1.f, h = 0.f;
#pragma unroll
        for (int k = 0; k < 4; ++k) { const float2 t = s[dir ? 3 - k : k]; h = t.x * h + t.y; A *= t.x; }
        LCS[i] = make_float2(A, h); }
}
__device__ __forceinline__ void lru_pass2_unit(int cu, const h2* AD, const float2* LCS, const bf16* LG, bf16* MIX, lds_t* lds, int tid) {
    const int b = cu < 256 ? cu >> 5 : (cu - 256) >> 1, c = cu < 256 ? cu & 31 : 32 + ((cu - 256) & 1);
    const int m0 = chunk_row0(b, c); const int dir = tid >> 8, ch = tid & 255;
    LAS _Float16* HS = (LAS _Float16*)lds;
    float h = 0.f;
    const float2* cs = LCS + (size_t)b * 34 * 512 + dir * 256 + ch;
    const int n = dir == 0 ? (c < 32 ? c + 2 : c - 32) : 33 - c;
    for (int i0 = 0; i0 < n; i0 += 8) { float2 s[8];
#pragma unroll
        for (int j = 0; j < 8; ++j) { const int ii = (i0 + j < n) ? i0 + j : 0; const int cc = dir == 0 ? (ii < 2 ? 32 + ii : ii - 2) : 33 - ii; s[j] = cs[(size_t)cc * 512]; }
#pragma unroll
        for (int j = 0; j < 8; ++j) if (i0 + j < n) h = s[j].x * h + s[j].y; }
    const h2* ad = AD + ((size_t)m0 * 2 + dir) * 256 + ch;
#pragma unroll 1
    for (int r0 = 0; r0 < 128; r0 += 16) { h2 f[16];
#pragma unroll
        for (int j = 0; j < 16; ++j) { const int r = dir == 0 ? r0 + j : 127 - (r0 + j); f[j] = ad[(size_t)r * 512]; }
#pragma unroll
        for (int j = 0; j < 16; ++j) { const int r = dir == 0 ? r0 + j : 127 - (r0 + j); h = (1.0f - (float)f[j][0]) * h + (float)f[j][1]; HS[r * 512 + dir * 256 + ch] = (_Float16)h; } }
    __syncthreads();
    { typedef _Float16 h8 __attribute__((ext_vector_type(8))); const int c8 = (tid & 31) * 8;
#pragma unroll 4
        for (int i = 0; i < 8; ++i) { const int r = (tid >> 5) + 16 * i; const h8 hf = *(const LAS h8*)(HS + r * 512 + c8), hb = *(const LAS h8*)(HS + r * 512 + 256 + c8);
            const v4u g = *(const v4u*)(LG + (size_t)(m0 + r) * 256 + c8); v4u o;
#pragma unroll
            for (int e = 0; e < 4; ++e) o[e] = pk2(((float)hf[2 * e] + (float)hb[2 * e]) * bflo(g[e]), ((float)hf[2 * e + 1] + (float)hb[2 * e + 1]) * bfhi(g[e]));
            *(v4u*)(MIX + (size_t)(m0 + r) * DM + 768 + c8) = o; } }
    __syncthreads();
}
#ifndef REP_G1N
#define REP_G1N 1
#endif
#ifndef REP_G4E
#define REP_G4E 1
#endif
#ifndef REP_P0
#define REP_P0 1
#endif
#ifndef REP_G4
#define REP_G4 1
#endif
#ifndef REP_G7
#define REP_G7 1
#endif
#ifndef REP_LN
#define REP_LN 1
#endif
#ifndef REP_SYNC
#define REP_SYNC 0
#endif
#ifndef REP_G1
#define REP_G1 1
#endif
#ifndef REP_S2
#define REP_S2 1
#endif
#ifndef REP_ATT
#define REP_ATT 1
#endif
#ifndef REP_R2
#define REP_R2 1
#endif
#ifndef REP_L2
#define REP_L2 1
#endif
#ifndef REP_G6
#define REP_G6 1
#endif
__global__ void __launch_bounds__(NTHR, 2) trunk_fwd(Args a) {
    extern __shared__ __attribute__((aligned(16))) unsigned char lds_raw[];
    cg::grid_group grid = cg::this_grid();
    lds_t* lds = (lds_t*)lds_raw;
    const int tid = threadIdx.x;
    const int G = gridDim.x, bx = blockIdx.x;
    const int vcu = (G % 8 == 0) ? (bx % 8) * (G / 8) + bx / 8 : bx;
    const int ngw = G * NWAVES;
    unsigned char* ws = a.ws;
    volatile LAS unsigned* bst = (volatile LAS unsigned*)(lds + LDS_BYTES - 64);
    if (threadIdx.x == 0) { bst[0] = 0u; bst[1] = 0u; }
    __syncthreads();
    (void)xcd_barrier_post((unsigned*)(ws + WS_CTL), bst);
#define GRID_BAR() do { XcdBarrier b_; b_.bar = (unsigned*)(a.ws + WS_CTL); b_.x = xb_xcc_id(); b_.st = (volatile LAS unsigned*)(lds + LDS_BYTES - 64); xcd_barrier(b_); } while (0)
    bf16* WT_IN = (bf16*)(ws + WS_WIN); bf16* WT_OUT = (bf16*)(ws + WS_WOUT); bf16* WT_1 = (bf16*)(ws + WS_W1); bf16* WT_2 = (bf16*)(ws + WS_W2);
    float* MOD = (float*)(ws + WS_MOD); float* ROPE = (float*)(ws + WS_ROPE); bf16* WLRU = (bf16*)(ws + WS_WLRU); float2* LCS = (float2*)(ws + WS_LCS);
    float* XC = (float*)(ws + WS_XC); float* RETC = (float*)(ws + WS_RETC); bf16* U = (bf16*)(ws + WS_U);
    unsigned char* R = ws + WS_R;
    float2* LCS4 = (float2*)(ws + WS_LCS4);
    bf16* P4 = (bf16*)(R + R_P4); bf16* RQ = P4; bf16* RK = P4 + (size_t)MT * 256; bf16* RV = P4 + (size_t)2 * MT * 256; bf16* RG = P4 + (size_t)3 * MT * 256;
    bf16* AQ = (bf16*)(R + R_AQ); bf16* KB = (bf16*)(R + R_KB); bf16* VB = (bf16*)(R + R_VB); bf16* LX = (bf16*)(R + R_LX); bf16* LG = (bf16*)(R + R_LG);
    bf16* MIX = (bf16*)(R + R_MIX); h2* AD = (h2*)(R + R_AD); bf16* H = (bf16*)R;

#define IDS() int tid_ = threadIdx.x; asm volatile("" : "+v"(tid_)); const int lane_ = tid_ & 63, wave_ = __builtin_amdgcn_readfirstlane(tid_ >> 6); const int gw_ = vcu * NWAVES + wave_; (void)lane_; (void)gw_
    for (int rep_ = 0; rep_ < REP_P0; ++rep_)
    {
        IDS(); const int tid = tid_, lane = lane_, wave = wave_, gw = gw_;
        LAS float* sS = (LAS float*)lds;
        LAS float* part = (LAS float*)(lds + 9 * 1024 * 4);
        for (int i = tid; i < 9 * 1024; i += NTHR) { const float v = i < 8192 ? a.c[i] : a.c_ctx[i - 8192]; sS[i] = v / (1.0f + expf(-v)); }
        __syncthreads();
        for (int unit = bx; unit < DEPTH * 48; unit += G) { const int l = unit / 48, n = (unit % 48) * 128 + 2 * lane;
            const float* wp = a.w_ada + ((size_t)l * 1024 + wave * 128) * 6144 + n; float acc0[9], acc1[9];
#pragma unroll
            for (int q = 0; q < 9; ++q) { acc0[q] = 0.f; acc1[q] = 0.f; }
#pragma unroll 1
            for (int k0 = 0; k0 < 128; k0 += 8) { float2 wv[8];
#pragma unroll
                for (int k = 0; k < 8; ++k) wv[k] = *(const float2*)(wp + (size_t)(k0 + k) * 6144);
#pragma unroll
                for (int k = 0; k < 8; ++k)
#pragma unroll
                    for (int q = 0; q < 9; ++q) { const float sv = sS[q * 1024 + wave * 128 + k0 + k]; acc0[q] += sv * wv[k].x; acc1[q] += sv * wv[k].y; } }
#pragma unroll
            for (int q = 0; q < 9; ++q) { part[(wave * 9 + q) * 128 + 2 * lane] = acc0[q]; part[(wave * 9 + q) * 128 + 2 * lane + 1] = acc1[q]; }
            __syncthreads();
            for (int i = tid; i < 9 * 128; i += NTHR) { float s = 0.f;
#pragma unroll
                for (int w = 0; w < 8; ++w) s += part[w * 1152 + i];
                const int q = i >> 7, nn = (unit % 48) * 128 + (i & 127); MOD[((size_t)l * 9 + q) * 6144 + nn] = s + a.b_ada[(size_t)l * 6144 + nn]; }
            __syncthreads(); }
        __syncthreads();
        LAS float* scr = (LAS float*)(lds + wave * 16384);
        constexpr int I_IN = 16 * 72, I_OUT = 16 * 32, I_1 = 16 * 128, I_2 = 64 * 32, I_L = I_IN + I_OUT + I_1 + I_2;
        for (int it = gw; it < DEPTH * I_L; it += ngw) { const int l = it / I_L; int r = it % I_L;
            if (r < I_IN) { transpose_item<true>(a.w_in + (size_t)l * DM * DIN, DM, DIN, WT_IN + (size_t)l * DIN * DM, scr, r, lane); continue; } r -= I_IN;
            if (r < I_OUT) { transpose_item<true>(a.w_out + (size_t)l * DM * DM, DM, DM, WT_OUT + (size_t)l * DM * DM, scr, r, lane); continue; } r -= I_OUT;
            if (r < I_1) { transpose_item<true>(a.w_ff1 + (size_t)l * DM * DFF, DM, DFF, WT_1 + (size_t)l * DFF * DM, scr, r, lane); continue; } r -= I_1;
            transpose_item<true>(a.w_ff2 + (size_t)l * DFF * DM, DFF, DM, WT_2 + (size_t)l * DM * DFF, scr, r, lane); }
        const int gt = bx * NTHR + tid, ngt = G * NTHR;
        for (int i = gt; i < SEQ * 32; i += ngt) { const int t = i >> 5, d = i & 31; const float inv = powf(10000.0f, -(float)(d & 15) / 16.0f); const float ang = (float)(d < 16 ? (t >> 6) : (t & 63)) * inv;
            ROPE[2 * i] = cosf(ang); ROPE[2 * i + 1] = sinf(ang); }
        for (int i = gt; i < DEPTH * 2 * 2 * 4 * 4096; i += ngt) { const int cin = i & 63, dout = (i >> 6) & 63, k = (i >> 12) & 3, ty = (i >> 14) & 1, ld = i >> 15;
            const float* src = ty ? a.lru_wx : a.lru_wa; WLRU[i] = (bf16)f2bf(src[(((size_t)ld * 4 + k) * 64 + cin) * 64 + dout]); }
        __syncthreads();
    }
    grid.sync();
    { IDS(); modulate_rows(a, MOD, U, gw_, ngw, lane_); }
    GRID_BAR();

    for (int l = 0; l < DEPTH; ++l) {
        const bool need_ctx = l < DEPTH - 1; const int mrows = need_ctx ? MT : ML;
        const float* modl = MOD + (size_t)l * 9 * 6144;
#ifndef SKIP_G1
        for (int rep_ = 1; rep_ < REP_G1N; ++rep_) { pg8::Gemm g{U, WT_IN + (size_t)l * DIN * DM, MT, DIN, DM}; pg8::StaticOrder S; S.init(MT, DIN, G, bx); pg8::EpiNull E{XC}; pg8::gemm_phase<pg8::EpiNull, pg8::StaticOrder, true, true>(lds, g, S, E); }
        for (int rep_ = 0; rep_ < REP_G1; ++rep_)
        {   pg8::Gemm g{U, WT_IN + (size_t)l * DIN * DM, MT, DIN, DM}; pg8::StaticOrder S; S.init(MT, DIN, G, bx);
            pg8::EpiIn E{P4, AQ, KB, VB, LX, LG, a.q_gain + l * 64, a.k_gain + l * 64, ROPE};
            pg8::gemm_phase<pg8::EpiIn, pg8::StaticOrder, true, true>(lds, g, S, E); }
#endif
        GRID_BAR();
        for (int rep_ = 0; rep_ < REP_SYNC; ++rep_) GRID_BAR();
#ifndef SKIP_R1
        for (int rep_ = 0; rep_ < REP_S2; ++rep_) {
        { IDS();
            if (G == 256) { if (bx < 64) { for (int k = 0; k < 2; ++k) ret_contrib_unit(2 * bx + k, RK, RV, a.ret_decay + l * 8, RETC, lds, tid_, lane_, wave_); }
                            else for (int u = 128 + (bx - 64); u < 32 * 34; u += 192) ret_contrib_unit(u, RK, RV, a.ret_decay + l * 8, RETC, lds, tid_, lane_, wave_); }
            else for (int u = (bx + G - 64) % G; u < 32 * 34; u += G) ret_contrib_unit(u, RK, RV, a.ret_decay + l * 8, RETC, lds, tid_, lane_, wave_); }
#endif
#ifndef SKIP_L1
        { IDS(); for (int u = bx; u < 272 * 4; u += G) lru_pass1_unit(u, a, l, LX, WLRU, AD, LCS4, lds, tid_, lane_, wave_); }
#endif
        }
        GRID_BAR();
        { IDS(); ret_prefix_phase(RETC, a.ret_decay + l * 8, bx * NTHR + tid_, G * NTHR); lru_compose_phase(LCS4, LCS, bx * NTHR + tid_, G * NTHR); }
        GRID_BAR();
#ifndef SKIP_ATT
        for (int rep_ = 0; rep_ < REP_ATT; ++rep_)
        {   const int nlat = NB * 8 * 16, natt = nlat + (need_ctx ? NB * 8 : 0);
            for (int u = vcu; u < natt; u += G) {
                if (u < nlat) { const int qb = u & 15, h = (u >> 4) & 3, kvh = (u >> 6) & 1, b = u >> 7; const int hq = kvh * 4 + h;
                    const size_t row0 = (size_t)b * SEQ + qb * 256;
                    attn_body::attn_unit<8>((const attn_body::bf16*)(AQ + row0 * 512 + hq * 64), (const attn_body::bf16*)(KB + (size_t)b * KVL * 128 + kvh * 64), (const attn_body::bf16*)(VB + (size_t)b * KVL * 128 + kvh * 64),
                                            (attn_body::bf16*)(MIX + row0 * DM + 256 + hq * 64), KVL / 64, (char*)lds_raw);
                } else { const int j = u - nlat, hq = j & 7, b = j >> 3, kvh = hq >> 2; const size_t row0 = (size_t)ML + b * CTXL;
                    attn_body::attn_unit<8>((const attn_body::bf16*)(AQ + row0 * 512 + hq * 64), (const attn_body::bf16*)(KB + ((size_t)b * KVL + SEQ) * 128 + kvh * 64), (const attn_body::bf16*)(VB + ((size_t)b * KVL + SEQ) * 128 + kvh * 64),
                                            (attn_body::bf16*)(MIX + row0 * DM + 256 + hq * 64), CTXL / 64, (char*)lds_raw); } }
            asm volatile("s_waitcnt vmcnt(0) lgkmcnt(0)" ::: "memory"); __syncthreads(); }
#endif
#ifndef SKIP_R2
        for (int rep_ = 0; rep_ < REP_R2; ++rep_)
            { IDS(); for (int u = (vcu + G - 64) % G; u < 32 * 34; u += G) { if (!need_ctx && (u % 34) >= 32) continue; ret_out_unit(u, RQ, RK, RV, RG, a.ret_decay + l * 8, RETC, MIX, lds, tid_, lane_, wave_); } }
#endif
#ifndef SKIP_L2
        for (int rep_ = 0; rep_ < REP_L2; ++rep_)
            { IDS(); for (int u = (vcu + G - 128) % G; u < 272; u += G) { if (!need_ctx && u >= 256) continue; lru_pass2_unit(u, AD, LCS, LG, MIX, lds, tid_); } }
#endif
        GRID_BAR();
#ifndef SKIP_G4
        for (int rep_ = 1; rep_ < REP_G4; ++rep_) { pg8::Gemm g{MIX, WT_OUT + (size_t)l * DM * DM, mrows, DM, DM}; pg8::StaticOrder S; S.init(mrows, DM, G, bx); pg8::EpiNull E{XC}; pg8::gemm_phase<pg8::EpiNull, pg8::StaticOrder, true, true>(lds, g, S, E); }
        for (int rep_ = 1; rep_ < REP_G4E; ++rep_) { pg8::Gemm g{MIX, WT_OUT + (size_t)l * DM * DM, mrows, DM, DM}; pg8::StaticOrder S; S.init(mrows, DM, G, bx); pg8::EpiRes E{l == 0 ? a.x : a.out, l == 0 ? a.ctx : XC, (float*)R, (float*)R + (size_t)ML * DM, modl + 2 * 1024, RETC, nullptr, nullptr}; pg8::gemm_phase<pg8::EpiRes, pg8::StaticOrder, true, true>(lds, g, S, E); }
        {   pg8::Gemm g{MIX, WT_OUT + (size_t)l * DM * DM, mrows, DM, DM};
            pg8::EpiRes E{a.x, l == 0 ? a.ctx : XC, a.out, XC, modl + 2 * 1024, RETC, l ? (const bf16*)a.out : nullptr, U};
            if (need_ctx) { pg8::SplitOrder S; S.init(DM, G, bx, 2); pg8::gemm_phase<pg8::EpiRes, pg8::SplitOrder, true, true>(lds, g, S, E); }
            else { pg8::StaticOrder S; S.init(mrows, DM, G, bx); pg8::gemm_phase<pg8::EpiRes, pg8::StaticOrder, true, true>(lds, g, S, E); } }
#endif
        GRID_BAR();
        for (int rep_ = 1; rep_ < REP_LN; ++rep_) { IDS(); ln_rows(a.out, XC, mrows, a.ln1_g + l * DM, a.ln1_b + l * DM, modl + 3 * 1024, (bf16*)AD, gw_, ngw, lane_, (float*)H); }
        { IDS(); ln_rows(a.out, XC, mrows, a.ln1_g + l * DM, a.ln1_b + l * DM, modl + 3 * 1024, U, gw_, ngw, lane_, nullptr, need_ctx ? RETC : nullptr, modl + 2 * 1024 + 8 * 6144, l == 0 ? a.ctx : nullptr, U, (bf16*)a.out); }
        GRID_BAR();
#ifndef SKIP_G6
        for (int rep_ = 0; rep_ < REP_G6; ++rep_)
        {   pg8::Gemm g{U, WT_1 + (size_t)l * DFF * DM, mrows, DFF, DM}; pg8::StaticOrder S; S.init(mrows, DFF, G, bx);
            pg8::EpiFF1 E{H};
            pg8::gemm_phase<pg8::EpiFF1, pg8::StaticOrder, true, true>(lds, g, S, E); }
#endif
        GRID_BAR();
#ifndef SKIP_G4
        for (int rep_ = 1; rep_ < REP_G7; ++rep_) { pg8::Gemm g{H, WT_2 + (size_t)l * DM * DFF, mrows, DM, DFF}; pg8::StaticOrder S; S.init(mrows, DM, G, bx); pg8::EpiNull E{XC}; pg8::gemm_phase<pg8::EpiNull, pg8::StaticOrder, true, true>(lds, g, S, E); }
        {   pg8::Gemm g{H, WT_2 + (size_t)l * DM * DFF, mrows, DM, DFF};
            pg8::EpiRes E{a.out, XC, a.out, XC, modl + 5 * 1024, RETC, (const bf16*)a.out, U};
            if (need_ctx) { pg8::SplitOrder S; S.init(DM, G, bx, 3); pg8::gemm_phase<pg8::EpiRes, pg8::SplitOrder, true, true>(lds, g, S, E); }
            else { pg8::StaticOrder S; S.init(mrows, DM, G, bx); pg8::gemm_phase<pg8::EpiRes, pg8::StaticOrder, true, true>(lds, g, S, E); } }
#endif
        GRID_BAR();
        { IDS(); ln_rows(a.out, XC, mrows, a.ln2_g + l * DM, a.ln2_b + l * DM, need_ctx ? modl + 9 * 6144 : nullptr, U, gw_, ngw, lane_, nullptr, need_ctx ? RETC : nullptr, modl + 5 * 1024 + 8 * 6144, nullptr, U, need_ctx ? (bf16*)a.out : nullptr, 8); }
        if (need_ctx) GRID_BAR();
    }
}

extern "C" void kernel_launch(void* const* d_in, const int* in_sizes, int n_in, void* d_out, int out_size, void* d_ws, size_t ws_size, hipStream_t stream) {
    static int grid = 0;
    if (grid == 0) {
        if (n_in != 24 || in_sizes[0] != ML * DM || out_size != ML * DM || ws_size < WS_END) { fprintf(stderr, "kernel_launch: unexpected shapes (n_in %d, in0 %d, out %d, ws %zu < %zu)\n", n_in, n_in > 0 ? in_sizes[0] : -1, out_size, ws_size, (size_t)WS_END); grid = -1; return; }
        int dev = 0, cus = 0, per_cu = 0;
        (void)hipGetDevice(&dev); (void)hipDeviceGetAttribute(&cus, hipDeviceAttributeMultiprocessorCount, dev);
        if (hipFuncSetAttribute((const void*)trunk_fwd, hipFuncAttributeMaxDynamicSharedMemorySize, LDS_BYTES) != hipSuccess) { fprintf(stderr, "kernel_launch: hipFuncSetAttribute failed\n"); grid = -1; return; }
        if (hipOccupancyMaxActiveBlocksPerMultiprocessor(&per_cu, (const void*)trunk_fwd, NTHR, LDS_BYTES) != hipSuccess || per_cu < 1) { fprintf(stderr, "kernel_launch: occupancy query says %d\n", per_cu); per_cu = 1; }
        (void)hipGetLastError();
        grid = cus * 1;
        if (grid <= 0) grid = 256;
    }
    if (grid < 0) return;
    Args a{};
    const float** f = (const float**)&a;
    for (int i = 0; i < 24; ++i) f[i] = (const float*)d_in[i];
    a.out = (float*)d_out; a.ws = (unsigned char*)d_ws;
    (void)hipMemsetAsync((unsigned char*)d_ws + WS_CTL, 0, CTL_BYTES, stream);
    void* args[] = {&a};
    hipError_t e = hipLaunchCooperativeKernel((const void*)trunk_fwd, dim3(grid), dim3(NTHR), args, LDS_BYTES, stream);
    if (e != hipSuccess) fprintf(stderr, "kernel_launch: cooperative launch failed: %s (grid %d)\n", hipGetErrorString(e), grid);
}
```

```cpp
#include <hip/hip_runtime.h>
#include <hip/hip_cooperative_groups.h>
#include <hip/hip_bf16.h>
#include <hip/hip_fp16.h>
#include <cstdio>
#include <cstdint>
#include <cmath>
namespace cg = cooperative_groups;

constexpr int DM = 1024, NB = 8, SEQ = 4096, CTXL = 256, DEPTH = 4;
constexpr int ML = NB * SEQ, MC = NB * CTXL, MT = ML + MC;
constexpr int DIN = 2304, DFF = 4096, KVL = SEQ + CTXL;
constexpr float ALPHA = 1.6817928305074290f, EPSN = 1e-6f;
namespace pg8 {
#define PG8_LAS __attribute__((address_space(3)))
typedef unsigned short bf16_t;
typedef short bf16x8 __attribute__((ext_vector_type(8)));
typedef float f32x4 __attribute__((ext_vector_type(4)));
typedef unsigned u32x4 __attribute__((ext_vector_type(4)));
constexpr int BM = 256, BK = 64, HALF = 128, HTB = HALF * BK * 2  , STAGE_BYTES = 8 * HTB, NXCD = 8, WGM = 8;

__host__ __device__ __forceinline__ int lds_byte(int r, int c) { const int st = (r >> 4) * 2 + (c >> 5), rr = r & 15, cc = c & 31, ob = rr * 64 + cc * 2; return st * 1024 + (ob ^ (((ob >> 9) & 1) << 5)); }
__host__ __device__ __forceinline__ void stage_rc(int b, int& R, int& C) { const int st = b / 1024, sb = b % 1024, swz = sb ^ (((sb >> 9) & 1) << 5); R = (st >> 1) * 16 + swz / 64; C = (st & 1) * 32 + (swz % 64) / 2; }
__host__ __device__ __forceinline__ int perm32(int rho) { const int n = rho >> 4, i = rho & 15; return 8 * (i >> 2) + 4 * n + (i & 3); }

struct Unit { int pm, pn, ks; };
struct Gemm { const bf16_t* A; const bf16_t* Bt; int M, N, K; };

struct StaticOrder {
    int nM, nN, nwg, G, c;
    __host__ __device__ void init(int M, int N, int G_, int c_) { nM = M / BM; nN = N / BM; nwg = nM * nN; G = G_; c = c_; }
    __host__ __device__ bool next(int i, Unit& u) const {
        const long L = (long)i * G + c; if (L >= nwg) return false;
        int wgid = (int)L; { const int q = nwg / NXCD, r = nwg % NXCD, xcd = wgid % NXCD, off = wgid / NXCD; wgid = (xcd < r ? xcd * (q + 1) : r * (q + 1) + (xcd - r) * q) + off; }
        const int nig = WGM * nN, gid = wgid / nig, fm = gid * WGM, gsz = (nM - fm) < WGM ? (nM - fm) : WGM;
        u.pm = fm + ((wgid % nig) % gsz); u.pn = (wgid % nig) / gsz; u.ks = -1; return true;
    }
    __device__ __forceinline__ void a_ready(const Unit&) const {}
    __device__ __forceinline__ void done(const Unit&) const {}
};


struct SplitOrder {
    StaticOrder base; int G, c, ksh;
    __host__ __device__ void init(int N, int G_, int c_, int ksh_) { base.init(32768, N, G_, c_); G = G_; c = c_; ksh = ksh_; }
    __host__ __device__ bool next(int i, Unit& u) const {
        if (base.next(i, u)) return true;
        const long L = (long)i * G + c - base.nwg; if (L < 0 || L >= (32 << ksh)) return false;
        u.pm = 128 + (int)(L >> (2 + ksh)); u.pn = (int)(L >> ksh) & 3; u.ks = (int)L & ((1 << ksh) - 1); return true;
    }
    __device__ __forceinline__ void a_ready(const Unit&) const {}
    __device__ __forceinline__ void done(const Unit&) const {}
};
__device__ __forceinline__ unsigned cvt_pk_bf16(float lo, float hi) { unsigned r; asm volatile("v_cvt_pk_bf16_f32 %0, %1, %2" : "=v"(r) : "v"(lo), "v"(hi)); return r; }
typedef unsigned u32x4 __attribute__((ext_vector_type(4)));
__device__ __forceinline__ float fast_sigmoid(float x) { return __builtin_amdgcn_rcpf(1.0f + __expf(-x)); }
__device__ __forceinline__ float act_silu(float x) { return x * fast_sigmoid(x); }
__device__ __forceinline__ float act_gelu_tanh(float x) { const float z = 0.7978845608028654f * (x + 0.044715f * x * x * x); return x * fast_sigmoid(2.0f * z); }
__device__ __forceinline__ u32x4 pack8(const f32x4 a, const f32x4 b) { u32x4 w; w.x = cvt_pk_bf16(a[0], a[1]); w.y = cvt_pk_bf16(a[2], a[3]); w.z = cvt_pk_bf16(b[0], b[1]); w.w = cvt_pk_bf16(b[2], b[3]); return w; }

struct EpiIn {
    static constexpr bool PERM = true, AFTER_DRAIN = false;
    bf16_t* P4;
    bf16_t *AQ, *KB, *VB, *LX, *LG;
    const float *qgain, *kgain, *rope;
    __device__ __forceinline__ void operator()(const f32x4 (&acc)[2][2][4][2], const Unit& u, int wr, int wc, int fr, int fq) const {
        const int pn = u.pn; const int rowb = u.pm * BM + wr * 64 + fr; const bool lat = u.pm < (32768 / BM);
        if (pn < 4 || pn >= 7) {
            bf16_t* base = pn < 4 ? P4 + (size_t)pn * ((size_t)34816 * 256) : (pn == 7 ? LX : LG);
#pragma unroll
            for (int ai = 0; ai < 2; ++ai)
#pragma unroll
                for (int m = 0; m < 4; ++m) { bf16_t* rp = base + (size_t)(rowb + ai * HALF + m * 16) * 256 + 64 * wc + 8 * fq;
#pragma unroll
                    for (int bj = 0; bj < 2; ++bj) { f32x4 v0 = acc[ai][bj][m][0], v1 = acc[ai][bj][m][1];
                        if (pn == 1) { v0 = v0 * 0.125f; v1 = v1 * 0.125f; }
                        else if (pn == 3) {
#pragma unroll
                            for (int e = 0; e < 4; ++e) { v0[e] = act_silu(v0[e]); v1[e] = act_silu(v1[e]); } }
                        else if (pn == 8) {
#pragma unroll
                            for (int e = 0; e < 4; ++e) { v0[e] = act_gelu_tanh(v0[e]); v1[e] = act_gelu_tanh(v1[e]); } }
                        *(u32x4*)(rp + 32 * bj) = pack8(v0, v1); } }
        } else if (pn < 6 || wc < 2) {
            const bool isq = pn < 6; const float* gain = isq ? qgain : kgain;
            const float post = isq ? (0.125f * 1.4426950408889634f) : 1.0f;
            float invf[2][4];
#pragma unroll
            for (int n = 0; n < 2; ++n)
#pragma unroll
                for (int e = 0; e < 4; ++e) invf[n][e] = __builtin_amdgcn_exp2f(-(float)((8 * fq + 4 * n + e) & 15) * (13.287712379549449f / 16.0f)) * 0.15915494309189535f;
#pragma unroll
            for (int ai = 0; ai < 2; ++ai)
#pragma unroll
                for (int m = 0; m < 4; ++m) { const int row = rowb + ai * HALF + m * 16;
                    float ss = 0.f;
#pragma unroll
                    for (int bj = 0; bj < 2; ++bj)
#pragma unroll
                        for (int n = 0; n < 2; ++n) { const f32x4 x = acc[ai][bj][m][n]; ss += (x[0] * x[0] + x[1] * x[1]) + (x[2] * x[2] + x[3] * x[3]); }
                    ss += __shfl_xor(ss, 16); ss += __shfl_xor(ss, 32);
                    const float rs = rsqrtf(ss * (1.0f / 64.0f) + 1e-6f);
                    f32x4 o1[2], o2[2];
#pragma unroll
                    for (int n = 0; n < 2; ++n) { o1[n] = acc[ai][0][m][n] * rs * *(const f32x4*)(gain + 8 * fq + 4 * n); o2[n] = acc[ai][1][m][n] * rs * *(const f32x4*)(gain + 32 + 8 * fq + 4 * n); }
                    if (lat) { const int t = row & 4095; const float pos = (float)(fq < 2 ? (t >> 6) : (t & 63));
#pragma unroll
                        for (int n = 0; n < 2; ++n)
#pragma unroll
                            for (int e = 0; e < 4; ++e) { const float rev = pos * invf[n][e]; const float c = __builtin_amdgcn_cosf(rev), s = __builtin_amdgcn_sinf(rev);
                                const float x1 = o1[n][e], x2 = o2[n][e]; o1[n][e] = x1 * c - x2 * s; o2[n][e] = x1 * s + x2 * c; } }
#pragma unroll
                    for (int n = 0; n < 2; ++n) { o1[n] = o1[n] * post; o2[n] = o2[n] * post; }
                    asm volatile("" ::: "memory");
                    bf16_t* dst;
                    if (isq) dst = AQ + (size_t)row * 512 + ((pn - 4) * 4 + wc) * 64 + 8 * fq;
                    else { const int j = row - 32768; const int kvrow = lat ? (row >> 12) * 4352 + (row & 4095) : (j >> 8) * 4352 + 4096 + (j & 255); dst = KB + (size_t)kvrow * 128 + wc * 64 + 8 * fq; }
                    *(u32x4*)dst = pack8(o1[0], o1[1]); *(u32x4*)(dst + 32) = pack8(o2[0], o2[1]); }
        } else {
#pragma unroll
            for (int ai = 0; ai < 2; ++ai)
#pragma unroll
                for (int m = 0; m < 4; ++m) { const int row = rowb + ai * HALF + m * 16; const int j = row - 32768;
                    const int kvrow = lat ? (row >> 12) * 4352 + (row & 4095) : (j >> 8) * 4352 + 4096 + (j & 255);
                    bf16_t* dst = VB + (size_t)kvrow * 128 + (wc - 2) * 64 + 8 * fq;
#pragma unroll
                    for (int bj = 0; bj < 2; ++bj) *(u32x4*)(dst + 32 * bj) = pack8(acc[ai][bj][m][0], acc[ai][bj][m][1]); }
        }
    }
};

struct EpiFF1 {
    static constexpr bool PERM = true, AFTER_DRAIN = false;
    bf16_t* H;
    __device__ __forceinline__ void operator()(const f32x4 (&acc)[2][2][4][2], const Unit& u, int wr, int wc, int fr, int fq) const {
        const int rowb = u.pm * BM + wr * 64 + fr; const int col0 = u.pn * BM + wc * 64 + 8 * fq;
#pragma unroll
        for (int ai = 0; ai < 2; ++ai)
#pragma unroll
            for (int m = 0; m < 4; ++m) { bf16_t* rp = H + (size_t)(rowb + ai * HALF + m * 16) * 4096 + col0;
#pragma unroll
                for (int bj = 0; bj < 2; ++bj) { f32x4 v0 = acc[ai][bj][m][0], v1 = acc[ai][bj][m][1];
#pragma unroll
                    for (int e = 0; e < 4; ++e) { const float a = fmaxf(v0[e], 0.f), b = fmaxf(v1[e], 0.f); v0[e] = a * a; v1[e] = b * b; }
                    __builtin_nontemporal_store(pack8(v0, v1), (u32x4*)(rp + bj * 32)); } }
    }
};

struct EpiRes {
    static constexpr bool PERM = true, AFTER_DRAIN = false;
    const float *rinL, *rinC; float *routL, *routC; const float* gate;
    float* part;
    const bf16_t* rinB;
    bf16_t* vout;
    __device__ __forceinline__ void operator()(const f32x4 (&acc)[2][2][4][2], const Unit& u, int wr, int wc, int fr, int fq) const {
        const bool lat = u.pm < (32768 / BM); const int bb = lat ? (u.pm >> 4) : 8;
        const int rowb = u.pm * BM + wr * 64 + fr; const int col0 = u.pn * BM + wc * 64 + 8 * fq;
        if (u.ks >= 0) { bf16_t* pb = (bf16_t*)part + ((size_t)u.ks * 2048 - 32768) * 1024;
#pragma unroll
            for (int ai = 0; ai < 2; ++ai)
#pragma unroll
                for (int m = 0; m < 4; ++m) { const size_t off = (size_t)(rowb + ai * HALF + m * 16) * 1024 + col0;
#pragma unroll
                    for (int bj = 0; bj < 2; ++bj) *(u32x4*)(pb + off + bj * 32) = pack8(acc[ai][bj][m][0], acc[ai][bj][m][1]); }
            return; }
        const float* gp = gate + (size_t)bb * 6144 + col0;
        f32x4 gv[2][2];
#pragma unroll
        for (int bj = 0; bj < 2; ++bj)
#pragma unroll
            for (int n = 0; n < 2; ++n) gv[bj][n] = *(const f32x4*)(gp + bj * 32 + n * 4);
        const float* ib = lat ? rinL : rinC - (size_t)32768 * 1024; float* ob = lat ? routL : routC - (size_t)32768 * 1024;
        const bool tobf = lat && vout != nullptr;
#pragma unroll
        for (int ai = 0; ai < 2; ++ai)
#pragma unroll
            for (int m = 0; m < 4; ++m) { const size_t off = (size_t)(rowb + ai * HALF + m * 16) * 1024 + col0;
#pragma unroll
                for (int bj = 0; bj < 2; ++bj) { f32x4 o[2];
                    if (lat && rinB) { const u32x4 w = *(const u32x4*)(rinB + off + bj * 32);
                        const f32x4 b0 = {__builtin_bit_cast(float, w.x << 16), __builtin_bit_cast(float, w.x & 0xffff0000u), __builtin_bit_cast(float, w.y << 16), __builtin_bit_cast(float, w.y & 0xffff0000u)};
                        const f32x4 b1 = {__builtin_bit_cast(float, w.z << 16), __builtin_bit_cast(float, w.z & 0xffff0000u), __builtin_bit_cast(float, w.w << 16), __builtin_bit_cast(float, w.w & 0xffff0000u)};
                        o[0] = b0 * 1.6817928305074290f + gv[bj][0] * acc[ai][bj][m][0]; o[1] = b1 * 1.6817928305074290f + gv[bj][1] * acc[ai][bj][m][1]; }
                    else {
#pragma unroll
                    for (int n = 0; n < 2; ++n) { const f32x4 bs = *(const f32x4*)(ib + off + bj * 32 + n * 4); o[n] = bs * 1.6817928305074290f + gv[bj][n] * acc[ai][bj][m][n]; } }
                    if (tobf) *(u32x4*)(vout + off + bj * 32) = pack8(o[0], o[1]);
                    else { *(f32x4*)(ob + off + bj * 32) = o[0]; *(f32x4*)(ob + off + bj * 32 + 4) = o[1]; } }
                if (m == 3) asm volatile("" ::: "memory"); }
    }
};

struct EpiNull {
    static constexpr bool PERM = false, AFTER_DRAIN = false;
    float* sink;
    __device__ __forceinline__ void operator()(const f32x4 (&acc)[2][2][4][2], const Unit& u, int wr, int wc, int fr, int fq) const {
        float s = 0.f;
#pragma unroll
        for (int ai = 0; ai < 2; ++ai)
#pragma unroll
            for (int bj = 0; bj < 2; ++bj)
#pragma unroll
                for (int m = 0; m < 4; ++m)
#pragma unroll
                    for (int n = 0; n < 2; ++n) s += acc[ai][bj][m][n][0] + acc[ai][bj][m][n][1] + acc[ai][bj][m][n][2] + acc[ai][bj][m][n][3];
        if (s == 123.456f) sink[0] = s;
    }
};
template <class Epi, class Sched, bool ALIGN_EPI = false, bool SP2 = false>
__device__ __forceinline__ void gemm_phase(PG8_LAS unsigned char* lds, const Gemm g, const Sched& S, const Epi& E) {
    int tid = threadIdx.x; asm volatile("" : "+v"(tid));
    const int wid = __builtin_amdgcn_readfirstlane(tid >> 6), lane = tid & 63, wr = wid >> 2, wc = wid & 3, fr = lane & 15, fq = lane >> 4;
    const int K = g.K, nt = K / BK;
    const int ksh = (K >= 4096) ? 3 : 2;
#define PG8_NT(u_) ((u_).ks < 0 ? nt : (nt >> ksh))
#define PG8_KOFF(u_) ((u_).ks < 0 ? (size_t)0 : (size_t)(u_).ks * (size_t)(K >> ksh) * 2)
    unsigned voffA[2], voffB[2];
#pragma unroll
    for (int i = 0; i < 2; ++i) { int R, C; stage_rc(tid * 16 + i * 8192, R, C); const int Rb = Epi::PERM ? ((R & ~31) + perm32(R & 31)) : R;
        voffA[i] = (unsigned)(R * K + C) * 2u; voffB[i] = (unsigned)(Rb * K + C) * 2u; }
    const size_t kstep = (size_t)(BK * 2);
    const size_t hstep = (size_t)HALF * K * 2;
    const size_t tstep = 2 * hstep;
    const unsigned ldsw = (unsigned)wid * 1024u;
    const int aoff = lds_byte(wr * 64 + fr, fq * 8), boff = lds_byte(wc * 32 + fr, fq * 8);
#define PG8_SA(b, h) (((b) * 2 + (h)) * HTB)
#define PG8_SB(b, h) ((4 + (b) * 2 + (h)) * HTB)
#define PG8_STAGE(bufoff, gbase, voff) do { _Pragma("unroll") for (int _i = 0; _i < 2; ++_i) \
        __builtin_amdgcn_global_load_lds((const unsigned*)((const char*)(gbase) + (voff)[_i]), (PG8_LAS unsigned*)(lds + (bufoff) + ldsw + _i * 8192), 16, 0, 0); } while (0)
#define PG8_LDA(dst, b, h) do { _Pragma("unroll") for (int m = 0; m < 4; ++m) _Pragma("unroll") for (int k = 0; k < 2; ++k) dst[m][k] = *(const PG8_LAS bf16x8*)(lds + PG8_SA(b, h) + aoff + m * 2048 + k * 1024); } while (0)
#define PG8_LDB(dst, b, h) do { _Pragma("unroll") for (int n = 0; n < 2; ++n) _Pragma("unroll") for (int k = 0; k < 2; ++k) dst[n][k] = *(const PG8_LAS bf16x8*)(lds + PG8_SB(b, h) + boff + n * 2048 + k * 1024); } while (0)
#define PG8_MMA(ai, bj, At, Bt) do { __builtin_amdgcn_s_setprio(1); _Pragma("unroll") for (int m = 0; m < 4; ++m) _Pragma("unroll") for (int n = 0; n < 2; ++n) _Pragma("unroll") for (int k = 0; k < 2; ++k) \
        acc[ai][bj][m][n] = __builtin_amdgcn_mfma_f32_16x16x32_bf16(Bt[n][k], At[m][k], acc[ai][bj][m][n], 0, 0, 0); __builtin_amdgcn_s_setprio(0); } while (0)
#define PG8_WAIT_V(n) asm volatile("s_waitcnt vmcnt(" #n ")" ::: "memory")
#define PG8_WAIT_L(n) asm volatile("s_waitcnt lgkmcnt(" #n ")" ::: "memory")
#define PG8_BAR __builtin_amdgcn_s_barrier()
#define PG8_SCHED __builtin_amdgcn_sched_barrier(0)
    Unit cur, nxt; int ui = 0;
    if (!S.next(0, cur)) return;
    f32x4 acc[2][2][4][2];
#pragma unroll
    for (int a = 0; a < 2; ++a)
#pragma unroll
        for (int b = 0; b < 2; ++b)
#pragma unroll
            for (int m = 0; m < 4; ++m)
#pragma unroll
                for (int n = 0; n < 2; ++n) acc[a][b][m][n] = (f32x4){0.f, 0.f, 0.f, 0.f};
    bf16x8 At[4][2], B0[2][2], B1[2][2];
    const char* cA = (const char*)g.A + (size_t)cur.pm * tstep + PG8_KOFF(cur); const char* cB = (const char*)g.Bt + (size_t)cur.pn * tstep + PG8_KOFF(cur);
    S.a_ready(cur);
    if constexpr (SP2) {
        PG8_STAGE(PG8_SB(0, 0), cB, voffB); PG8_STAGE(PG8_SB(0, 1), cB + hstep, voffB); PG8_STAGE(PG8_SA(0, 0), cA, voffA); PG8_STAGE(PG8_SA(0, 1), cA + hstep, voffA);
        if (wr == 1) PG8_BAR;
        PG8_WAIT_V(2); PG8_BAR;
        PG8_STAGE(PG8_SB(1, 0), cB + kstep, voffB); PG8_STAGE(PG8_SA(1, 0), cA + kstep, voffA); PG8_STAGE(PG8_SB(1, 1), cB + hstep + kstep, voffB);
        PG8_WAIT_V(6); PG8_BAR;
    } else {
        PG8_STAGE(PG8_SB(0, 0), cB, voffB); PG8_STAGE(PG8_SA(0, 0), cA, voffA); PG8_STAGE(PG8_SB(0, 1), cB + hstep, voffB); PG8_STAGE(PG8_SA(0, 1), cA + hstep, voffA);
        if (wr == 1) PG8_BAR;
        PG8_WAIT_V(4); PG8_BAR;
        PG8_STAGE(PG8_SB(1, 0), cB + kstep, voffB); PG8_STAGE(PG8_SA(1, 0), cA + kstep, voffA); PG8_STAGE(PG8_SB(1, 1), cB + hstep + kstep, voffB);
        PG8_WAIT_V(6); PG8_BAR;
    }
    for (;;) {
        const bool has_next = S.next(ui + 1, nxt);
        const char* nA = has_next ? (const char*)g.A + (size_t)nxt.pm * tstep + PG8_KOFF(nxt) : cA; const char* nB = has_next ? (const char*)g.Bt + (size_t)nxt.pn * tstep + PG8_KOFF(nxt) : cB;
        const int ntc = PG8_NT(cur);
        for (int t = 0; t < ntc; t += 2) {
            const bool last = (t == ntc - 2);
            const char* a1 = cA + (size_t)(t + 1) * kstep;
            const char* a2 = last ? nA : cA + (size_t)(t + 2) * kstep; const char* b2 = last ? nB : cB + (size_t)(t + 2) * kstep;
            const char* a3 = a2 + kstep; const char* b3 = b2 + kstep;
            if (last && has_next) S.a_ready(nxt);
            if constexpr (SP2) {
            PG8_LDB(B0, 0, 0); PG8_LDB(B1, 0, 1); PG8_SCHED; PG8_LDA(At, 0, 0); PG8_STAGE(PG8_SA(1, 1), a1 + hstep, voffA);
            PG8_WAIT_V(8); PG8_WAIT_L(0); PG8_BAR; PG8_MMA(0, 0, At, B0); PG8_MMA(0, 1, At, B1); PG8_BAR; PG8_SCHED;
            PG8_LDA(At, 0, 1); PG8_STAGE(PG8_SB(0, 0), b2, voffB); PG8_STAGE(PG8_SB(0, 1), b2 + hstep, voffB); PG8_STAGE(PG8_SA(0, 0), a2, voffA);
            PG8_WAIT_V(8); PG8_WAIT_L(0); PG8_BAR; PG8_MMA(1, 0, At, B0); PG8_MMA(1, 1, At, B1); PG8_BAR; PG8_SCHED;
            PG8_LDB(B0, 1, 0); PG8_LDB(B1, 1, 1); PG8_SCHED; PG8_LDA(At, 1, 0); PG8_STAGE(PG8_SA(0, 1), a2 + hstep, voffA);
            PG8_WAIT_V(8); PG8_WAIT_L(0); PG8_BAR; PG8_MMA(0, 0, At, B0); PG8_MMA(0, 1, At, B1); PG8_BAR; PG8_SCHED;
            PG8_LDA(At, 1, 1); PG8_STAGE(PG8_SB(1, 0), b3, voffB); PG8_STAGE(PG8_SB(1, 1), b3 + hstep, voffB); PG8_STAGE(PG8_SA(1, 0), a3, voffA);
            PG8_WAIT_V(8); PG8_WAIT_L(0); PG8_BAR; PG8_MMA(1, 0, At, B0); PG8_MMA(1, 1, At, B1); PG8_BAR; PG8_SCHED;
            } else {
            PG8_LDB(B0, 0, 0); PG8_SCHED; PG8_LDA(At, 0, 0); PG8_STAGE(PG8_SA(1, 1), a1 + hstep, voffA);
            PG8_WAIT_L(8); PG8_BAR; PG8_WAIT_L(0); PG8_MMA(0, 0, At, B0); PG8_BAR; PG8_SCHED;
            PG8_LDB(B1, 0, 1); PG8_STAGE(PG8_SB(0, 0), b2, voffB);
            PG8_BAR; PG8_WAIT_L(0); PG8_MMA(0, 1, At, B1); PG8_BAR;
            PG8_LDA(At, 0, 1); PG8_STAGE(PG8_SA(0, 0), a2, voffA);
            PG8_BAR; PG8_WAIT_L(0); PG8_MMA(1, 0, At, B0); PG8_BAR; PG8_SCHED;
            PG8_STAGE(PG8_SB(0, 1), b2 + hstep, voffB);
            PG8_WAIT_V(6); PG8_BAR; PG8_MMA(1, 1, At, B1); PG8_BAR;
            PG8_LDB(B0, 1, 0); PG8_SCHED; PG8_LDA(At, 1, 0); PG8_STAGE(PG8_SA(0, 1), a2 + hstep, voffA);
            PG8_WAIT_L(8); PG8_BAR; PG8_WAIT_L(0); PG8_MMA(0, 0, At, B0); PG8_BAR; PG8_SCHED;
            PG8_LDB(B1, 1, 1); PG8_STAGE(PG8_SB(1, 0), b3, voffB);
            PG8_BAR; PG8_WAIT_L(0); PG8_MMA(0, 1, At, B1); PG8_BAR;
            PG8_LDA(At, 1, 1); PG8_STAGE(PG8_SA(1, 0), a3, voffA);
            PG8_BAR; PG8_WAIT_L(0); PG8_MMA(1, 0, At, B0); PG8_BAR; PG8_SCHED;
            PG8_STAGE(PG8_SB(1, 1), b3 + hstep, voffB);
            PG8_WAIT_V(6); PG8_BAR; PG8_MMA(1, 1, At, B1); PG8_BAR;
            }
        }
        if constexpr (ALIGN_EPI) { if (wr == 0) PG8_BAR; }
        if constexpr (!Epi::AFTER_DRAIN) { E(acc, cur, wr, wc, fr, fq); S.done(cur); }
        if (!has_next) break;
#pragma unroll
        for (int a = 0; a < 2; ++a)
#pragma unroll
            for (int b = 0; b < 2; ++b)
#pragma unroll
                for (int m = 0; m < 4; ++m)
#pragma unroll
                    for (int n = 0; n < 2; ++n) acc[a][b][m][n] = (f32x4){0.f, 0.f, 0.f, 0.f};
        cur = nxt; cA = nA; cB = nB; ++ui;
        if constexpr (ALIGN_EPI) { if (wr == 1) PG8_BAR; }
    }
    PG8_WAIT_V(0);
    if constexpr (!ALIGN_EPI) { if (wr == 0) PG8_BAR; }
    PG8_BAR;
    if constexpr (Epi::AFTER_DRAIN) { E.fused(acc, cur, wr, wc, fr, fq, lds, wid, lane); S.done(cur); }
#undef PG8_NT
#undef PG8_KOFF
#undef PG8_SA
#undef PG8_SB
#undef PG8_STAGE
#undef PG8_LDA
#undef PG8_LDB
#undef PG8_MMA
#undef PG8_WAIT_V
#undef PG8_WAIT_L
#undef PG8_BAR
#undef PG8_SCHED
}
}
#include <hip/hip_bf16.h>
namespace attn_body {
using bf16=__hip_bfloat16;
using bf16x8=__attribute__((ext_vector_type(8)))short;
using s16x4=__attribute__((ext_vector_type(4)))short;
using f32x16=__attribute__((ext_vector_type(16)))float;
using u32x4=__attribute__((ext_vector_type(4)))unsigned;
constexpr int D=64,QP=512,KP=128,OP=1024;
constexpr int NW=8,QBLK=32,QB=QBLK*NW,KVBLK=64;
__device__ __forceinline__ int crow(int r,int hi){return (r&3)+8*(r>>2)+4*hi;}
#define SBAR() __builtin_amdgcn_sched_barrier(0)
__device__ __forceinline__ void cmask(f32x16&p0,f32x16&p1,int jb,int qrel,int hi){
  const float NEG=-INFINITY; int kb=64*jb+4*hi;
  #pragma unroll
  for(int r=0;r<16;++r){int kv=kb+(r&3)+8*(r>>2); if(kv>qrel)p0[r]=NEG; if(kv+32>qrel)p1[r]=NEG;}
}

constexpr int NSLOT=3, SLOTB=8192;
constexpr int LDS_K=0, LDS_V=NSLOT*SLOTB, LDS_WS=2*NSLOT*SLOTB, LDS_OST=LDS_WS+NW*64*4, LDS_BYTES=LDS_OST+NW*4096;
constexpr float C2=0.125f*1.4426950408889634f;
__device__ __forceinline__ void glds16(const void*gsrc,unsigned lds_dst){unsigned keep;
  asm volatile("s_mov_b32 %0, m0\n\ts_mov_b32 m0, %2\n\ts_nop 0\n\tglobal_load_lds_dwordx4 %1, off\n\ts_mov_b32 m0, %0":"=&s"(keep):"v"(gsrc),"s"(lds_dst):"memory");}
__device__ __forceinline__ float max3f(float a,float b,float c){float r;asm("v_max3_f32 %0, %1, %2, %3":"=v"(r):"v"(a),"v"(b),"v"(c));return r;}
__device__ __forceinline__ float max2f(float a,float b){float r;asm("v_max_f32_e32 %0, %1, %2":"=v"(r):"v"(a),"v"(b));return r;}
__device__ __forceinline__ float fadd_s(float a,float b){float r;asm("v_add_f32_e32 %0, %1, %2":"=v"(r):"v"(a),"v"(b));return r;}
__device__ __forceinline__ float fsub_s(float a,float b){float r;asm("v_sub_f32_e32 %0, %1, %2":"=v"(r):"v"(a),"v"(b));return r;}
typedef float f32x2_t __attribute__((ext_vector_type(2))); typedef __bf16 bf16x2_t __attribute__((ext_vector_type(2)));
__device__ __forceinline__ unsigned cvtpk_s(float lo,float hi){f32x2_t v={lo,hi};bf16x2_t b=__builtin_convertvector(v,bf16x2_t);return __builtin_bit_cast(unsigned,b);}
#define WAIT_BAR(N) asm volatile("s_waitcnt vmcnt(" #N ") lgkmcnt(0)\n\ts_barrier":::"memory")

__device__ __forceinline__ void qkt(f32x16&p0,f32x16&p1,const char*Kslot,const bf16x8*qr,const f32x16&negm,int r32,int hi){
  const char*kb=Kslot+hi*1024+r32*16;
  #pragma unroll
  for(int d0=0;d0<4;++d0){
    const bf16x8 b0=*reinterpret_cast<const bf16x8*>(kb+d0*2048);
    const bf16x8 b1=*reinterpret_cast<const bf16x8*>(kb+d0*2048+512);
    if(d0==0){p0=__builtin_amdgcn_mfma_f32_32x32x16_bf16(b0,qr[0],negm,0,0,0);p1=__builtin_amdgcn_mfma_f32_32x32x16_bf16(b1,qr[0],negm,0,0,0);}
    else{p0=__builtin_amdgcn_mfma_f32_32x32x16_bf16(b0,qr[d0],p0,0,0,0);p1=__builtin_amdgcn_mfma_f32_32x32x16_bf16(b1,qr[d0],p1,0,0,0);}}
}
typedef __attribute__((address_space(3))) const char* lds_cptr;
typedef short v4i16_t __attribute__((ext_vector_type(4)));
__device__ __forceinline__ void kload8(bf16x8*kf,lds_cptr kp){
  kf[0]=*(const __attribute__((address_space(3))) bf16x8*)(kp);      kf[1]=*(const __attribute__((address_space(3))) bf16x8*)(kp+512);
  kf[2]=*(const __attribute__((address_space(3))) bf16x8*)(kp+2048); kf[3]=*(const __attribute__((address_space(3))) bf16x8*)(kp+2560);
  kf[4]=*(const __attribute__((address_space(3))) bf16x8*)(kp+4096); kf[5]=*(const __attribute__((address_space(3))) bf16x8*)(kp+4608);
  kf[6]=*(const __attribute__((address_space(3))) bf16x8*)(kp+6144); kf[7]=*(const __attribute__((address_space(3))) bf16x8*)(kp+6656);
}
__device__ __forceinline__ void kload2(bf16x8*kf,lds_cptr kp,int j){ kf[2*j]=*(const __attribute__((address_space(3))) bf16x8*)(kp+j*2048); kf[2*j+1]=*(const __attribute__((address_space(3))) bf16x8*)(kp+j*2048+512); }
__device__ __forceinline__ s16x4 vtr(lds_cptr p){ return __builtin_bit_cast(s16x4,__builtin_amdgcn_ds_read_tr16_b64_v4i16((__attribute__((address_space(3))) v4i16_t*)p)); }
__device__ __forceinline__ float rowmax(const f32x16&p0,const f32x16&p1){
  float a=max3f(p0[0],p0[1],p1[0]),b=max3f(p0[2],p0[3],p1[1]);a=max3f(a,p1[2],p1[3]);
  #pragma unroll
  for(int r=4;r<16;r+=4){a=max3f(a,p0[r],p0[r+1]);b=max3f(b,p0[r+2],p0[r+3]);a=max3f(a,p1[r],p1[r+1]);b=max3f(b,p1[r+2],p1[r+3]);}
  const float m=max2f(a,b);
  auto rr=__builtin_amdgcn_permlane32_swap(__float_as_uint(m),__float_as_uint(m),false,false);
  return max2f(__uint_as_float(rr[0]),__uint_as_float(rr[1]));
}
__device__ __forceinline__ void pv(f32x16*o,int vb,bf16x8 pa0,bf16x8 pa1,bf16x8 pa2,bf16x8 pa3){
  #pragma unroll
  for(int d0=0;d0<2;++d0){s16x4 lo[4],hi[4];
    #pragma unroll
    for(int ks=0;ks<4;++ks){
      asm volatile("ds_read_b64_tr_b16 %0,%1 offset:%c2":"=&v"(lo[ks]):"v"(vb),"i"(d0*4096+ks*1024):"memory");
      asm volatile("ds_read_b64_tr_b16 %0,%1 offset:%c2":"=&v"(hi[ks]):"v"(vb),"i"(d0*4096+ks*1024+512):"memory");}
    asm volatile("s_waitcnt lgkmcnt(0)":::"memory");SBAR();
    #define PK(k) (bf16x8){lo[k][0],lo[k][1],lo[k][2],lo[k][3],hi[k][0],hi[k][1],hi[k][2],hi[k][3]}
    o[d0]=__builtin_amdgcn_mfma_f32_32x32x16_bf16(pa0,PK(0),o[d0],0,0,0);
    o[d0]=__builtin_amdgcn_mfma_f32_32x32x16_bf16(pa1,PK(1),o[d0],0,0,0);
    o[d0]=__builtin_amdgcn_mfma_f32_32x32x16_bf16(pa2,PK(2),o[d0],0,0,0);
    o[d0]=__builtin_amdgcn_mfma_f32_32x32x16_bf16(pa3,PK(3),o[d0],0,0,0);
    #undef PK
  }
}
#define ATTN_STORE16(p,v) (*(u32x4*)(p)=(v))
template<int THRL> __device__ __forceinline__ void attn_unit(const bf16*Qu,const bf16*__restrict__ Kh,const bf16*__restrict__ Vh,bf16*Ou,const int NT,char*shm){
  int tid=threadIdx.x; asm volatile("":"+v"(tid)); const int lane=tid&63,r32=lane&31,hi=lane>>5; const int wid=__builtin_amdgcn_readfirstlane(tid>>6);
  const bf16*Qw=Qu+(long)(wid*QBLK)*QP;
  const unsigned lds0=(unsigned)(uintptr_t)shm;
  float*wsf=(float*)(shm+LDS_WS)+wid*64;
  const bf16*ksrc=Kh+(long)lane*KP+wid*8;
  const bf16*vsrc=Vh+(long)(16*(wid&3)+(lane>>2))*KP+(wid>>2)*32+(lane&3)*8;
  const unsigned kdst=lds0+LDS_K+wid*1024, vdst=lds0+LDS_V+wid*1024;
  #define DMA_K(t,slot) glds16(ksrc+(long)(t)*KVBLK*KP,(unsigned)__builtin_amdgcn_readfirstlane(kdst+(slot)))
  #define DMA_V(t,slot) glds16(vsrc+(long)(t)*KVBLK*KP,(unsigned)__builtin_amdgcn_readfirstlane(vdst+(slot)))
  const int vb0=(int)(lds0+LDS_V)+((lane>>4)&1)*32+(lane&3)*8+(4*hi+((lane&15)>>2))*64;
  const char*Kbase=shm+LDS_K; bf16x8 kf[8];
  const lds_cptr shm3=(lds_cptr)shm; const lds_cptr kp0=shm3+LDS_K+hi*1024+r32*16; const lds_cptr vp0=shm3+LDS_V+((lane>>4)&1)*32+(lane&3)*8+(4*hi+((lane&15)>>2))*64;
  DMA_K(0,0);DMA_V(0,0);DMA_K(1,SLOTB);
  bf16x8 qr[4];
  #pragma unroll
  for(int d0=0;d0<4;++d0)qr[d0]=*reinterpret_cast<const bf16x8*>(&Qw[(long)r32*QP+d0*16+hi*8]);
  float mhat=0.f,l_reg=0.f;f32x16 o[2];o[0]=f32x16{};o[1]=f32x16{};f32x16 negm=f32x16{};asm volatile("":"+v"(negm));
  #define CMASK(P0,P1,t) do{}while(0)
  bool resc=false;
  #define START(P0,P1) do{ const float rm=rowmax(P0,P1); resc=false; \
    { const float dl=rm; mhat=fadd_s(mhat,dl); \
      _Pragma("unroll") for(int r=0;r<16;++r){P0[r]=fsub_s(P0[r],dl);P1[r]=fsub_s(P1[r],dl);} \
      _Pragma("unroll") for(int r=0;r<16;++r)negm[r]=-mhat; asm volatile("":"+v"(negm)); } \
    _Pragma("unroll") for(int r=0;r<16;++r)P0[r]=__builtin_amdgcn_exp2f(P0[r]); }while(0)
  #define RESC() do{ if(resc){ asm volatile("s_waitcnt lgkmcnt(0)":::"memory"); \
      _Pragma("unroll") for(int d_=0;d_<2;++d_) _Pragma("unroll") for(int r=0;r<16;++r)o[d_][r]*=wsf[crow(r,hi)]; } }while(0)
  f32x16 pA0,pA1,pB0,pB1;
  int sl_prev=0,sl_cur=0,sl_next=SLOTB;
  #define ROT() do{sl_prev=sl_cur;sl_cur=sl_next;sl_next=(sl_next==(NSLOT-1)*SLOTB)?0:sl_next+SLOTB;}while(0)
  DMA_K(2,2*SLOTB);
  WAIT_BAR(3);
  qkt(pA0,pA1,Kbase,qr,negm,r32,hi);asm volatile("s_nop 15\n\ts_nop 7":"+v"(pA0),"+v"(pA1));CMASK(pA0,pA1,0);
  START(pA0,pA1);
  _Pragma("unroll") for(int r=0;r<16;++r)pA1[r]=__builtin_amdgcn_exp2f(pA1[r]);
  WAIT_BAR(0);
  DMA_K(3,0);DMA_V(1,SLOTB);
  ROT();
  kload8(kf,kp0+sl_cur);
  WAIT_BAR(2);
  s16x4 vlo[8],vhi[8]; u32x4 pw0,pw1,pw2,pw3;
  #define PKW(P,B) cvtpk_s(P[B],P[B+1])
  #define PAF(k) __builtin_bit_cast(bf16x8,pw##k)
  #define VFR(i) (bf16x8){vlo[i][0],vlo[i][1],vlo[i][2],vlo[i][3],vhi[i][0],vhi[i][1],vhi[i][2],vhi[i][3]}
  #define PIN(x) asm volatile("":"+v"(x))
  #define MX3(a,b,c) __builtin_fmaxf(__builtin_fmaxf((a),(b)),(c))
  #define GAPA(MF,A0,A1,A2,A3,W0,W1,PW) do{ MF; sacc+=A0; sacc+=A1; sacc+=A2; sacc+=A3; PIN(sacc); W0; W1; PIN(PW); SBAR(); }while(0)
  #define EX(v) __builtin_amdgcn_exp2f(v)
  #define GAPB(MF,X,B) do{ MF; X[B]=EX(X[B]); X[B+1]=EX(X[B+1]); X[B+2]=EX(X[B+2]); X[B+3]=EX(X[B+3]); PIN(X); SBAR(); }while(0)
  #define VRD(i) do{ vlo[i]=vtr(vp_+(((i)>>2)*4096+((i)&3)*1024)); vhi[i]=vtr(vp_+(((i)>>2)*4096+((i)&3)*1024+512)); }while(0)
  #define KRD(G,j) do{ if(G){ kload2(kf,kp0+sl_next,j); SBAR(); } }while(0)
  #define STEP(C0,C1,P0,P1,t,GK,GV,GL) do{ SBAR(); \
    const lds_cptr vp_=vp0+sl_prev; \
    VRD(0); SBAR(); float sacc=(P0[0]+P0[1]); \
    GAPA(C0=__builtin_amdgcn_mfma_f32_32x32x16_bf16(kf[0],qr[0],negm,0,0,0), P0[2],P0[3],P0[4],P0[5],     pw0[0]=PKW(P0,0), pw0[1]=PKW(P0,2), pw0); \
    VRD(4); SBAR(); GAPA(C1=__builtin_amdgcn_mfma_f32_32x32x16_bf16(kf[1],qr[0],negm,0,0,0), P0[6],P0[7],P0[8],P0[9],     pw0[2]=PKW(P0,4), pw0[3]=PKW(P0,6), pw0); \
    VRD(1); SBAR(); GAPA(C0=__builtin_amdgcn_mfma_f32_32x32x16_bf16(kf[2],qr[1],C0,0,0,0),   P0[10],P0[11],P0[12],P0[13], pw1[0]=PKW(P0,8), pw1[1]=PKW(P0,10), pw1); \
    VRD(5); SBAR(); GAPA(C1=__builtin_amdgcn_mfma_f32_32x32x16_bf16(kf[3],qr[1],C1,0,0,0),   P0[14],P0[15],P1[0],P1[1],   pw1[2]=PKW(P0,12),pw1[3]=PKW(P0,14), pw1); \
    VRD(2); SBAR(); GAPA(C0=__builtin_amdgcn_mfma_f32_32x32x16_bf16(kf[4],qr[2],C0,0,0,0),   P1[2],P1[3],P1[4],P1[5],     pw2[0]=PKW(P1,0), pw2[1]=PKW(P1,2), pw2); \
    VRD(6); SBAR(); GAPA(C1=__builtin_amdgcn_mfma_f32_32x32x16_bf16(kf[5],qr[2],C1,0,0,0),   P1[6],P1[7],P1[8],P1[9],     pw2[2]=PKW(P1,4), pw2[3]=PKW(P1,6), pw2); \
    VRD(3); SBAR(); GAPA(C0=__builtin_amdgcn_mfma_f32_32x32x16_bf16(kf[6],qr[3],C0,0,0,0),   P1[10],P1[11],P1[12],P1[13], pw3[0]=PKW(P1,8), pw3[1]=PKW(P1,10), pw3); \
    VRD(7); SBAR(); GAPA(C1=__builtin_amdgcn_mfma_f32_32x32x16_bf16(kf[7],qr[3],C1,0,0,0),   P1[14],P1[15],0.f,0.f,       pw3[2]=PKW(P1,12),pw3[3]=PKW(P1,14), pw3); \
    l_reg+=sacc; \
    if(GK){DMA_K((t)+3,sl_cur);} if(GV){DMA_V((t)+1,sl_next);} \
    CMASK(C0,C1,t); \
    { float a=MX3(C0[0],C0[1],C1[0]),b=MX3(C0[2],C0[3],C1[1]); a=MX3(a,C1[2],C1[3]); \
      _Pragma("unroll") for(int r=4;r<16;r+=4){a=MX3(a,C0[r],C0[r+1]);b=MX3(b,C0[r+2],C0[r+3]);a=MX3(a,C1[r],C1[r+1]);b=MX3(b,C1[r+2],C1[r+3]);} \
      float rm=__builtin_fmaxf(a,b); { auto rr=__builtin_amdgcn_permlane32_swap(__float_as_uint(rm),__float_as_uint(rm),false,false); rm=__builtin_fmaxf(__uint_as_float(rr[0]),__uint_as_float(rr[1])); } \
      resc=false; \
      if(__builtin_expect(__any(rm>(float)THRL),0)){ const float dl=__builtin_fmaxf(rm,0.f); mhat+=dl; \
        _Pragma("unroll") for(int r=0;r<16;++r){C0[r]-=dl;C1[r]-=dl;} \
        _Pragma("unroll") for(int r=0;r<16;++r)negm[r]=-mhat; asm volatile("":"+v"(negm)); \
        const float f=__builtin_amdgcn_exp2f(-dl); l_reg*=f; if(hi==0)wsf[r32]=f; resc=true; } } \
    SBAR(); \
    GAPB(o[0]=__builtin_amdgcn_mfma_f32_32x32x16_bf16(PAF(0),VFR(0),o[0],0,0,0), C0,0); \
    GAPB(o[1]=__builtin_amdgcn_mfma_f32_32x32x16_bf16(PAF(0),VFR(4),o[1],0,0,0), C0,4); \
    KRD(GL,0); GAPB(o[0]=__builtin_amdgcn_mfma_f32_32x32x16_bf16(PAF(1),VFR(1),o[0],0,0,0), C0,8); \
    KRD(GL,1); GAPB(o[1]=__builtin_amdgcn_mfma_f32_32x32x16_bf16(PAF(1),VFR(5),o[1],0,0,0), C0,12); \
    KRD(GL,2); GAPB(o[0]=__builtin_amdgcn_mfma_f32_32x32x16_bf16(PAF(2),VFR(2),o[0],0,0,0), C1,0); \
    KRD(GL,3); GAPB(o[1]=__builtin_amdgcn_mfma_f32_32x32x16_bf16(PAF(2),VFR(6),o[1],0,0,0), C1,4); \
    GAPB(o[0]=__builtin_amdgcn_mfma_f32_32x32x16_bf16(PAF(3),VFR(3),o[0],0,0,0), C1,8); \
    GAPB(o[1]=__builtin_amdgcn_mfma_f32_32x32x16_bf16(PAF(3),VFR(7),o[1],0,0,0), C1,12); \
    }while(0)
  int t=1;
  #undef CMASK
  #define CMASK(P0,P1,t) do{}while(0)
  for(;t+5<NT;t+=2){
    STEP(pB0,pB1,pA0,pA1,t,true,true,true);     WAIT_BAR(2); RESC(); ROT();
    STEP(pA0,pA1,pB0,pB1,t+1,true,true,true);   WAIT_BAR(2); RESC(); ROT();
  }
  #undef CMASK
  #define CMASK(P0,P1,t) do{}while(0)
  #define ENDW(tt) do{ if((tt)+3<NT){WAIT_BAR(2);} else if((tt)+2<NT){WAIT_BAR(1);} else {WAIT_BAR(0);} }while(0)
  for(;t+1<NT;t+=2){
    STEP(pB0,pB1,pA0,pA1,t,(t+3<NT),(t+1<NT),(t+1<NT));       ENDW(t);   RESC(); ROT();
    STEP(pA0,pA1,pB0,pB1,t+1,(t+4<NT),(t+2<NT),(t+2<NT));     ENDW(t+1); RESC(); ROT();
  }
  STEP(pB0,pB1,pA0,pA1,NT-1,false,false,false); RESC();
  { float sacc=pB0[0]+pB0[1]; _Pragma("unroll") for(int r=2;r<16;++r)sacc+=pB0[r]; _Pragma("unroll") for(int r=0;r<16;++r)sacc+=pB1[r]; l_reg+=sacc;
    pw0=(u32x4){PKW(pB0,0),PKW(pB0,2),PKW(pB0,4),PKW(pB0,6)};pw1=(u32x4){PKW(pB0,8),PKW(pB0,10),PKW(pB0,12),PKW(pB0,14)};pw2=(u32x4){PKW(pB1,0),PKW(pB1,2),PKW(pB1,4),PKW(pB1,6)};pw3=(u32x4){PKW(pB1,8),PKW(pB1,10),PKW(pB1,12),PKW(pB1,14)};
    SBAR(); pv(o,vb0+sl_cur,PAF(0),PAF(1),PAF(2),PAF(3)); }
  #undef PKW
  #undef PAF
  #undef VFR
  #undef PIN
  #undef MX3
  #undef GAPA
  #undef GAPB
  #undef EX
  #undef VRD
  #undef KRD
  #undef STEP
  #undef ENDW
  {auto rr=__builtin_amdgcn_permlane32_swap(__float_as_uint(l_reg),__float_as_uint(l_reg),false,false);l_reg=__uint_as_float(rr[0])+__uint_as_float(rr[1]);}
  if(hi==0)wsf[32+r32]=l_reg;asm volatile("s_waitcnt lgkmcnt(0)":::"memory");
  float rli[16];
  #pragma unroll
  for(int r=0;r<16;++r)rli[r]=__builtin_amdgcn_rcpf(wsf[32+crow(r,hi)]);
  bf16*Ow=Ou+(long)(wid*QBLK)*OP;
  { bf16*stg=(bf16*)(shm+LDS_OST)+wid*2048;
    #pragma unroll
    for(int r=0;r<16;++r){const int orow=crow(r,hi);
      #pragma unroll
      for(int d0=0;d0<2;++d0)stg[orow*64+d0*32+r32]=__float2bfloat16(o[d0][r]*rli[r]);}
    asm volatile("s_waitcnt lgkmcnt(0)":::"memory");
    #pragma unroll
    for(int i=0;i<4;++i){const int row=i*8+(lane>>3),ch=lane&7; const u32x4 v=*(const u32x4*)(stg+row*64+ch*8); ATTN_STORE16(Ow+(long)row*OP+ch*8,v);} }
  asm volatile("s_waitcnt lgkmcnt(0)\n\ts_barrier":::"memory");
  #undef DMA_K
  #undef DMA_V
  #undef CMASK
  #undef START
  #undef RESC
  #undef ROT
}
#undef SBAR
#undef WAIT_BAR
}
#define LAS __attribute__((address_space(3)))
typedef unsigned short bf16;
typedef unsigned v4u __attribute__((ext_vector_type(4)));
typedef unsigned v2u __attribute__((ext_vector_type(2)));
typedef float f32x4 __attribute__((ext_vector_type(4)));
typedef float f32x16 __attribute__((ext_vector_type(16)));
typedef short bf16x8 __attribute__((ext_vector_type(8)));
typedef LAS unsigned char lds_t;
typedef _Float16 h2 __attribute__((ext_vector_type(2)));
constexpr int NWAVES = 8, NTHR = 512;
constexpr int LDS_BYTES = 155648;
constexpr size_t MiB = 1u << 20;
constexpr size_t WS_WIN = 0, WS_WOUT = 18 * MiB, WS_W1 = 26 * MiB, WS_W2 = 58 * MiB;
constexpr size_t WS_MOD = 90 * MiB, WS_ROPE = 91 * MiB, WS_WLRU = 92 * MiB, WS_LCS = 93 * MiB, WS_XC = 96 * MiB, WS_RETC = 104 * MiB, WS_U = 138 * MiB, WS_R = 206 * MiB;
constexpr size_t R_P4 = 0, R_AQ = 68 * MiB, R_KB = 102 * MiB, R_VB = R_KB + (size_t)NB * KVL * 128 * 2, R_LX = 119 * MiB, R_LG = 136 * MiB, R_MIX = 153 * MiB, R_AD = 221 * MiB, R_END = 289 * MiB;
constexpr size_t WS_CTL = WS_R + R_END, CTL_BYTES = 65536;
constexpr size_t WS_LCS4 = WS_CTL + MiB;
constexpr size_t WS_END = WS_CTL + 7 * MiB;
static_assert(R_VB + (size_t)NB * KVL * 128 * 2 <= R_LX, "ws map");

__device__ __forceinline__ unsigned f2bf(float f) { unsigned u = __builtin_bit_cast(unsigned, f); return (u + 0x7fffu + ((u >> 16) & 1u)) >> 16; }
__device__ __forceinline__ unsigned pk2(float lo, float hi) { return f2bf(lo) | (f2bf(hi) << 16); }
__device__ __forceinline__ float bf2f(unsigned short b) { return __builtin_bit_cast(float, (unsigned)b << 16); }
__device__ __forceinline__ float bflo(unsigned w) { return __builtin_bit_cast(float, w << 16); }
__device__ __forceinline__ float bfhi(unsigned w) { return __builtin_bit_cast(float, w & 0xffff0000u); }
__device__ __forceinline__ float wave_sum(float v) {
#pragma unroll
    for (int o = 1; o < 64; o <<= 1) v += __shfl_xor(v, o);
    return v;
}
__device__ __forceinline__ float fsig(float x) { return __builtin_amdgcn_rcpf(1.0f + __expf(-x)); }
__device__ __forceinline__ int crow16(int r, int hi) { return (r & 3) + 8 * (r >> 2) + 4 * hi; }
template <int KSTEPS> __device__ __forceinline__ void mma32(f32x16& acc, const lds_t* A, int lda, const lds_t* B, int ldb, int lane) {
    const lds_t* ap = A + (lane & 31) * lda + (lane >> 5) * 16; const lds_t* bp = B + (lane & 31) * ldb + (lane >> 5) * 16;
#pragma unroll
    for (int k = 0; k < KSTEPS; ++k) acc = __builtin_amdgcn_mfma_f32_32x32x16_bf16(*(const LAS bf16x8*)(ap + 32 * k), *(const LAS bf16x8*)(bp + 32 * k), acc, 0, 0, 0);
}

#define XB_TMO      128
#define XB_XCNT(j)  (256  + 64 * (j))
#define XB_XSUB(j)  (1280 + 64 * (j))
#define XB_XGEN(j)  (2304 + 64 * (j))
#define XB_TOP      3328
#define XB_TOPGEN   3392
#define XCD_BAR_WORDS 3456
#define XB_SPIN_CAP (1u << 18)

__device__ __forceinline__ unsigned xb_ld(unsigned* p)              { return __hip_atomic_load(p, __ATOMIC_RELAXED, __HIP_MEMORY_SCOPE_AGENT); }
__device__ __forceinline__ unsigned xb_add(unsigned* p, unsigned v) { return __hip_atomic_fetch_add(p, v, __ATOMIC_RELAXED, __HIP_MEMORY_SCOPE_AGENT); }
__device__ __forceinline__ unsigned xb_xcc_id() { return (unsigned)__builtin_amdgcn_s_getreg((3 << 11) | 20) & 0xFu; }
#define XB_SPIN(cond, bar) do { unsigned _sp = 0; while (cond) { __builtin_amdgcn_s_sleep(1); \
    if ((++_sp & 255u) == 0u) { if (xb_ld(&(bar)[XB_TMO])) break; if (_sp > XB_SPIN_CAP) { atomicAdd(&(bar)[XB_TMO], 1u); break; } } } } while (0)

struct XcdBarrier {
    unsigned* bar; unsigned x;
    volatile LAS unsigned* st;
};

__device__ __forceinline__ XcdBarrier xcd_barrier_post(unsigned* bar, volatile LAS unsigned* st) {
    XcdBarrier b; b.bar = bar; b.x = xb_xcc_id(); b.st = st;
    if (threadIdx.x == 0) (void)xb_add(&bar[XB_XCNT(b.x)], 1u);
    return b;
}
__device__ __forceinline__ void xcd_barrier_complete(unsigned* bar, unsigned x, unsigned& nloc, unsigned& nx) {
    const unsigned G = gridDim.x * gridDim.y * gridDim.z;
    unsigned sum, cnt, mine, sp = 0u;
    for (;;) {
        sum = 0u; cnt = 0u; mine = 0u;
#pragma unroll
        for (unsigned j = 0; j < 16; ++j) { const unsigned c = xb_ld(&bar[XB_XCNT(j)]); sum += c; cnt += (c > 0u) ? 1u : 0u; mine = (j == x) ? c : mine; }
        if (sum == G) break;
        __builtin_amdgcn_s_sleep(1);
        if ((++sp & 255u) == 0u) { if (xb_ld(&bar[XB_TMO])) break; if (sp > XB_SPIN_CAP) { atomicAdd(&bar[XB_TMO], 1u); break; } }
    }
    nloc = mine > 0u ? mine : 1u; nx = cnt > 0u ? cnt : 1u;
}

__device__ __forceinline__ void xcd_barrier(const XcdBarrier& b) {
    asm volatile("s_waitcnt vmcnt(0)" ::: "memory");
    __syncthreads();
    if (threadIdx.x == 0) {
        unsigned* bar = b.bar;
        __builtin_amdgcn_s_waitcnt(0);
        unsigned nloc = b.st[0], nx = b.st[1];
        if (nloc == 0u) { xcd_barrier_complete(bar, b.x, nloc, nx); b.st[0] = nloc; b.st[1] = nx; }
        const unsigned old = xb_add(&bar[XB_XSUB(b.x)], 1u);
        const unsigned gen = old / nloc;
        if (old + 1u == (gen + 1u) * nloc) {
            __builtin_amdgcn_fence(__ATOMIC_RELEASE, "agent");
            asm volatile("s_waitcnt vmcnt(0)" ::: "memory");
            const unsigned og = xb_add(&bar[XB_TOP], 1u);
            const unsigned tg = og / nx;
            if (og + 1u == (tg + 1u) * nx) xb_add(&bar[XB_TOPGEN], 1u);
            else XB_SPIN(xb_ld(&bar[XB_TOPGEN]) == tg, bar);
            __builtin_amdgcn_fence(__ATOMIC_ACQUIRE, "agent");
            xb_add(&bar[XB_XGEN(b.x)], 1u);
            asm volatile("s_waitcnt vmcnt(0)" ::: "memory");
        } else {
            XB_SPIN(xb_ld(&bar[XB_XGEN(b.x)]) == gen, bar);
            __builtin_amdgcn_fence(__ATOMIC_ACQUIRE, "agent");
            asm volatile("s_waitcnt vmcnt(0)" ::: "memory");
        }
    }
    __syncthreads();
}

struct Args {
    const float *x, *c, *ctx, *c_ctx, *w_ada, *b_ada, *w_in, *ret_decay, *q_gain, *k_gain, *conv_w, *conv_b, *lru_wa, *lru_ba, *lru_wx, *lru_bx, *lru_lam, *w_out, *ln1_g, *ln1_b, *w_ff1, *w_ff2, *ln2_g, *ln2_b;
    float* out; unsigned char* ws;
};

template <bool PERMIN> __device__ __forceinline__ void transpose_item(const float* W, int K, int N, bf16* WT, LAS float* scr, int item, int lane) {
    const int nblk = N / 32, kb = item / nblk, nb = item % nblk, k0 = 64 * kb, n0 = 32 * nb;
#pragma unroll 8
    for (int i = 0; i < 32; ++i) { const int kk = 2 * i + (lane >> 5); scr[kk * 33 + (lane & 31)] = W[(size_t)(k0 + kk) * N + n0 + (lane & 31)]; }
    asm volatile("s_waitcnt lgkmcnt(0)" ::: "memory");
    int r0 = n0;
    if (PERMIN) { const int cl = n0 & 255; r0 = (n0 & ~255) + 128 * ((cl >> 5) & 1) + 32 * (cl >> 6); }
    const int c = lane & 7;
#pragma unroll
    for (int j = 0; j < 4; ++j) { const int n = (lane >> 3) + 8 * j; const LAS float* s = scr + (8 * c) * 33 + n;
        v4u o; o.x = pk2(s[0 * 33], s[1 * 33]); o.y = pk2(s[2 * 33], s[3 * 33]); o.z = pk2(s[4 * 33], s[5 * 33]); o.w = pk2(s[6 * 33], s[7 * 33]);
        *(v4u*)(WT + (size_t)(r0 + n) * K + k0 + 8 * c) = o; }
    asm volatile("s_waitcnt lgkmcnt(0)" ::: "memory");
}

__device__ __forceinline__ void modulate_rows(const Args& a, const float* mod0, bf16* U, int gw, int ngw, int lane) {
    for (int m = gw; m < MT; m += ngw) {
        const bool lat = m < ML; const int bb = lat ? (m >> 12) : 8;
        const float* xr = lat ? a.x + (size_t)m * DM : a.ctx + (size_t)(m - ML) * DM;
        const float* mp = mod0 + (size_t)bb * 6144;
#pragma unroll
        for (int j = 0; j < 4; ++j) { const int col = 4 * (lane + 64 * j); const f32x4 v = *(const f32x4*)(xr + col), sh = *(const f32x4*)(mp + col), sc = *(const f32x4*)(mp + 1024 + col);
            const f32x4 o = v * (sc + 1.0f) + sh; v2u w; w.x = pk2(o[0], o[1]); w.y = pk2(o[2], o[3]); *(v2u*)(U + (size_t)m * DM + col) = w; }
    }
}
template <int NR> __device__ __forceinline__ void ln_lat_body(float* xL, const float* g, const float* b, const float* modp, bf16* U, int m0, int ngw, int lane, float* dummy, const bf16* vin, bf16* xB) {
    {
        f32x4 v[NR][4]; float s[NR], s2[NR];
#pragma unroll
        for (int q = 0; q < NR; ++q)
#pragma unroll
            for (int jj = 0; jj < 2; ++jj) { const size_t o_ = (size_t)(m0 + q * ngw) * DM + 8 * lane + 512 * jj;
                if (vin) { const v4u w = *(const v4u*)(vin + o_); v[q][2 * jj] = (f32x4){bflo(w.x), bfhi(w.x), bflo(w.y), bfhi(w.y)}; v[q][2 * jj + 1] = (f32x4){bflo(w.z), bfhi(w.z), bflo(w.w), bfhi(w.w)}; }
                else { v[q][2 * jj] = *(const f32x4*)(xL + o_); v[q][2 * jj + 1] = *(const f32x4*)(xL + o_ + 4); } }
#pragma unroll
        for (int q = 0; q < NR; ++q) { s[q] = 0.f;
#pragma unroll
            for (int j = 0; j < 4; ++j) s[q] += (v[q][j][0] + v[q][j][1]) + (v[q][j][2] + v[q][j][3]); }
#pragma unroll
        for (int o = 1; o < 64; o <<= 1) {
#pragma unroll
            for (int q = 0; q < NR; ++q) s[q] += __shfl_xor(s[q], o); }
#pragma unroll
        for (int q = 0; q < NR; ++q) { const float mean = s[q] * (1.0f / DM); s2[q] = 0.f;
#pragma unroll
            for (int j = 0; j < 4; ++j) { v[q][j] = v[q][j] - mean; s2[q] += (v[q][j][0] * v[q][j][0] + v[q][j][1] * v[q][j][1]) + (v[q][j][2] * v[q][j][2] + v[q][j][3] * v[q][j][3]); } }
#pragma unroll
        for (int o = 1; o < 64; o <<= 1) {
#pragma unroll
            for (int q = 0; q < NR; ++q) s2[q] += __shfl_xor(s2[q], o); }
#pragma unroll
        for (int jj = 0; jj < 2; ++jj) { const int col = 8 * lane + 512 * jj;
            const f32x4 g0 = *(const f32x4*)(g + col), g1 = *(const f32x4*)(g + col + 4), b0 = *(const f32x4*)(b + col), b1 = *(const f32x4*)(b + col + 4);
#pragma unroll
            for (int q = 0; q < NR; ++q) { const int m = m0 + q * ngw; const float rstd = rsqrtf(s2[q] * (1.0f / DM) + EPSN);
                const f32x4 o0 = v[q][2 * jj] * rstd * g0 + b0, o1 = v[q][2 * jj + 1] * rstd * g1 + b1;
                if (xB) { v4u wx; wx.x = pk2(o0[0], o0[1]); wx.y = pk2(o0[2], o0[3]); wx.z = pk2(o1[0], o1[1]); wx.w = pk2(o1[2], o1[3]); *(v4u*)(xB + (size_t)m * DM + col) = wx; }
                else { float* xo = (dummy ? dummy : xL) + (size_t)m * DM + col; *(f32x4*)xo = o0; *(f32x4*)(xo + 4) = o1; }
                if (modp) { const float* mp = modp + (size_t)(m >> 12) * 6144 + col; const f32x4 u0 = o0 * (*(const f32x4*)(mp + 1024) + 1.0f) + *(const f32x4*)mp, u1 = o1 * (*(const f32x4*)(mp + 1024 + 4) + 1.0f) + *(const f32x4*)(mp + 4);
                    v4u w; w.x = pk2(u0[0], u0[1]); w.y = pk2(u0[2], u0[3]); w.z = pk2(u1[0], u1[1]); w.w = pk2(u1[2], u1[3]); *(v4u*)(U + (size_t)m * DM + col) = w; } } }
    }
}
__device__ __forceinline__ void ln_rows_lat(float* xL, const float* g, const float* b, const float* modp, bf16* U, int gw, int ngw, int lane, float* dummy, const bf16* vin, bf16* xB) {
    int m0 = gw;
    for (; m0 + 3 * ngw < ML; m0 += 4 * ngw) ln_lat_body<4>(xL, g, b, modp, U, m0, ngw, lane, dummy, vin, xB);
    for (; m0 < ML; m0 += ngw) ln_lat_body<1>(xL, g, b, modp, U, m0, ngw, lane, dummy, vin, xB);
}
__device__ __forceinline__ void ln_rows_ctx(float* xC, const float* xCin, const float* g, const float* b, const float* modp, bf16* U, int gw, int ngw, int lane, const float* part, const float* gate8, int nsplit) {
    for (int r = gw; r < MC; r += ngw) {
        f32x4 v[4]; float s = 0.f;
#pragma unroll
        for (int j = 0; j < 4; ++j) { const int col = 4 * (lane + 64 * j); v[j] = *(const f32x4*)(xCin + (size_t)r * DM + col);
            if (part) { const bf16* pp = (const bf16*)part + (size_t)r * DM + col; f32x4 ps = {0.f, 0.f, 0.f, 0.f};
                for (int k = 0; k < nsplit; ++k) { const v2u w = *(const v2u*)(pp + (size_t)k * 2048 * 1024); ps = ps + (f32x4){bflo(w.x), bfhi(w.x), bflo(w.y), bfhi(w.y)}; }
                v[j] = v[j] * ALPHA + *(const f32x4*)(gate8 + col) * ps; }
            s += (v[j][0] + v[j][1]) + (v[j][2] + v[j][3]); }
        const float mean = wave_sum(s) * (1.0f / DM); float s2 = 0.f;
#pragma unroll
        for (int j = 0; j < 4; ++j) { v[j] = v[j] - mean; s2 += (v[j][0] * v[j][0] + v[j][1] * v[j][1]) + (v[j][2] * v[j][2] + v[j][3] * v[j][3]); }
        const float rstd = rsqrtf(wave_sum(s2) * (1.0f / DM) + EPSN);
#pragma unroll
        for (int j = 0; j < 4; ++j) { const int col = 4 * (lane + 64 * j); const f32x4 o = v[j] * rstd * *(const f32x4*)(g + col) + *(const f32x4*)(b + col);
            *(f32x4*)(xC + (size_t)r * DM + col) = o;
            if (modp) { const float* mp = modp + (size_t)8 * 6144; const f32x4 sh = *(const f32x4*)(mp + col), sc = *(const f32x4*)(mp + 1024 + col); const f32x4 uu = o * (sc + 1.0f) + sh;
                v2u w; w.x = pk2(uu[0], uu[1]); w.y = pk2(uu[2], uu[3]); *(v2u*)(U + (size_t)(ML + r) * DM + col) = w; } }
    }
}
__device__ __forceinline__ void ln_rows(float* xL, float* xC, int mrows, const float* g, const float* b, const float* modp, bf16* U, int gw, int ngw, int lane, float* dummy = nullptr, const float* part = nullptr, const float* gate8 = nullptr, const float* xCin = nullptr, const bf16* vin = nullptr, bf16* xB = nullptr, int nsplit = 4) {
    ln_rows_lat(xL, g, b, modp, U, gw, ngw, lane, dummy, vin, xB);
    if (mrows > ML && !dummy) ln_rows_ctx(xC, xCin ? xCin : xC, g, b, modp, U, gw, ngw, lane, part, gate8, nsplit);
}

__device__ __forceinline__ int chunk_row0(int b, int c) { return c < 32 ? b * SEQ + c * 128 : ML + b * CTXL + (c - 32) * 128; }
__device__ __forceinline__ float log_sigmoid(float x) { return fminf(x, 0.f) - log1pf(expf(-fabsf(x))); }
constexpr int RT_LDK = 272;
constexpr int RT_LDD = 144;
__device__ __forceinline__ void ret_contrib_unit(int unit, const bf16* RK, const bf16* RV, const float* decay_l, float* RETC, lds_t* lds, int tid, int lane, int wave) {
    const int c = unit % 34, bh = unit / 34, h = bh & 3, b = bh >> 2; const int m0 = chunk_row0(b, c);
    lds_t* Kft = lds; lds_t* Kbt = lds + 64 * RT_LDK; lds_t* Vt = lds + 128 * RT_LDK;
    const float lgf = log_sigmoid(decay_l[h]), lgb = log_sigmoid(decay_l[4 + h]);
    { const int j = tid >> 2, d0 = (tid & 3) * 16; const float wf = __expf(lgf * (float)(127 - j)), wb = __expf(lgb * (float)j);
        const v4u* kp = (const v4u*)(RK + (size_t)(m0 + j) * 256 + h * 64 + d0); const v4u* vp = (const v4u*)(RV + (size_t)(m0 + j) * 256 + h * 64 + d0);
#pragma unroll
        for (int q = 0; q < 2; ++q) { const v4u kw = kp[q], vw = vp[q];
#pragma unroll
            for (int e = 0; e < 4; ++e) { const unsigned kk = kw[e], vv = vw[e]; const int d = d0 + q * 8 + 2 * e; const float k0 = bflo(kk), k1 = bfhi(kk);
                *(LAS unsigned short*)(Kft + d * RT_LDK + j * 2) = (unsigned short)f2bf(k0 * wf); *(LAS unsigned short*)(Kft + (d + 1) * RT_LDK + j * 2) = (unsigned short)f2bf(k1 * wf);
                *(LAS unsigned short*)(Kbt + d * RT_LDK + j * 2) = (unsigned short)f2bf(k0 * wb); *(LAS unsigned short*)(Kbt + (d + 1) * RT_LDK + j * 2) = (unsigned short)f2bf(k1 * wb);
                *(LAS unsigned short*)(Vt + d * RT_LDK + j * 2) = (unsigned short)(vv & 0xffffu); *(LAS unsigned short*)(Vt + (d + 1) * RT_LDK + j * 2) = (unsigned short)(vv >> 16); } } }
    __syncthreads();
    { const int dir = wave >> 2, dt = (wave >> 1) & 1, vt = wave & 1; f32x16 acc = {};
        mma32<8>(acc, (dir ? Kbt : Kft) + 32 * dt * RT_LDK, RT_LDK, Vt + 32 * vt * RT_LDK, RT_LDK, lane);
        float* dst = RETC + ((size_t)unit * 2 + dir) * 4096 + (32 * vt + (lane & 31));
#pragma unroll
        for (int r = 0; r < 16; ++r) dst[(size_t)(32 * dt + crow16(r, lane >> 5)) * 64] = acc[r]; }
    __syncthreads();
}
__device__ __forceinline__ void ret_prefix_phase(float* RETC, const float* decay_l, int gt, int ngt) {
    for (int i = gt; i < 32 * 2 * 4096; i += ngt) { const int e = i & 4095, dir = (i >> 12) & 1, bh = i >> 13, h = bh & 3;
        const float G = __expf(log_sigmoid(decay_l[dir * 4 + h]) * 128.f); float* base = RETC + (size_t)bh * 34 * 8192 + dir * 4096 + e;
        float cv[34];
#pragma unroll
        for (int x = 0; x < 34; ++x) cv[x] = base[(size_t)x * 8192];
        float s = 0.f;
        if (dir == 0) {
#pragma unroll
            for (int k = 0; k < 34; ++k) { const int x = k < 2 ? 32 + k : k - 2; base[(size_t)x * 8192] = s; s = s * G + cv[x]; } }
        else {
#pragma unroll
            for (int k = 0; k < 34; ++k) { const int x = 33 - k; base[(size_t)x * 8192] = s; s = s * G + cv[x]; } }
    }
}
__device__ __forceinline__ void ret_out_unit(int unit, const bf16* RQ, const bf16* RK, const bf16* RV, const bf16* RG, const float* decay_l, const float* RETC, bf16* MIX, lds_t* lds, int tid, int lane, int wave) {
    const int c = unit % 34, bh = unit / 34, h = bh & 3, b = bh >> 2; const int m0 = chunk_row0(b, c);
    lds_t* Qs = lds; lds_t* Ks = Qs + 128 * RT_LDD; lds_t* Vt = Ks + 128 * RT_LDD; lds_t* Sft = Vt + 64 * RT_LDK; lds_t* Sbt = Sft + 64 * RT_LDD; lds_t* Ws = Sbt + 64 * RT_LDD;
    const float lgf = log_sigmoid(decay_l[h]), lgb = log_sigmoid(decay_l[4 + h]);
    { const float* base = RETC + ((size_t)bh * 34 + c) * 2 * 4096 + tid * 8;
        const f32x4 sf0 = *(const f32x4*)base, sf1 = *(const f32x4*)(base + 4), sb0 = *(const f32x4*)(base + 4096), sb1 = *(const f32x4*)(base + 4096 + 4);
        const int d = tid >> 3, v0 = (tid & 7) * 8;
#pragma unroll
        for (int e = 0; e < 4; ++e) { *(LAS unsigned short*)(Sft + (v0 + e) * RT_LDD + d * 2) = (unsigned short)f2bf(sf0[e]); *(LAS unsigned short*)(Sft + (v0 + 4 + e) * RT_LDD + d * 2) = (unsigned short)f2bf(sf1[e]);
            *(LAS unsigned short*)(Sbt + (v0 + e) * RT_LDD + d * 2) = (unsigned short)f2bf(sb0[e]); *(LAS unsigned short*)(Sbt + (v0 + 4 + e) * RT_LDD + d * 2) = (unsigned short)f2bf(sb1[e]); } }
    { const int j = tid >> 2, d0 = (tid & 3) * 16; const size_t go = (size_t)(m0 + j) * 256 + h * 64 + d0;
        const v4u* qp = (const v4u*)(RQ + go); const v4u* kp = (const v4u*)(RK + go); const v4u* vp = (const v4u*)(RV + go);
#pragma unroll
        for (int q = 0; q < 2; ++q) { *(LAS v4u*)(Qs + j * RT_LDD + (d0 + 8 * q) * 2) = qp[q]; *(LAS v4u*)(Ks + j * RT_LDD + (d0 + 8 * q) * 2) = kp[q]; const v4u vw = vp[q];
#pragma unroll
            for (int e = 0; e < 4; ++e) { const unsigned vv = vw[e]; const int d = d0 + q * 8 + 2 * e;
                *(LAS unsigned short*)(Vt + d * RT_LDK + j * 2) = (unsigned short)(vv & 0xffffu); *(LAS unsigned short*)(Vt + (d + 1) * RT_LDK + j * 2) = (unsigned short)(vv >> 16); } } }
    __syncthreads();
#pragma unroll
    for (int tt = 0; tt < 2; ++tt) { const int tile = wave * 2 + tt, it = tile >> 2, jt = tile & 3; f32x16 acc = {};
        mma32<4>(acc, Qs + 32 * it * RT_LDD, RT_LDD, Ks + 32 * jt * RT_LDD, RT_LDD, lane);
        const int j = 32 * jt + (lane & 31);
#pragma unroll
        for (int r = 0; r < 16; ++r) { const int i = 32 * it + crow16(r, lane >> 5); const float dd = (float)(i - j); const float w = acc[r] * __expf(dd >= 0.f ? lgf * dd : -lgb * dd);
            *(LAS unsigned short*)(Ws + i * RT_LDK + j * 2) = (unsigned short)f2bf(w); } }
    __syncthreads();
    f32x16 o;
    { const int it = wave >> 1, vt = wave & 1; f32x16 a1 = {}, a2 = {}, a3 = {};
        mma32<8>(a1, Ws + 32 * it * RT_LDK, RT_LDK, Vt + 32 * vt * RT_LDK, RT_LDK, lane);
        mma32<4>(a2, Qs + 32 * it * RT_LDD, RT_LDD, Sft + 32 * vt * RT_LDD, RT_LDD, lane);
        mma32<4>(a3, Qs + 32 * it * RT_LDD, RT_LDD, Sbt + 32 * vt * RT_LDD, RT_LDD, lane);
#pragma unroll
        for (int r = 0; r < 16; ++r) { const int i = 32 * it + crow16(r, lane >> 5); o[r] = a1[r] + __expf(lgf * (float)(i + 1)) * a2[r] + __expf(lgb * (float)(128 - i)) * a3[r]; } }
    __syncthreads();
    { const int it = wave >> 1, vt = wave & 1; LAS float* Os = (LAS float*)Ws;
#pragma unroll
        for (int r = 0; r < 16; ++r) Os[(32 * it + crow16(r, lane >> 5)) * 65 + 32 * vt + (lane & 31)] = o[r]; }
    __syncthreads();
    { const int i = tid >> 2, c0 = (tid & 3) * 16; const LAS float* Os = (const LAS float*)Ws + i * 65 + c0; float vals[16]; float ss = 0.f;
#pragma unroll
        for (int e = 0; e < 16; ++e) { vals[e] = Os[e]; ss += vals[e] * vals[e]; }
        ss += __shfl_xor(ss, 1); ss += __shfl_xor(ss, 2);
        const float rs = rsqrtf(ss * (1.0f / 64.0f) + EPSN);
        const v4u* gp = (const v4u*)(RG + (size_t)(m0 + i) * 256 + h * 64 + c0); bf16* dst = MIX + (size_t)(m0 + i) * DM + h * 64 + c0;
#pragma unroll
        for (int q = 0; q < 2; ++q) { const v4u gw = gp[q]; v4u ow;
#pragma unroll
            for (int e = 0; e < 4; ++e) ow[e] = pk2(vals[q * 8 + 2 * e] * rs * bflo(gw[e]), vals[q * 8 + 2 * e + 1] * rs * bfhi(gw[e]));
            *(v4u*)(dst + 8 * q) = ow; } }
    __syncthreads();
}

constexpr int LR_LDX = 528;
__device__ __forceinline__ void lru_pass1_unit(int cu4, const Args& a, int l, const bf16* LX, const bf16* WLRU, h2* AD, float2* LCS4, lds_t* lds, int tid, int lane, int wave) {
    const int cu = cu4 >> 2, rt0 = cu4 & 3;
    const int b = cu < 256 ? cu >> 5 : (cu - 256) >> 1, c = cu < 256 ? cu & 31 : 32 + ((cu - 256) & 1);
    const int m0 = chunk_row0(b, c), ms = c < 32 ? b * SEQ : ML + b * CTXL, me = ms + (c < 32 ? SEQ : CTXL);
    lds_t* XR = lds; LAS h2* ADL = (LAS h2*)(lds + 128 * LR_LDX);
    { const int w8 = (tid & 31) * 8, tr = tid >> 5; float cw[4][8], cb[8];
#pragma unroll
        for (int j = 0; j < 4; ++j)
#pragma unroll
            for (int e = 0; e < 8; ++e) cw[j][e] = a.conv_w[(size_t)l * 1024 + j * 256 + w8 + e];
#pragma unroll
        for (int e = 0; e < 8; ++e) cb[e] = a.conv_b[l * 256 + w8 + e];
        for (int i = 0; i < 2; ++i) { const int t = 32 * rt0 + tr + 16 * i; float acc[8];
#pragma unroll
            for (int e = 0; e < 8; ++e) acc[e] = cb[e];
#pragma unroll
            for (int j = 0; j < 4; ++j) { const int m = m0 + t + j - 2;
                if (m >= ms && m < me) { const v4u xv = *(const v4u*)(LX + (size_t)m * 256 + w8);
#pragma unroll
                    for (int e = 0; e < 4; ++e) { acc[2 * e] += bflo(xv[e]) * cw[j][2 * e]; acc[2 * e + 1] += bfhi(xv[e]) * cw[j][2 * e + 1]; } } }
            v4u ow;
#pragma unroll
            for (int e = 0; e < 4; ++e) ow[e] = pk2(acc[2 * e], acc[2 * e + 1]);
            *(LAS v4u*)(XR + (t & 31) * LR_LDX + w8 * 2) = ow; } }
    __syncthreads();
    const int k = wave & 3, dir = wave >> 2;
    float ba[2], bx[2], lsl[2];
#pragma unroll
    for (int ct = 0; ct < 2; ++ct) { const int ch = 64 * k + 32 * ct + (lane & 31); ba[ct] = a.lru_ba[(l * 2 + dir) * 256 + ch]; bx[ct] = a.lru_bx[(l * 2 + dir) * 256 + ch]; lsl[ct] = 8.0f * log_sigmoid(a.lru_lam[(l * 2 + dir) * 256 + ch]); }
    float At = 1.f, Ht = 0.f;
    for (int rt = rt0; rt < rt0 + 1; ++rt) {
        bf16x8 af[4];
#pragma unroll
        for (int ks = 0; ks < 4; ++ks) af[ks] = *(const LAS bf16x8*)(XR + (lane & 31) * LR_LDX + (64 * k + 16 * ks + 8 * (lane >> 5)) * 2);
#pragma unroll
        for (int ct = 0; ct < 2; ++ct) { f32x16 ga = {}, gx = {};
#pragma unroll
            for (int ks = 0; ks < 4; ++ks) { const bf16* wb = WLRU + (((size_t)(l * 2 + dir) * 2 * 4 + k) * 64 + 32 * ct + (lane & 31)) * 64 + 16 * ks + 8 * (lane >> 5);
                ga = __builtin_amdgcn_mfma_f32_32x32x16_bf16(af[ks], *(const bf16x8*)wb, ga, 0, 0, 0); gx = __builtin_amdgcn_mfma_f32_32x32x16_bf16(af[ks], *(const bf16x8*)(wb + 4 * 4096), gx, 0, 0, 0); }
            const int ch = 64 * k + 32 * ct + (lane & 31);
#pragma unroll
            for (int r = 0; r < 16; ++r) { const int row = crow16(r, lane >> 5);
                const float rg = fsig(ga[r] + ba[ct]), ig = fsig(gx[r] + bx[ct]); const float la = lsl[ct] * rg;
                const float a_ = __expf(la); const float oma = 1.0f - a_, dr = __builtin_amdgcn_sqrtf(oma * (1.0f + a_)) * ig * bf2f(*(const LAS unsigned short*)(XR + row * LR_LDX + ch * 2));
                h2 hv; hv[0] = (_Float16)oma; hv[1] = (_Float16)dr;
                ADL[row * 512 + dir * 256 + ch] = hv; AD[((size_t)(m0 + 32 * rt + row) * 2 + dir) * 256 + ch] = hv; } }
        __syncthreads();
        { const int sd = tid >> 8, sc = tid & 255; float A = 1.f, H = 0.f;
            h2 fr_[32];
#pragma unroll
            for (int r = 0; r < 32; ++r) fr_[r] = ADL[r * 512 + sd * 256 + sc];
            if (sd == 0) {
#pragma unroll
                for (int r = 0; r < 32; ++r) { const float aa = 1.0f - (float)fr_[r][0]; H = aa * H + (float)fr_[r][1]; A *= aa; }
                Ht = A * Ht + H; At = A * At; }
            else {
#pragma unroll
                for (int r = 31; r >= 0; --r) { const float aa = 1.0f - (float)fr_[r][0]; H = aa * H + (float)fr_[r][1]; A *= aa; }
                Ht = At * H + Ht; At = At * A; } }
        __syncthreads();
    }
    LCS4[(((size_t)(b * 34 + c) * 4 + rt0) * 2 + (tid >> 8)) * 256 + (tid & 255)] = make_float2(At, Ht);
}
__device__ __forceinline__ void lru_compose_phase(const float2* LCS4, float2* LCS, int gt, int ngt) {
    for (int i = gt; i < NB * 34 * 2 * 256; i += ngt) { const int ch = i & 255, dir = (i >> 8) & 1, bc = i >> 9; float2 s[4];
#pragma unroll
        for (int rt = 0; rt < 4; ++rt) s[rt] = LCS4[(((size_t)bc * 4 + rt) * 2 + dir) * 256 + ch];
        float A = 1.f, h = 0.f;
#pragma unroll
        for (int k = 0; k < 4; ++k) { const float2 t = s[dir ? 3 - k : k]; h = t.x * h + t.y; A *= t.x; }
        LCS[i] = make_float2(A, h); }
}
__device__ __forceinline__ void lru_pass2_unit(int cu, const h2* AD, const float2* LCS, const bf16* LG, bf16* MIX, lds_t* lds, int tid) {
    const int b = cu < 256 ? cu >> 5 : (cu - 256) >> 1, c = cu < 256 ? cu & 31 : 32 + ((cu - 256) & 1);
    const int m0 = chunk_row0(b, c); const int dir = tid >> 8, ch = tid & 255;
    LAS _Float16* HS = (LAS _Float16*)lds;
    float h = 0.f;
    const float2* cs = LCS + (size_t)b * 34 * 512 + dir * 256 + ch;
    const int n = dir == 0 ? (c < 32 ? c + 2 : c - 32) : 33 - c;
    for (int i0 = 0; i0 < n; i0 += 8) { float2 s[8];
#pragma unroll
        for (int j = 0; j < 8; ++j) { const int ii = (i0 + j < n) ? i0 + j : 0; const int cc = dir == 0 ? (ii < 2 ? 32 + ii : ii - 2) : 33 - ii; s[j] = cs[(size_t)cc * 512]; }
#pragma unroll
        for (int j = 0; j < 8; ++j) if (i0 + j < n) h = s[j].x * h + s[j].y; }
    const h2* ad = AD + ((size_t)m0 * 2 + dir) * 256 + ch;
#pragma unroll 1
    for (int r0 = 0; r0 < 128; r0 += 16) { h2 f[16];
#pragma unroll
        for (int j = 0; j < 16; ++j) { const int r = dir == 0 ? r0 + j : 127 - (r0 + j); f[j] = ad[(size_t)r * 512]; }
#pragma unroll
        for (int j = 0; j < 16; ++j) { const int r = dir == 0 ? r0 + j : 127 - (r0 + j); h = (1.0f - (float)f[j][0]) * h + (float)f[j][1]; HS[r * 512 + dir * 256 + ch] = (_Float16)h; } }
    __syncthreads();
    { typedef _Float16 h8 __attribute__((ext_vector_type(8))); const int c8 = (tid & 31) * 8;
#pragma unroll 4
        for (int i = 0; i < 8; ++i) { const int r = (tid >> 5) + 16 * i; const h8 hf = *(const LAS h8*)(HS + r * 512 + c8), hb = *(const LAS h8*)(HS + r * 512 + 256 + c8);
            const v4u g = *(const v4u*)(LG + (size_t)(m0 + r) * 256 + c8); v4u o;
#pragma unroll
            for (int e = 0; e < 4; ++e) o[e] = pk2(((float)hf[2 * e] + (float)hb[2 * e]) * bflo(g[e]), ((float)hf[2 * e + 1] + (float)hb[2 * e + 1]) * bfhi(g[e]));
            *(v4u*)(MIX + (size_t)(m0 + r) * DM + 768 + c8) = o; } }
    __syncthreads();
}
#ifndef REP_G1N
#define REP_G1N 1
#endif
#ifndef REP_G4E
#define REP_G4E 1
#endif
#ifndef REP_P0
#define REP_P0 1
#endif
#ifndef REP_G4
#define REP_G4 1
#endif
#ifndef REP_G7
#define REP_G7 1
#endif
#ifndef REP_LN
#define REP_LN 1
#endif
#ifndef REP_SYNC
#define REP_SYNC 0
#endif
#ifndef REP_G1
#define REP_G1 1
#endif
#ifndef REP_S2
#define REP_S2 1
#endif
#ifndef REP_ATT
#define REP_ATT 1
#endif
#ifndef REP_R2
#define REP_R2 1
#endif
#ifndef REP_L2
#define REP_L2 1
#endif
#ifndef REP_G6
#define REP_G6 1
#endif
__global__ void __launch_bounds__(NTHR, 2) trunk_fwd(Args a) {
    extern __shared__ __attribute__((aligned(16))) unsigned char lds_raw[];
    cg::grid_group grid = cg::this_grid();
    lds_t* lds = (lds_t*)lds_raw;
    const int tid = threadIdx.x;
    const int G = gridDim.x, bx = blockIdx.x;
    const int vcu = (G % 8 == 0) ? (bx % 8) * (G / 8) + bx / 8 : bx;
    const int ngw = G * NWAVES;
    unsigned char* ws = a.ws;
    volatile LAS unsigned* bst = (volatile LAS unsigned*)(lds + LDS_BYTES - 64);
    if (threadIdx.x == 0) { bst[0] = 0u; bst[1] = 0u; }
    __syncthreads();
    (void)xcd_barrier_post((unsigned*)(ws + WS_CTL), bst);
#define GRID_BAR() do { XcdBarrier b_; b_.bar = (unsigned*)(a.ws + WS_CTL); b_.x = xb_xcc_id(); b_.st = (volatile LAS unsigned*)(lds + LDS_BYTES - 64); xcd_barrier(b_); } while (0)
    bf16* WT_IN = (bf16*)(ws + WS_WIN); bf16* WT_OUT = (bf16*)(ws + WS_WOUT); bf16* WT_1 = (bf16*)(ws + WS_W1); bf16* WT_2 = (bf16*)(ws + WS_W2);
    float* MOD = (float*)(ws + WS_MOD); float* ROPE = (float*)(ws + WS_ROPE); bf16* WLRU = (bf16*)(ws + WS_WLRU); float2* LCS = (float2*)(ws + WS_LCS);
    float* XC = (float*)(ws + WS_XC); float* RETC = (float*)(ws + WS_RETC); bf16* U = (bf16*)(ws + WS_U);
    unsigned char* R = ws + WS_R;
    float2* LCS4 = (float2*)(ws + WS_LCS4);
    bf16* P4 = (bf16*)(R + R_P4); bf16* RQ = P4; bf16* RK = P4 + (size_t)MT * 256; bf16* RV = P4 + (size_t)2 * MT * 256; bf16* RG = P4 + (size_t)3 * MT * 256;
    bf16* AQ = (bf16*)(R + R_AQ); bf16* KB = (bf16*)(R + R_KB); bf16* VB = (bf16*)(R + R_VB); bf16* LX = (bf16*)(R + R_LX); bf16* LG = (bf16*)(R + R_LG);
    bf16* MIX = (bf16*)(R + R_MIX); h2* AD = (h2*)(R + R_AD); bf16* H = (bf16*)R;

#define IDS() int tid_ = threadIdx.x; asm volatile("" : "+v"(tid_)); const int lane_ = tid_ & 63, wave_ = __builtin_amdgcn_readfirstlane(tid_ >> 6); const int gw_ = vcu * NWAVES + wave_; (void)lane_; (void)gw_
    for (int rep_ = 0; rep_ < REP_P0; ++rep_)
    {
        IDS(); const int tid = tid_, lane = lane_, wave = wave_, gw = gw_;
        LAS float* sS = (LAS float*)lds;
        LAS float* part = (LAS float*)(lds + 9 * 1024 * 4);
        for (int i = tid; i < 9 * 1024; i += NTHR) { const float v = i < 8192 ? a.c[i] : a.c_ctx[i - 8192]; sS[i] = v / (1.0f + expf(-v)); }
        __syncthreads();
        for (int unit = bx; unit < DEPTH * 48; unit += G) { const int l = unit / 48, n = (unit % 48) * 128 + 2 * lane;
            const float* wp = a.w_ada + ((size_t)l * 1024 + wave * 128) * 6144 + n; float acc0[9], acc1[9];
#pragma unroll
            for (int q = 0; q < 9; ++q) { acc0[q] = 0.f; acc1[q] = 0.f; }
#pragma unroll 1
            for (int k0 = 0; k0 < 128; k0 += 8) { float2 wv[8];
#pragma unroll
                for (int k = 0; k < 8; ++k) wv[k] = *(const float2*)(wp + (size_t)(k0 + k) * 6144);
#pragma unroll
                for (int k = 0; k < 8; ++k)
#pragma unroll
                    for (int q = 0; q < 9; ++q) { const float sv = sS[q * 1024 + wave * 128 + k0 + k]; acc0[q] += sv * wv[k].x; acc1[q] += sv * wv[k].y; } }
#pragma unroll
            for (int q = 0; q < 9; ++q) { part[(wave * 9 + q) * 128 + 2 * lane] = acc0[q]; part[(wave * 9 + q) * 128 + 2 * lane + 1] = acc1[q]; }
            __syncthreads();
            for (int i = tid; i < 9 * 128; i += NTHR) { float s = 0.f;
#pragma unroll
                for (int w = 0; w < 8; ++w) s += part[w * 1152 + i];
                const int q = i >> 7, nn = (unit % 48) * 128 + (i & 127); MOD[((size_t)l * 9 + q) * 6144 + nn] = s + a.b_ada[(size_t)l * 6144 + nn]; }
            __syncthreads(); }
        __syncthreads();
        LAS float* scr = (LAS float*)(lds + wave * 16384);
        constexpr int I_IN = 16 * 72, I_OUT = 16 * 32, I_1 = 16 * 128, I_2 = 64 * 32, I_L = I_IN + I_OUT + I_1 + I_2;
        for (int it = gw; it < DEPTH * I_L; it += ngw) { const int l = it / I_L; int r = it % I_L;
            if (r < I_IN) { transpose_item<true>(a.w_in + (size_t)l * DM * DIN, DM, DIN, WT_IN + (size_t)l * DIN * DM, scr, r, lane); continue; } r -= I_IN;
            if (r < I_OUT) { transpose_item<true>(a.w_out + (size_t)l * DM * DM, DM, DM, WT_OUT + (size_t)l * DM * DM, scr, r, lane); continue; } r -= I_OUT;
            if (r < I_1) { transpose_item<true>(a.w_ff1 + (size_t)l * DM * DFF, DM, DFF, WT_1 + (size_t)l * DFF * DM, scr, r, lane); continue; } r -= I_1;
            transpose_item<true>(a.w_ff2 + (size_t)l * DFF * DM, DFF, DM, WT_2 + (size_t)l * DM * DFF, scr, r, lane); }
        const int gt = bx * NTHR + tid, ngt = G * NTHR;
        for (int i = gt; i < SEQ * 32; i += ngt) { const int t = i >> 5, d = i & 31; const float inv = powf(10000.0f, -(float)(d & 15) / 16.0f); const float ang = (float)(d < 16 ? (t >> 6) : (t & 63)) * inv;
            ROPE[2 * i] = cosf(ang); ROPE[2 * i + 1] = sinf(ang); }
        for (int i = gt; i < DEPTH * 2 * 2 * 4 * 4096; i += ngt) { const int cin = i & 63, dout = (i >> 6) & 63, k = (i >> 12) & 3, ty = (i >> 14) & 1, ld = i >> 15;
            const float* src = ty ? a.lru_wx : a.lru_wa; WLRU[i] = (bf16)f2bf(src[(((size_t)ld * 4 + k) * 64 + cin) * 64 + dout]); }
        __syncthreads();
    }
    grid.sync();
    { IDS(); modulate_rows(a, MOD, U, gw_, ngw, lane_); }
    GRID_BAR();

    for (int l = 0; l < DEPTH; ++l) {
        const bool need_ctx = l < DEPTH - 1; const int mrows = need_ctx ? MT : ML;
        const float* modl = MOD + (size_t)l * 9 * 6144;
#ifndef SKIP_G1
        for (int rep_ = 1; rep_ < REP_G1N; ++rep_) { pg8::Gemm g{U, WT_IN + (size_t)l * DIN * DM, MT, DIN, DM}; pg8::StaticOrder S; S.init(MT, DIN, G, bx); pg8::EpiNull E{XC}; pg8::gemm_phase<pg8::EpiNull, pg8::StaticOrder, true, true>(lds, g, S, E); }
        for (int rep_ = 0; rep_ < REP_G1; ++rep_)
        {   pg8::Gemm g{U, WT_IN + (size_t)l * DIN * DM, MT, DIN, DM}; pg8::StaticOrder S; S.init(MT, DIN, G, bx);
            pg8::EpiIn E{P4, AQ, KB, VB, LX, LG, a.q_gain + l * 64, a.k_gain + l * 64, ROPE};
            pg8::gemm_phase<pg8::EpiIn, pg8::StaticOrder, true, true>(lds, g, S, E); }
#endif
        GRID_BAR();
        for (int rep_ = 0; rep_ < REP_SYNC; ++rep_) GRID_BAR();
#ifndef SKIP_R1
        for (int rep_ = 0; rep_ < REP_S2; ++rep_) {
        { IDS();
            if (G == 256) { if (bx < 64) { for (int k = 0; k < 2; ++k) ret_contrib_unit(2 * bx + k, RK, RV, a.ret_decay + l * 8, RETC, lds, tid_, lane_, wave_); }
                            else for (int u = 128 + (bx - 64); u < 32 * 34; u += 192) ret_contrib_unit(u, RK, RV, a.ret_decay + l * 8, RETC, lds, tid_, lane_, wave_); }
            else for (int u = (bx + G - 64) % G; u < 32 * 34; u += G) ret_contrib_unit(u, RK, RV, a.ret_decay + l * 8, RETC, lds, tid_, lane_, wave_); }
#endif
#ifndef SKIP_L1
        { IDS(); for (int u = bx; u < 272 * 4; u += G) lru_pass1_unit(u, a, l, LX, WLRU, AD, LCS4, lds, tid_, lane_, wave_); }
#endif
        }
        GRID_BAR();
        { IDS(); ret_prefix_phase(RETC, a.ret_decay + l * 8, bx * NTHR + tid_, G * NTHR); lru_compose_phase(LCS4, LCS, bx * NTHR + tid_, G * NTHR); }
        GRID_BAR();
#ifndef SKIP_ATT
        for (int rep_ = 0; rep_ < REP_ATT; ++rep_)
        {   const int nlat = NB * 8 * 16, natt = nlat + (need_ctx ? NB * 8 : 0);
            for (int u = vcu; u < natt; u += G) {
                if (u < nlat) { const int qb = u & 15, h = (u >> 4) & 3, kvh = (u >> 6) & 1, b = u >> 7; const int hq = kvh * 4 + h;
                    const size_t row0 = (size_t)b * SEQ + qb * 256;
                    attn_body::attn_unit<8>((const attn_body::bf16*)(AQ + row0 * 512 + hq * 64), (const attn_body::bf16*)(KB + (size_t)b * KVL * 128 + kvh * 64), (const attn_body::bf16*)(VB + (size_t)b * KVL * 128 + kvh * 64),
                                            (attn_body::bf16*)(MIX + row0 * DM + 256 + hq * 64), KVL / 64, (char*)lds_raw);
                } else { const int j = u - nlat, hq = j & 7, b = j >> 3, kvh = hq >> 2; const size_t row0 = (size_t)ML + b * CTXL;
                    attn_body::attn_unit<8>((const attn_body::bf16*)(AQ + row0 * 512 + hq * 64), (const attn_body::bf16*)(KB + ((size_t)b * KVL + SEQ) * 128 + kvh * 64), (const attn_body::bf16*)(VB + ((size_t)b * KVL + SEQ) * 128 + kvh * 64),
                                            (attn_body::bf16*)(MIX + row0 * DM + 256 + hq * 64), CTXL / 64, (char*)lds_raw); } }
            asm volatile("s_waitcnt vmcnt(0) lgkmcnt(0)" ::: "memory"); __syncthreads(); }
#endif
#ifndef SKIP_R2
        for (int rep_ = 0; rep_ < REP_R2; ++rep_)
            { IDS(); for (int u = (vcu + G - 64) % G; u < 32 * 34; u += G) { if (!need_ctx && (u % 34) >= 32) continue; ret_out_unit(u, RQ, RK, RV, RG, a.ret_decay + l * 8, RETC, MIX, lds, tid_, lane_, wave_); } }
#endif
#ifndef SKIP_L2
        for (int rep_ = 0; rep_ < REP_L2; ++rep_)
            { IDS(); for (int u = (vcu + G - 128) % G; u < 272; u += G) { if (!need_ctx && u >= 256) continue; lru_pass2_unit(u, AD, LCS, LG, MIX, lds, tid_); } }
#endif
        GRID_BAR();
#ifndef SKIP_G4
        for (int rep_ = 1; rep_ < REP_G4; ++rep_) { pg8::Gemm g{MIX, WT_OUT + (size_t)l * DM * DM, mrows, DM, DM}; pg8::StaticOrder S; S.init(mrows, DM, G, bx); pg8::EpiNull E{XC}; pg8::gemm_phase<pg8::EpiNull, pg8::StaticOrder, true, true>(lds, g, S, E); }
        for (int rep_ = 1; rep_ < REP_G4E; ++rep_) { pg8::Gemm g{MIX, WT_OUT + (size_t)l * DM * DM, mrows, DM, DM}; pg8::StaticOrder S; S.init(mrows, DM, G, bx); pg8::EpiRes E{l == 0 ? a.x : a.out, l == 0 ? a.ctx : XC, (float*)R, (float*)R + (size_t)ML * DM, modl + 2 * 1024, RETC, nullptr, nullptr}; pg8::gemm_phase<pg8::EpiRes, pg8::StaticOrder, true, true>(lds, g, S, E); }
        {   pg8::Gemm g{MIX, WT_OUT + (size_t)l * DM * DM, mrows, DM, DM};
            pg8::EpiRes E{a.x, l == 0 ? a.ctx : XC, a.out, XC, modl + 2 * 1024, RETC, l ? (const bf16*)a.out : nullptr, U};
            if (need_ctx) { pg8::SplitOrder S; S.init(DM, G, bx, 2); pg8::gemm_phase<pg8::EpiRes, pg8::SplitOrder, true, true>(lds, g, S, E); }
            else { pg8::StaticOrder S; S.init(mrows, DM, G, bx); pg8::gemm_phase<pg8::EpiRes, pg8::StaticOrder, true, true>(lds, g, S, E); } }
#endif
        GRID_BAR();
        for (int rep_ = 1; rep_ < REP_LN; ++rep_) { IDS(); ln_rows(a.out, XC, mrows, a.ln1_g + l * DM, a.ln1_b + l * DM, modl + 3 * 1024, (bf16*)AD, gw_, ngw, lane_, (float*)H); }
        { IDS(); ln_rows(a.out, XC, mrows, a.ln1_g + l * DM, a.ln1_b + l * DM, modl + 3 * 1024, U, gw_, ngw, lane_, nullptr, need_ctx ? RETC : nullptr, modl + 2 * 1024 + 8 * 6144, l == 0 ? a.ctx : nullptr, U, (bf16*)a.out); }
        GRID_BAR();
#ifndef SKIP_G6
        for (int rep_ = 0; rep_ < REP_G6; ++rep_)
        {   pg8::Gemm g{U, WT_1 + (size_t)l * DFF * DM, mrows, DFF, DM}; pg8::StaticOrder S; S.init(mrows, DFF, G, bx);
            pg8::EpiFF1 E{H};
            pg8::gemm_phase<pg8::EpiFF1, pg8::StaticOrder, true, true>(lds, g, S, E); }
#endif
        GRID_BAR();
#ifndef SKIP_G4
        for (int rep_ = 1; rep_ < REP_G7; ++rep_) { pg8::Gemm g{H, WT_2 + (size_t)l * DM * DFF, mrows, DM, DFF}; pg8::StaticOrder S; S.init(mrows, DM, G, bx); pg8::EpiNull E{XC}; pg8::gemm_phase<pg8::EpiNull, pg8::StaticOrder, true, true>(lds, g, S, E); }
        {   pg8::Gemm g{H, WT_2 + (size_t)l * DM * DFF, mrows, DM, DFF};
            pg8::EpiRes E{a.out, XC, a.out, XC, modl + 5 * 1024, RETC, (const bf16*)a.out, U};
            if (need_ctx) { pg8::SplitOrder S; S.init(DM, G, bx, 3); pg8::gemm_phase<pg8::EpiRes, pg8::SplitOrder, true, true>(lds, g, S, E); }
            else { pg8::StaticOrder S; S.init(mrows, DM, G, bx); pg8::gemm_phase<pg8::EpiRes, pg8::StaticOrder, true, true>(lds, g, S, E); } }
#endif
        GRID_BAR();
        { IDS(); ln_rows(a.out, XC, mrows, a.ln2_g + l * DM, a.ln2_b + l * DM, need_ctx ? modl + 9 * 6144 : nullptr, U, gw_, ngw, lane_, nullptr, need_ctx ? RETC : nullptr, modl + 5 * 1024 + 8 * 6144, nullptr, U, need_ctx ? (bf16*)a.out : nullptr, 8); }
        if (need_ctx) GRID_BAR();
    }
}

extern "C" void kernel_launch(void* const* d_in, const int* in_sizes, int n_in, void* d_out, int out_size, void* d_ws, size_t ws_size, hipStream_t stream) {
    static int grid = 0;
    if (grid == 0) {
        if (n_in != 24 || in_sizes[0] != ML * DM || out_size != ML * DM || ws_size < WS_END) { fprintf(stderr, "kernel_launch: unexpected shapes (n_in %d, in0 %d, out %d, ws %zu < %zu)\n", n_in, n_in > 0 ? in_sizes[0] : -1, out_size, ws_size, (size_t)WS_END); grid = -1; return; }
        int dev = 0, cus = 0, per_cu = 0;
        (void)hipGetDevice(&dev); (void)hipDeviceGetAttribute(&cus, hipDeviceAttributeMultiprocessorCount, dev);
        if (hipFuncSetAttribute((const void*)trunk_fwd, hipFuncAttributeMaxDynamicSharedMemorySize, LDS_BYTES) != hipSuccess) { fprintf(stderr, "kernel_launch: hipFuncSetAttribute failed\n"); grid = -1; return; }
        if (hipOccupancyMaxActiveBlocksPerMultiprocessor(&per_cu, (const void*)trunk_fwd, NTHR, LDS_BYTES) != hipSuccess || per_cu < 1) { fprintf(stderr, "kernel_launch: occupancy query says %d\n", per_cu); per_cu = 1; }
        (void)hipGetLastError();
        grid = cus * 1;
        if (grid <= 0) grid = 256;
    }
    if (grid < 0) return;
    Args a{};
    const float** f = (const float**)&a;
    for (int i = 0; i < 24; ++i) f[i] = (const float*)d_in[i];
    a.out = (float*)d_out; a.ws = (unsigned char*)d_ws;
    (void)hipMemsetAsync((unsigned char*)d_ws + WS_CTL, 0, CTL_BYTES, stream);
    void* args[] = {&a};
    hipError_t e = hipLaunchCooperativeKernel((const void*)trunk_fwd, dim3(grid), dim3(NTHR), args, LDS_BYTES, stream);
    if (e != hipSuccess) fprintf(stderr, "kernel_launch: cooperative launch failed: %s (grid %d)\n", hipGetErrorString(e), grid);
}
```

```cpp
#include <hip/hip_runtime.h>
#include <hip/hip_cooperative_groups.h>
#include <hip/hip_bf16.h>
#include <hip/hip_fp16.h>
#include <cstdio>
#include <cstdint>
#include <cmath>
namespace cg = cooperative_groups;

constexpr int DM = 1024, NB = 8, SEQ = 4096, CTXL = 256, DEPTH = 4;
constexpr int ML = NB * SEQ, MC = NB * CTXL, MT = ML + MC;
constexpr int DIN = 2304, DFF = 4096, KVL = SEQ + CTXL;
constexpr float ALPHA = 1.6817928305074290f, EPSN = 1e-6f;
namespace pg8 {
#define PG8_LAS __attribute__((address_space(3)))
typedef unsigned short bf16_t;
typedef short bf16x8 __attribute__((ext_vector_type(8)));
typedef float f32x4 __attribute__((ext_vector_type(4)));
typedef unsigned u32x4 __attribute__((ext_vector_type(4)));
constexpr int BM = 256, BK = 64, HALF = 128, HTB = HALF * BK * 2  , STAGE_BYTES = 8 * HTB, NXCD = 8, WGM = 8;

__host__ __device__ __forceinline__ int lds_byte(int r, int c) { const int st = (r >> 4) * 2 + (c >> 5), rr = r & 15, cc = c & 31, ob = rr * 64 + cc * 2; return st * 1024 + (ob ^ (((ob >> 9) & 1) << 5)); }
__host__ __device__ __forceinline__ void stage_rc(int b, int& R, int& C) { const int st = b / 1024, sb = b % 1024, swz = sb ^ (((sb >> 9) & 1) << 5); R = (st >> 1) * 16 + swz / 64; C = (st & 1) * 32 + (swz % 64) / 2; }
__host__ __device__ __forceinline__ int perm32(int rho) { const int n = rho >> 4, i = rho & 15; return 8 * (i >> 2) + 4 * n + (i & 3); }

struct Unit { int pm, pn, ks; };
struct Gemm { const bf16_t* A; const bf16_t* Bt; int M, N, K; };

struct StaticOrder {
    int nM, nN, nwg, G, c;
    __host__ __device__ void init(int M, int N, int G_, int c_) { nM = M / BM; nN = N / BM; nwg = nM * nN; G = G_; c = c_; }
    __host__ __device__ bool next(int i, Unit& u) const {
        const long L = (long)i * G + c; if (L >= nwg) return false;
        int wgid = (int)L; { const int q = nwg / NXCD, r = nwg % NXCD, xcd = wgid % NXCD, off = wgid / NXCD; wgid = (xcd < r ? xcd * (q + 1) : r * (q + 1) + (xcd - r) * q) + off; }
        const int nig = WGM * nN, gid = wgid / nig, fm = gid * WGM, gsz = (nM - fm) < WGM ? (nM - fm) : WGM;
        u.pm = fm + ((wgid % nig) % gsz); u.pn = (wgid % nig) / gsz; u.ks = -1; return true;
    }
    __device__ __forceinline__ void a_ready(const Unit&) const {}
    __device__ __forceinline__ void done(const Unit&) const {}
};


struct SplitOrder {
    StaticOrder base; int G, c, ksh;
    __host__ __device__ void init(int N, int G_, int c_, int ksh_) { base.init(32768, N, G_, c_); G = G_; c = c_; ksh = ksh_; }
    __host__ __device__ bool next(int i, Unit& u) const {
        if (base.next(i, u)) return true;
        const long L = (long)i * G + c - base.nwg; if (L < 0 || L >= (32 << ksh)) return false;
        u.pm = 128 + (int)(L >> (2 + ksh)); u.pn = (int)(L >> ksh) & 3; u.ks = (int)L & ((1 << ksh) - 1); return true;
    }
    __device__ __forceinline__ void a_ready(const Unit&) const {}
    __device__ __forceinline__ void done(const Unit&) const {}
};
__device__ __forceinline__ unsigned cvt_pk_bf16(float lo, float hi) { unsigned r; asm volatile("v_cvt_pk_bf16_f32 %0, %1, %2" : "=v"(r) : "v"(lo), "v"(hi)); return r; }
typedef unsigned u32x4 __attribute__((ext_vector_type(4)));
__device__ __forceinline__ float fast_sigmoid(float x) { return __builtin_amdgcn_rcpf(1.0f + __expf(-x)); }
__device__ __forceinline__ float act_silu(float x) { return x * fast_sigmoid(x); }
__device__ __forceinline__ float act_gelu_tanh(float x) { const float z = 0.7978845608028654f * (x + 0.044715f * x * x * x); return x * fast_sigmoid(2.0f * z); }
__device__ __forceinline__ u32x4 pack8(const f32x4 a, const f32x4 b) { u32x4 w; w.x = cvt_pk_bf16(a[0], a[1]); w.y = cvt_pk_bf16(a[2], a[3]); w.z = cvt_pk_bf16(b[0], b[1]); w.w = cvt_pk_bf16(b[2], b[3]); return w; }

struct EpiIn {
    static constexpr bool PERM = true, AFTER_DRAIN = false;
    bf16_t* P4;
    bf16_t *AQ, *KB, *VB, *LX, *LG;
    const float *qgain, *kgain, *rope;
    __device__ __forceinline__ void operator()(const f32x4 (&acc)[2][2][4][2], const Unit& u, int wr, int wc, int fr, int fq) const {
        const int pn = u.pn; const int rowb = u.pm * BM + wr * 64 + fr; const bool lat = u.pm < (32768 / BM);
        if (pn < 4 || pn >= 7) {
            bf16_t* base = pn < 4 ? P4 + (size_t)pn * ((size_t)34816 * 256) : (pn == 7 ? LX : LG);
#pragma unroll
            for (int ai = 0; ai < 2; ++ai)
#pragma unroll
                for (int m = 0; m < 4; ++m) { bf16_t* rp = base + (size_t)(rowb + ai * HALF + m * 16) * 256 + 64 * wc + 8 * fq;
#pragma unroll
                    for (int bj = 0; bj < 2; ++bj) { f32x4 v0 = acc[ai][bj][m][0], v1 = acc[ai][bj][m][1];
                        if (pn == 1) { v0 = v0 * 0.125f; v1 = v1 * 0.125f; }
                        else if (pn == 3) {
#pragma unroll
                            for (int e = 0; e < 4; ++e) { v0[e] = act_silu(v0[e]); v1[e] = act_silu(v1[e]); } }
                        else if (pn == 8) {
#pragma unroll
                            for (int e = 0; e < 4; ++e) { v0[e] = act_gelu_tanh(v0[e]); v1[e] = act_gelu_tanh(v1[e]); } }
                        *(u32x4*)(rp + 32 * bj) = pack8(v0, v1); } }
        } else if (pn < 6 || wc < 2) {
            const bool isq = pn < 6; const float* gain = isq ? qgain : kgain;
            const float post = isq ? (0.125f * 1.4426950408889634f) : 1.0f;
            f32x4 g1[2], g2[2];
#pragma unroll
            for (int n = 0; n < 2; ++n) { g1[n] = *(const f32x4*)(gain + 8 * fq + 4 * n); g2[n] = *(const f32x4*)(gain + 32 + 8 * fq + 4 * n); }
            float invf[2][4];
#pragma unroll
            for (int n = 0; n < 2; ++n)
#pragma unroll
                for (int e = 0; e < 4; ++e) invf[n][e] = __builtin_amdgcn_exp2f(-(float)((8 * fq + 4 * n + e) & 15) * (13.287712379549449f / 16.0f)) * 0.15915494309189535f;
#pragma unroll
            for (int ai = 0; ai < 2; ++ai)
#pragma unroll
                for (int m = 0; m < 4; ++m) { const int row = rowb + ai * HALF + m * 16;
                    float ss = 0.f;
#pragma unroll
                    for (int bj = 0; bj < 2; ++bj)
#pragma unroll
                        for (int n = 0; n < 2; ++n) { const f32x4 x = acc[ai][bj][m][n]; ss += (x[0] * x[0] + x[1] * x[1]) + (x[2] * x[2] + x[3] * x[3]); }
                    ss += __shfl_xor(ss, 16); ss += __shfl_xor(ss, 32);
                    const float rs = rsqrtf(ss * (1.0f / 64.0f) + 1e-6f);
                    f32x4 o1[2], o2[2];
#pragma unroll
                    for (int n = 0; n < 2; ++n) { o1[n] = acc[ai][0][m][n] * rs * g1[n]; o2[n] = acc[ai][1][m][n] * rs * g2[n]; }
                    if (lat) { const int t = row & 4095; const float pos = (float)(fq < 2 ? (t >> 6) : (t & 63));
#pragma unroll
                        for (int n = 0; n < 2; ++n)
#pragma unroll
                            for (int e = 0; e < 4; ++e) { const float rev = pos * invf[n][e]; const float c = __builtin_amdgcn_cosf(rev), s = __builtin_amdgcn_sinf(rev);
                                const float x1 = o1[n][e], x2 = o2[n][e]; o1[n][e] = x1 * c - x2 * s; o2[n][e] = x1 * s + x2 * c; } }
#pragma unroll
                    for (int n = 0; n < 2; ++n) { o1[n] = o1[n] * post; o2[n] = o2[n] * post; }
                    bf16_t* dst;
                    if (isq) dst = AQ + (size_t)row * 512 + ((pn - 4) * 4 + wc) * 64 + 8 * fq;
                    else { const int j = row - 32768; const int kvrow = lat ? (row >> 12) * 4352 + (row & 4095) : (j >> 8) * 4352 + 4096 + (j & 255); dst = KB + (size_t)kvrow * 128 + wc * 64 + 8 * fq; }
                    *(u32x4*)dst = pack8(o1[0], o1[1]); *(u32x4*)(dst + 32) = pack8(o2[0], o2[1]); }
        } else {
#pragma unroll
            for (int ai = 0; ai < 2; ++ai)
#pragma unroll
                for (int m = 0; m < 4; ++m) { const int row = rowb + ai * HALF + m * 16; const int j = row - 32768;
                    const int kvrow = lat ? (row >> 12) * 4352 + (row & 4095) : (j >> 8) * 4352 + 4096 + (j & 255);
                    bf16_t* dst = VB + (size_t)kvrow * 128 + (wc - 2) * 64 + 8 * fq;
#pragma unroll
                    for (int bj = 0; bj < 2; ++bj) *(u32x4*)(dst + 32 * bj) = pack8(acc[ai][bj][m][0], acc[ai][bj][m][1]); }
        }
    }
};

struct EpiFF1 {
    static constexpr bool PERM = true, AFTER_DRAIN = false;
    bf16_t* H;
    __device__ __forceinline__ void operator()(const f32x4 (&acc)[2][2][4][2], const Unit& u, int wr, int wc, int fr, int fq) const {
        const int rowb = u.pm * BM + wr * 64 + fr; const int col0 = u.pn * BM + wc * 64 + 8 * fq;
#pragma unroll
        for (int ai = 0; ai < 2; ++ai)
#pragma unroll
            for (int m = 0; m < 4; ++m) { bf16_t* rp = H + (size_t)(rowb + ai * HALF + m * 16) * 4096 + col0;
#pragma unroll
                for (int bj = 0; bj < 2; ++bj) { f32x4 v0 = acc[ai][bj][m][0], v1 = acc[ai][bj][m][1];
#pragma unroll
                    for (int e = 0; e < 4; ++e) { const float a = fmaxf(v0[e], 0.f), b = fmaxf(v1[e], 0.f); v0[e] = a * a; v1[e] = b * b; }
                    __builtin_nontemporal_store(pack8(v0, v1), (u32x4*)(rp + bj * 32)); } }
    }
};

struct EpiRes {
    static constexpr bool PERM = true, AFTER_DRAIN = false;
    const float *rinL, *rinC; float *routL, *routC; const float* gate;
    float* part;
    const bf16_t* rinB;
    bf16_t* vout;
    __device__ __forceinline__ void operator()(const f32x4 (&acc)[2][2][4][2], const Unit& u, int wr, int wc, int fr, int fq) const {
        const bool lat = u.pm < (32768 / BM); const int bb = lat ? (u.pm >> 4) : 8;
        const int rowb = u.pm * BM + wr * 64 + fr; const int col0 = u.pn * BM + wc * 64 + 8 * fq;
        if (u.ks >= 0) { bf16_t* pb = (bf16_t*)part + ((size_t)u.ks * 2048 - 32768) * 1024;
#pragma unroll
            for (int ai = 0; ai < 2; ++ai)
#pragma unroll
                for (int m = 0; m < 4; ++m) { const size_t off = (size_t)(rowb + ai * HALF + m * 16) * 1024 + col0;
#pragma unroll
                    for (int bj = 0; bj < 2; ++bj) *(u32x4*)(pb + off + bj * 32) = pack8(acc[ai][bj][m][0], acc[ai][bj][m][1]); }
            return; }
        const float* gp = gate + (size_t)bb * 6144 + col0;
        f32x4 gv[2][2];
#pragma unroll
        for (int bj = 0; bj < 2; ++bj)
#pragma unroll
            for (int n = 0; n < 2; ++n) gv[bj][n] = *(const f32x4*)(gp + bj * 32 + n * 4);
        const float* ib = lat ? rinL : rinC - (size_t)32768 * 1024; float* ob = lat ? routL : routC - (size_t)32768 * 1024;
        const bool tobf = lat && vout != nullptr;
#pragma unroll
        for (int ai = 0; ai < 2; ++ai)
#pragma unroll
            for (int m = 0; m < 4; ++m) { const size_t off = (size_t)(rowb + ai * HALF + m * 16) * 1024 + col0;
#pragma unroll
                for (int bj = 0; bj < 2; ++bj) { f32x4 o[2];
                    if (lat && rinB) { const u32x4 w = *(const u32x4*)(rinB + off + bj * 32);
                        const f32x4 b0 = {__builtin_bit_cast(float, w.x << 16), __builtin_bit_cast(float, w.x & 0xffff0000u), __builtin_bit_cast(float, w.y << 16), __builtin_bit_cast(float, w.y & 0xffff0000u)};
                        const f32x4 b1 = {__builtin_bit_cast(float, w.z << 16), __builtin_bit_cast(float, w.z & 0xffff0000u), __builtin_bit_cast(float, w.w << 16), __builtin_bit_cast(float, w.w & 0xffff0000u)};
                        o[0] = b0 * 1.6817928305074290f + gv[bj][0] * acc[ai][bj][m][0]; o[1] = b1 * 1.6817928305074290f + gv[bj][1] * acc[ai][bj][m][1]; }
                    else {
#pragma unroll
                    for (int n = 0; n < 2; ++n) { const f32x4 bs = *(const f32x4*)(ib + off + bj * 32 + n * 4); o[n] = bs * 1.6817928305074290f + gv[bj][n] * acc[ai][bj][m][n]; } }
                    if (tobf) *(u32x4*)(vout + off + bj * 32) = pack8(o[0], o[1]);
                    else { *(f32x4*)(ob + off + bj * 32) = o[0]; *(f32x4*)(ob + off + bj * 32 + 4) = o[1]; } }
                if (m == 3) asm volatile("" ::: "memory"); }
    }
};

struct EpiNull {
    static constexpr bool PERM = false, AFTER_DRAIN = false;
    float* sink;
    __device__ __forceinline__ void operator()(const f32x4 (&acc)[2][2][4][2], const Unit& u, int wr, int wc, int fr, int fq) const {
        float s = 0.f;
#pragma unroll
        for (int ai = 0; ai < 2; ++ai)
#pragma unroll
            for (int bj = 0; bj < 2; ++bj)
#pragma unroll
                for (int m = 0; m < 4; ++m)
#pragma unroll
                    for (int n = 0; n < 2; ++n) s += acc[ai][bj][m][n][0] + acc[ai][bj][m][n][1] + acc[ai][bj][m][n][2] + acc[ai][bj][m][n][3];
        if (s == 123.456f) sink[0] = s;
    }
};
template <class Epi, class Sched, bool ALIGN_EPI = false, bool SP2 = false>
__device__ __forceinline__ void gemm_phase(PG8_LAS unsigned char* lds, const Gemm g, const Sched& S, const Epi& E) {
    int tid = threadIdx.x; asm volatile("" : "+v"(tid));
    const int wid = __builtin_amdgcn_readfirstlane(tid >> 6), lane = tid & 63, wr = wid >> 2, wc = wid & 3, fr = lane & 15, fq = lane >> 4;
    const int K = g.K, nt = K / BK;
    const int ksh = (K >= 4096) ? 3 : 2;
#define PG8_NT(u_) ((u_).ks < 0 ? nt : (nt >> ksh))
#define PG8_KOFF(u_) ((u_).ks < 0 ? (size_t)0 : (size_t)(u_).ks * (size_t)(K >> ksh) * 2)
    unsigned voffA[2], voffB[2];
#pragma unroll
    for (int i = 0; i < 2; ++i) { int R, C; stage_rc(tid * 16 + i * 8192, R, C); const int Rb = Epi::PERM ? ((R & ~31) + perm32(R & 31)) : R;
        voffA[i] = (unsigned)(R * K + C) * 2u; voffB[i] = (unsigned)(Rb * K + C) * 2u; }
    const size_t kstep = (size_t)(BK * 2);
    const size_t hstep = (size_t)HALF * K * 2;
    const size_t tstep = 2 * hstep;
    const unsigned ldsw = (unsigned)wid * 1024u;
    const int aoff = lds_byte(wr * 64 + fr, fq * 8), boff = lds_byte(wc * 32 + fr, fq * 8);
#define PG8_SA(b, h) (((b) * 2 + (h)) * HTB)
#define PG8_SB(b, h) ((4 + (b) * 2 + (h)) * HTB)
#define PG8_STAGE(bufoff, gbase, voff) do { _Pragma("unroll") for (int _i = 0; _i < 2; ++_i) \
        __builtin_amdgcn_global_load_lds((const unsigned*)((const char*)(gbase) + (voff)[_i]), (PG8_LAS unsigned*)(lds + (bufoff) + ldsw + _i * 8192), 16, 0, 0); } while (0)
#define PG8_LDA(dst, b, h) do { _Pragma("unroll") for (int m = 0; m < 4; ++m) _Pragma("unroll") for (int k = 0; k < 2; ++k) dst[m][k] = *(const PG8_LAS bf16x8*)(lds + PG8_SA(b, h) + aoff + m * 2048 + k * 1024); } while (0)
#define PG8_LDB(dst, b, h) do { _Pragma("unroll") for (int n = 0; n < 2; ++n) _Pragma("unroll") for (int k = 0; k < 2; ++k) dst[n][k] = *(const PG8_LAS bf16x8*)(lds + PG8_SB(b, h) + boff + n * 2048 + k * 1024); } while (0)
#define PG8_MMA(ai, bj, At, Bt) do { __builtin_amdgcn_s_setprio(1); _Pragma("unroll") for (int m = 0; m < 4; ++m) _Pragma("unroll") for (int n = 0; n < 2; ++n) _Pragma("unroll") for (int k = 0; k < 2; ++k) \
        acc[ai][bj][m][n] = __builtin_amdgcn_mfma_f32_16x16x32_bf16(Bt[n][k], At[m][k], acc[ai][bj][m][n], 0, 0, 0); __builtin_amdgcn_s_setprio(0); } while (0)
#define PG8_WAIT_V(n) asm volatile("s_waitcnt vmcnt(" #n ")" ::: "memory")
#define PG8_WAIT_L(n) asm volatile("s_waitcnt lgkmcnt(" #n ")" ::: "memory")
#define PG8_BAR __builtin_amdgcn_s_barrier()
#define PG8_SCHED __builtin_amdgcn_sched_barrier(0)
    Unit cur, nxt; int ui = 0;
    if (!S.next(0, cur)) return;
    f32x4 acc[2][2][4][2];
#pragma unroll
    for (int a = 0; a < 2; ++a)
#pragma unroll
        for (int b = 0; b < 2; ++b)
#pragma unroll
            for (int m = 0; m < 4; ++m)
#pragma unroll
                for (int n = 0; n < 2; ++n) acc[a][b][m][n] = (f32x4){0.f, 0.f, 0.f, 0.f};
    bf16x8 At[4][2], B0[2][2], B1[2][2];
    const char* cA = (const char*)g.A + (size_t)cur.pm * tstep + PG8_KOFF(cur); const char* cB = (const char*)g.Bt + (size_t)cur.pn * tstep + PG8_KOFF(cur);
    S.a_ready(cur);
    if constexpr (SP2) {
        PG8_STAGE(PG8_SB(0, 0), cB, voffB); PG8_STAGE(PG8_SB(0, 1), cB + hstep, voffB); PG8_STAGE(PG8_SA(0, 0), cA, voffA); PG8_STAGE(PG8_SA(0, 1), cA + hstep, voffA);
        if (wr == 1) PG8_BAR;
        PG8_WAIT_V(2); PG8_BAR;
        PG8_STAGE(PG8_SB(1, 0), cB + kstep, voffB); PG8_STAGE(PG8_SA(1, 0), cA + kstep, voffA); PG8_STAGE(PG8_SB(1, 1), cB + hstep + kstep, voffB);
        PG8_WAIT_V(6); PG8_BAR;
    } else {
        PG8_STAGE(PG8_SB(0, 0), cB, voffB); PG8_STAGE(PG8_SA(0, 0), cA, voffA); PG8_STAGE(PG8_SB(0, 1), cB + hstep, voffB); PG8_STAGE(PG8_SA(0, 1), cA + hstep, voffA);
        if (wr == 1) PG8_BAR;
        PG8_WAIT_V(4); PG8_BAR;
        PG8_STAGE(PG8_SB(1, 0), cB + kstep, voffB); PG8_STAGE(PG8_SA(1, 0), cA + kstep, voffA); PG8_STAGE(PG8_SB(1, 1), cB + hstep + kstep, voffB);
        PG8_WAIT_V(6); PG8_BAR;
    }
    for (;;) {
        const bool has_next = S.next(ui + 1, nxt);
        const char* nA = has_next ? (const char*)g.A + (size_t)nxt.pm * tstep + PG8_KOFF(nxt) : cA; const char* nB = has_next ? (const char*)g.Bt + (size_t)nxt.pn * tstep + PG8_KOFF(nxt) : cB;
        const int ntc = PG8_NT(cur);
        for (int t = 0; t < ntc; t += 2) {
            const bool last = (t == ntc - 2);
            const char* a1 = cA + (size_t)(t + 1) * kstep;
            const char* a2 = last ? nA : cA + (size_t)(t + 2) * kstep; const char* b2 = last ? nB : cB + (size_t)(t + 2) * kstep;
            const char* a3 = a2 + kstep; const char* b3 = b2 + kstep;
            if (last && has_next) S.a_ready(nxt);
            if constexpr (SP2) {
            PG8_LDB(B0, 0, 0); PG8_LDB(B1, 0, 1); PG8_SCHED; PG8_LDA(At, 0, 0); PG8_STAGE(PG8_SA(1, 1), a1 + hstep, voffA);
            PG8_WAIT_V(8); PG8_WAIT_L(0); PG8_BAR; PG8_MMA(0, 0, At, B0); PG8_MMA(0, 1, At, B1); PG8_BAR; PG8_SCHED;
            PG8_LDA(At, 0, 1); PG8_STAGE(PG8_SB(0, 0), b2, voffB); PG8_STAGE(PG8_SB(0, 1), b2 + hstep, voffB); PG8_STAGE(PG8_SA(0, 0), a2, voffA);
            PG8_WAIT_V(8); PG8_WAIT_L(0); PG8_BAR; PG8_MMA(1, 0, At, B0); PG8_MMA(1, 1, At, B1); PG8_BAR; PG8_SCHED;
            PG8_LDB(B0, 1, 0); PG8_LDB(B1, 1, 1); PG8_SCHED; PG8_LDA(At, 1, 0); PG8_STAGE(PG8_SA(0, 1), a2 + hstep, voffA);
            PG8_WAIT_V(8); PG8_WAIT_L(0); PG8_BAR; PG8_MMA(0, 0, At, B0); PG8_MMA(0, 1, At, B1); PG8_BAR; PG8_SCHED;
            PG8_LDA(At, 1, 1); PG8_STAGE(PG8_SB(1, 0), b3, voffB); PG8_STAGE(PG8_SB(1, 1), b3 + hstep, voffB); PG8_STAGE(PG8_SA(1, 0), a3, voffA);
            PG8_WAIT_V(8); PG8_WAIT_L(0); PG8_BAR; PG8_MMA(1, 0, At, B0); PG8_MMA(1, 1, At, B1); PG8_BAR; PG8_SCHED;
            } else {
            PG8_LDB(B0, 0, 0); PG8_SCHED; PG8_LDA(At, 0, 0); PG8_STAGE(PG8_SA(1, 1), a1 + hstep, voffA);
            PG8_WAIT_L(8); PG8_BAR; PG8_WAIT_L(0); PG8_MMA(0, 0, At, B0); PG8_BAR; PG8_SCHED;
            PG8_LDB(B1, 0, 1); PG8_STAGE(PG8_SB(0, 0), b2, voffB);
            PG8_BAR; PG8_WAIT_L(0); PG8_MMA(0, 1, At, B1); PG8_BAR;
            PG8_LDA(At, 0, 1); PG8_STAGE(PG8_SA(0, 0), a2, voffA);
            PG8_BAR; PG8_WAIT_L(0); PG8_MMA(1, 0, At, B0); PG8_BAR; PG8_SCHED;
            PG8_STAGE(PG8_SB(0, 1), b2 + hstep, voffB);
            PG8_WAIT_V(6); PG8_BAR; PG8_MMA(1, 1, At, B1); PG8_BAR;
            PG8_LDB(B0, 1, 0); PG8_SCHED; PG8_LDA(At, 1, 0); PG8_STAGE(PG8_SA(0, 1), a2 + hstep, voffA);
            PG8_WAIT_L(8); PG8_BAR; PG8_WAIT_L(0); PG8_MMA(0, 0, At, B0); PG8_BAR; PG8_SCHED;
            PG8_LDB(B1, 1, 1); PG8_STAGE(PG8_SB(1, 0), b3, voffB);
            PG8_BAR; PG8_WAIT_L(0); PG8_MMA(0, 1, At, B1); PG8_BAR;
            PG8_LDA(At, 1, 1); PG8_STAGE(PG8_SA(1, 0), a3, voffA);
            PG8_BAR; PG8_WAIT_L(0); PG8_MMA(1, 0, At, B0); PG8_BAR; PG8_SCHED;
            PG8_STAGE(PG8_SB(1, 1), b3 + hstep, voffB);
            PG8_WAIT_V(6); PG8_BAR; PG8_MMA(1, 1, At, B1); PG8_BAR;
            }
        }
        if constexpr (ALIGN_EPI) { if (wr == 0) PG8_BAR; }
        if constexpr (!Epi::AFTER_DRAIN) { E(acc, cur, wr, wc, fr, fq); S.done(cur); }
        if (!has_next) break;
#pragma unroll
        for (int a = 0; a < 2; ++a)
#pragma unroll
            for (int b = 0; b < 2; ++b)
#pragma unroll
                for (int m = 0; m < 4; ++m)
#pragma unroll
                    for (int n = 0; n < 2; ++n) acc[a][b][m][n] = (f32x4){0.f, 0.f, 0.f, 0.f};
        cur = nxt; cA = nA; cB = nB; ++ui;
        if constexpr (ALIGN_EPI) { if (wr == 1) PG8_BAR; }
    }
    PG8_WAIT_V(0);
    if constexpr (!ALIGN_EPI) { if (wr == 0) PG8_BAR; }
    PG8_BAR;
    if constexpr (Epi::AFTER_DRAIN) { E.fused(acc, cur, wr, wc, fr, fq, lds, wid, lane); S.done(cur); }
#undef PG8_NT
#undef PG8_KOFF
#undef PG8_SA
#undef PG8_SB
#undef PG8_STAGE
#undef PG8_LDA
#undef PG8_LDB
#undef PG8_MMA
#undef PG8_WAIT_V
#undef PG8_WAIT_L
#undef PG8_BAR
#undef PG8_SCHED
}
}
#include <hip/hip_bf16.h>
namespace attn_body {
using bf16=__hip_bfloat16;
using bf16x8=__attribute__((ext_vector_type(8)))short;
using s16x4=__attribute__((ext_vector_type(4)))short;
using f32x16=__attribute__((ext_vector_type(16)))float;
using u32x4=__attribute__((ext_vector_type(4)))unsigned;
constexpr int D=64,QP=512,KP=128,OP=1024;
constexpr int NW=8,QBLK=32,QB=QBLK*NW,KVBLK=64;
__device__ __forceinline__ int crow(int r,int hi){return (r&3)+8*(r>>2)+4*hi;}
#define SBAR() __builtin_amdgcn_sched_barrier(0)
__device__ __forceinline__ void cmask(f32x16&p0,f32x16&p1,int jb,int qrel,int hi){
  const float NEG=-INFINITY; int kb=64*jb+4*hi;
  #pragma unroll
  for(int r=0;r<16;++r){int kv=kb+(r&3)+8*(r>>2); if(kv>qrel)p0[r]=NEG; if(kv+32>qrel)p1[r]=NEG;}
}

constexpr int NSLOT=3, SLOTB=8192;
constexpr int LDS_K=0, LDS_V=NSLOT*SLOTB, LDS_WS=2*NSLOT*SLOTB, LDS_OST=LDS_WS+NW*64*4, LDS_BYTES=LDS_OST+NW*4096;
constexpr float C2=0.125f*1.4426950408889634f;
__device__ __forceinline__ void glds16(const void*gsrc,unsigned lds_dst){unsigned keep;
  asm volatile("s_mov_b32 %0, m0\n\ts_mov_b32 m0, %2\n\ts_nop 0\n\tglobal_load_lds_dwordx4 %1, off\n\ts_mov_b32 m0, %0":"=&s"(keep):"v"(gsrc),"s"(lds_dst):"memory");}
__device__ __forceinline__ float max3f(float a,float b,float c){float r;asm("v_max3_f32 %0, %1, %2, %3":"=v"(r):"v"(a),"v"(b),"v"(c));return r;}
__device__ __forceinline__ float max2f(float a,float b){float r;asm("v_max_f32_e32 %0, %1, %2":"=v"(r):"v"(a),"v"(b));return r;}
__device__ __forceinline__ float fadd_s(float a,float b){float r;asm("v_add_f32_e32 %0, %1, %2":"=v"(r):"v"(a),"v"(b));return r;}
__device__ __forceinline__ float fsub_s(float a,float b){float r;asm("v_sub_f32_e32 %0, %1, %2":"=v"(r):"v"(a),"v"(b));return r;}
typedef float f32x2_t __attribute__((ext_vector_type(2))); typedef __bf16 bf16x2_t __attribute__((ext_vector_type(2)));
__device__ __forceinline__ unsigned cvtpk_s(float lo,float hi){f32x2_t v={lo,hi};bf16x2_t b=__builtin_convertvector(v,bf16x2_t);return __builtin_bit_cast(unsigned,b);}
#define WAIT_BAR(N) asm volatile("s_waitcnt vmcnt(" #N ") lgkmcnt(0)\n\ts_barrier":::"memory")

__device__ __forceinline__ void qkt(f32x16&p0,f32x16&p1,const char*Kslot,const bf16x8*qr,const f32x16&negm,int r32,int hi){
  const char*kb=Kslot+hi*1024+r32*16;
  #pragma unroll
  for(int d0=0;d0<4;++d0){
    const bf16x8 b0=*reinterpret_cast<const bf16x8*>(kb+d0*2048);
    const bf16x8 b1=*reinterpret_cast<const bf16x8*>(kb+d0*2048+512);
    if(d0==0){p0=__builtin_amdgcn_mfma_f32_32x32x16_bf16(b0,qr[0],negm,0,0,0);p1=__builtin_amdgcn_mfma_f32_32x32x16_bf16(b1,qr[0],negm,0,0,0);}
    else{p0=__builtin_amdgcn_mfma_f32_32x32x16_bf16(b0,qr[d0],p0,0,0,0);p1=__builtin_amdgcn_mfma_f32_32x32x16_bf16(b1,qr[d0],p1,0,0,0);}}
}
typedef __attribute__((address_space(3))) const char* lds_cptr;
typedef short v4i16_t __attribute__((ext_vector_type(4)));
__device__ __forceinline__ void kload8(bf16x8*kf,lds_cptr kp){
  kf[0]=*(const __attribute__((address_space(3))) bf16x8*)(kp);      kf[1]=*(const __attribute__((address_space(3))) bf16x8*)(kp+512);
  kf[2]=*(const __attribute__((address_space(3))) bf16x8*)(kp+2048); kf[3]=*(const __attribute__((address_space(3))) bf16x8*)(kp+2560);
  kf[4]=*(const __attribute__((address_space(3))) bf16x8*)(kp+4096); kf[5]=*(const __attribute__((address_space(3))) bf16x8*)(kp+4608);
  kf[6]=*(const __attribute__((address_space(3))) bf16x8*)(kp+6144); kf[7]=*(const __attribute__((address_space(3))) bf16x8*)(kp+6656);
}
__device__ __forceinline__ void kload2(bf16x8*kf,lds_cptr kp,int j){ kf[2*j]=*(const __attribute__((address_space(3))) bf16x8*)(kp+j*2048); kf[2*j+1]=*(const __attribute__((address_space(3))) bf16x8*)(kp+j*2048+512); }
__device__ __forceinline__ s16x4 vtr(lds_cptr p){ return __builtin_bit_cast(s16x4,__builtin_amdgcn_ds_read_tr16_b64_v4i16((__attribute__((address_space(3))) v4i16_t*)p)); }
__device__ __forceinline__ float rowmax(const f32x16&p0,const f32x16&p1){
  float a=max3f(p0[0],p0[1],p1[0]),b=max3f(p0[2],p0[3],p1[1]);a=max3f(a,p1[2],p1[3]);
  #pragma unroll
  for(int r=4;r<16;r+=4){a=max3f(a,p0[r],p0[r+1]);b=max3f(b,p0[r+2],p0[r+3]);a=max3f(a,p1[r],p1[r+1]);b=max3f(b,p1[r+2],p1[r+3]);}
  const float m=max2f(a,b);
  auto rr=__builtin_amdgcn_permlane32_swap(__float_as_uint(m),__float_as_uint(m),false,false);
  return max2f(__uint_as_float(rr[0]),__uint_as_float(rr[1]));
}
__device__ __forceinline__ void pv(f32x16*o,int vb,bf16x8 pa0,bf16x8 pa1,bf16x8 pa2,bf16x8 pa3){
  #pragma unroll
  for(int d0=0;d0<2;++d0){s16x4 lo[4],hi[4];
    #pragma unroll
    for(int ks=0;ks<4;++ks){
      asm volatile("ds_read_b64_tr_b16 %0,%1 offset:%c2":"=&v"(lo[ks]):"v"(vb),"i"(d0*4096+ks*1024):"memory");
      asm volatile("ds_read_b64_tr_b16 %0,%1 offset:%c2":"=&v"(hi[ks]):"v"(vb),"i"(d0*4096+ks*1024+512):"memory");}
    asm volatile("s_waitcnt lgkmcnt(0)":::"memory");SBAR();
    #define PK(k) (bf16x8){lo[k][0],lo[k][1],lo[k][2],lo[k][3],hi[k][0],hi[k][1],hi[k][2],hi[k][3]}
    o[d0]=__builtin_amdgcn_mfma_f32_32x32x16_bf16(pa0,PK(0),o[d0],0,0,0);
    o[d0]=__builtin_amdgcn_mfma_f32_32x32x16_bf16(pa1,PK(1),o[d0],0,0,0);
    o[d0]=__builtin_amdgcn_mfma_f32_32x32x16_bf16(pa2,PK(2),o[d0],0,0,0);
    o[d0]=__builtin_amdgcn_mfma_f32_32x32x16_bf16(pa3,PK(3),o[d0],0,0,0);
    #undef PK
  }
}
#define ATTN_STORE16(p,v) (*(u32x4*)(p)=(v))
template<int THRL> __device__ __forceinline__ void attn_unit(const bf16*Qu,const bf16*__restrict__ Kh,const bf16*__restrict__ Vh,bf16*Ou,const int NT,char*shm){
  int tid=threadIdx.x; asm volatile("":"+v"(tid)); const int lane=tid&63,r32=lane&31,hi=lane>>5; const int wid=__builtin_amdgcn_readfirstlane(tid>>6);
  const bf16*Qw=Qu+(long)(wid*QBLK)*QP;
  const unsigned lds0=(unsigned)(uintptr_t)shm;
  float*wsf=(float*)(shm+LDS_WS)+wid*64;
  const bf16*ksrc=Kh+(long)lane*KP+wid*8;
  const bf16*vsrc=Vh+(long)(16*(wid&3)+(lane>>2))*KP+(wid>>2)*32+(lane&3)*8;
  const unsigned kdst=lds0+LDS_K+wid*1024, vdst=lds0+LDS_V+wid*1024;
  #define DMA_K(t,slot) glds16(ksrc+(long)(t)*KVBLK*KP,(unsigned)__builtin_amdgcn_readfirstlane(kdst+(slot)))
  #define DMA_V(t,slot) glds16(vsrc+(long)(t)*KVBLK*KP,(unsigned)__builtin_amdgcn_readfirstlane(vdst+(slot)))
  const int vb0=(int)(lds0+LDS_V)+((lane>>4)&1)*32+(lane&3)*8+(4*hi+((lane&15)>>2))*64;
  const char*Kbase=shm+LDS_K; bf16x8 kf[8];
  const lds_cptr shm3=(lds_cptr)shm; const lds_cptr kp0=shm3+LDS_K+hi*1024+r32*16; const lds_cptr vp0=shm3+LDS_V+((lane>>4)&1)*32+(lane&3)*8+(4*hi+((lane&15)>>2))*64;
  DMA_K(0,0);DMA_V(0,0);DMA_K(1,SLOTB);
  bf16x8 qr[4];
  #pragma unroll
  for(int d0=0;d0<4;++d0)qr[d0]=*reinterpret_cast<const bf16x8*>(&Qw[(long)r32*QP+d0*16+hi*8]);
  float mhat=0.f,l_reg=0.f;f32x16 o[2];o[0]=f32x16{};o[1]=f32x16{};f32x16 negm=f32x16{};asm volatile("":"+v"(negm));
  #define CMASK(P0,P1,t) do{}while(0)
  bool resc=false;
  #define START(P0,P1) do{ const float rm=rowmax(P0,P1); resc=false; \
    { const float dl=rm; mhat=fadd_s(mhat,dl); \
      _Pragma("unroll") for(int r=0;r<16;++r){P0[r]=fsub_s(P0[r],dl);P1[r]=fsub_s(P1[r],dl);} \
      _Pragma("unroll") for(int r=0;r<16;++r)negm[r]=-mhat; asm volatile("":"+v"(negm)); } \
    _Pragma("unroll") for(int r=0;r<16;++r)P0[r]=__builtin_amdgcn_exp2f(P0[r]); }while(0)
  #define RESC() do{ if(resc){ asm volatile("s_waitcnt lgkmcnt(0)":::"memory"); \
      _Pragma("unroll") for(int d_=0;d_<2;++d_) _Pragma("unroll") for(int r=0;r<16;++r)o[d_][r]*=wsf[crow(r,hi)]; } }while(0)
  f32x16 pA0,pA1,pB0,pB1;
  int sl_prev=0,sl_cur=0,sl_next=SLOTB;
  #define ROT() do{sl_prev=sl_cur;sl_cur=sl_next;sl_next=(sl_next==(NSLOT-1)*SLOTB)?0:sl_next+SLOTB;}while(0)
  DMA_K(2,2*SLOTB);
  WAIT_BAR(3);
  qkt(pA0,pA1,Kbase,qr,negm,r32,hi);asm volatile("s_nop 15\n\ts_nop 7":"+v"(pA0),"+v"(pA1));CMASK(pA0,pA1,0);
  START(pA0,pA1);
  _Pragma("unroll") for(int r=0;r<16;++r)pA1[r]=__builtin_amdgcn_exp2f(pA1[r]);
  WAIT_BAR(0);
  DMA_K(3,0);DMA_V(1,SLOTB);
  ROT();
  kload8(kf,kp0+sl_cur);
  WAIT_BAR(2);
  s16x4 vlo[8],vhi[8]; u32x4 pw0,pw1,pw2,pw3;
  #define PKW(P,B) cvtpk_s(P[B],P[B+1])
  #define PAF(k) __builtin_bit_cast(bf16x8,pw##k)
  #define VFR(i) (bf16x8){vlo[i][0],vlo[i][1],vlo[i][2],vlo[i][3],vhi[i][0],vhi[i][1],vhi[i][2],vhi[i][3]}
  #define PIN(x) asm volatile("":"+v"(x))
  #define MX3(a,b,c) __builtin_fmaxf(__builtin_fmaxf((a),(b)),(c))
  #define GAPA(MF,A0,A1,A2,A3,W0,W1,PW) do{ MF; sacc+=A0; sacc+=A1; sacc+=A2; sacc+=A3; PIN(sacc); W0; W1; PIN(PW); SBAR(); }while(0)
  #define EX(v) __builtin_amdgcn_exp2f(v)
  #define GAPB(MF,X,B) do{ MF; X[B]=EX(X[B]); X[B+1]=EX(X[B+1]); X[B+2]=EX(X[B+2]); X[B+3]=EX(X[B+3]); PIN(X); SBAR(); }while(0)
  #define VRD(i) do{ vlo[i]=vtr(vp_+(((i)>>2)*4096+((i)&3)*1024)); vhi[i]=vtr(vp_+(((i)>>2)*4096+((i)&3)*1024+512)); }while(0)
  #define KRD(G,j) do{ if(G){ kload2(kf,kp0+sl_next,j); SBAR(); } }while(0)
  #define STEP(C0,C1,P0,P1,t,GK,GV,GL) do{ SBAR(); \
    const lds_cptr vp_=vp0+sl_prev; \
    VRD(0); SBAR(); float sacc=(P0[0]+P0[1]); \
    GAPA(C0=__builtin_amdgcn_mfma_f32_32x32x16_bf16(kf[0],qr[0],negm,0,0,0), P0[2],P0[3],P0[4],P0[5],     pw0[0]=PKW(P0,0), pw0[1]=PKW(P0,2), pw0); \
    VRD(4); SBAR(); GAPA(C1=__builtin_amdgcn_mfma_f32_32x32x16_bf16(kf[1],qr[0],negm,0,0,0), P0[6],P0[7],P0[8],P0[9],     pw0[2]=PKW(P0,4), pw0[3]=PKW(P0,6), pw0); \
    VRD(1); SBAR(); GAPA(C0=__builtin_amdgcn_mfma_f32_32x32x16_bf16(kf[2],qr[1],C0,0,0,0),   P0[10],P0[11],P0[12],P0[13], pw1[0]=PKW(P0,8), pw1[1]=PKW(P0,10), pw1); \
    VRD(5); SBAR(); GAPA(C1=__builtin_amdgcn_mfma_f32_32x32x16_bf16(kf[3],qr[1],C1,0,0,0),   P0[14],P0[15],P1[0],P1[1],   pw1[2]=PKW(P0,12),pw1[3]=PKW(P0,14), pw1); \
    VRD(2); SBAR(); GAPA(C0=__builtin_amdgcn_mfma_f32_32x32x16_bf16(kf[4],qr[2],C0,0,0,0),   P1[2],P1[3],P1[4],P1[5],     pw2[0]=PKW(P1,0), pw2[1]=PKW(P1,2), pw2); \
    VRD(6); SBAR(); GAPA(C1=__builtin_amdgcn_mfma_f32_32x32x16_bf16(kf[5],qr[2],C1,0,0,0),   P1[6],P1[7],P1[8],P1[9],     pw2[2]=PKW(P1,4), pw2[3]=PKW(P1,6), pw2); \
    VRD(3); SBAR(); GAPA(C0=__builtin_amdgcn_mfma_f32_32x32x16_bf16(kf[6],qr[3],C0,0,0,0),   P1[10],P1[11],P1[12],P1[13], pw3[0]=PKW(P1,8), pw3[1]=PKW(P1,10), pw3); \
    VRD(7); SBAR(); GAPA(C1=__builtin_amdgcn_mfma_f32_32x32x16_bf16(kf[7],qr[3],C1,0,0,0),   P1[14],P1[15],0.f,0.f,       pw3[2]=PKW(P1,12),pw3[3]=PKW(P1,14), pw3); \
    l_reg+=sacc; \
    if(GK){DMA_K((t)+3,sl_cur);} if(GV){DMA_V((t)+1,sl_next);} \
    CMASK(C0,C1,t); \
    { float a=MX3(C0[0],C0[1],C1[0]),b=MX3(C0[2],C0[3],C1[1]); a=MX3(a,C1[2],C1[3]); \
      _Pragma("unroll") for(int r=4;r<16;r+=4){a=MX3(a,C0[r],C0[r+1]);b=MX3(b,C0[r+2],C0[r+3]);a=MX3(a,C1[r],C1[r+1]);b=MX3(b,C1[r+2],C1[r+3]);} \
      float rm=__builtin_fmaxf(a,b); { auto rr=__builtin_amdgcn_permlane32_swap(__float_as_uint(rm),__float_as_uint(rm),false,false); rm=__builtin_fmaxf(__uint_as_float(rr[0]),__uint_as_float(rr[1])); } \
      resc=false; \
      if(__builtin_expect(__any(rm>(float)THRL),0)){ const float dl=__builtin_fmaxf(rm,0.f); mhat+=dl; \
        _Pragma("unroll") for(int r=0;r<16;++r){C0[r]-=dl;C1[r]-=dl;} \
        _Pragma("unroll") for(int r=0;r<16;++r)negm[r]=-mhat; asm volatile("":"+v"(negm)); \
        const float f=__builtin_amdgcn_exp2f(-dl); l_reg*=f; if(hi==0)wsf[r32]=f; resc=true; } } \
    SBAR(); \
    GAPB(o[0]=__builtin_amdgcn_mfma_f32_32x32x16_bf16(PAF(0),VFR(0),o[0],0,0,0), C0,0); \
    GAPB(o[1]=__builtin_amdgcn_mfma_f32_32x32x16_bf16(PAF(0),VFR(4),o[1],0,0,0), C0,4); \
    KRD(GL,0); GAPB(o[0]=__builtin_amdgcn_mfma_f32_32x32x16_bf16(PAF(1),VFR(1),o[0],0,0,0), C0,8); \
    KRD(GL,1); GAPB(o[1]=__builtin_amdgcn_mfma_f32_32x32x16_bf16(PAF(1),VFR(5),o[1],0,0,0), C0,12); \
    KRD(GL,2); GAPB(o[0]=__builtin_amdgcn_mfma_f32_32x32x16_bf16(PAF(2),VFR(2),o[0],0,0,0), C1,0); \
    KRD(GL,3); GAPB(o[1]=__builtin_amdgcn_mfma_f32_32x32x16_bf16(PAF(2),VFR(6),o[1],0,0,0), C1,4); \
    GAPB(o[0]=__builtin_amdgcn_mfma_f32_32x32x16_bf16(PAF(3),VFR(3),o[0],0,0,0), C1,8); \
    GAPB(o[1]=__builtin_amdgcn_mfma_f32_32x32x16_bf16(PAF(3),VFR(7),o[1],0,0,0), C1,12); \
    }while(0)
  int t=1;
  #undef CMASK
  #define CMASK(P0,P1,t) do{}while(0)
  for(;t+5<NT;t+=2){
    STEP(pB0,pB1,pA0,pA1,t,true,true,true);     WAIT_BAR(2); RESC(); ROT();
    STEP(pA0,pA1,pB0,pB1,t+1,true,true,true);   WAIT_BAR(2); RESC(); ROT();
  }
  #undef CMASK
  #define CMASK(P0,P1,t) do{}while(0)
  #define ENDW(tt) do{ if((tt)+3<NT){WAIT_BAR(2);} else if((tt)+2<NT){WAIT_BAR(1);} else {WAIT_BAR(0);} }while(0)
  for(;t+1<NT;t+=2){
    STEP(pB0,pB1,pA0,pA1,t,(t+3<NT),(t+1<NT),(t+1<NT));       ENDW(t);   RESC(); ROT();
    STEP(pA0,pA1,pB0,pB1,t+1,(t+4<NT),(t+2<NT),(t+2<NT));     ENDW(t+1); RESC(); ROT();
  }
  STEP(pB0,pB1,pA0,pA1,NT-1,false,false,false); RESC();
  { float sacc=pB0[0]+pB0[1]; _Pragma("unroll") for(int r=2;r<16;++r)sacc+=pB0[r]; _Pragma("unroll") for(int r=0;r<16;++r)sacc+=pB1[r]; l_reg+=sacc;
    pw0=(u32x4){PKW(pB0,0),PKW(pB0,2),PKW(pB0,4),PKW(pB0,6)};pw1=(u32x4){PKW(pB0,8),PKW(pB0,10),PKW(pB0,12),PKW(pB0,14)};pw2=(u32x4){PKW(pB1,0),PKW(pB1,2),PKW(pB1,4),PKW(pB1,6)};pw3=(u32x4){PKW(pB1,8),PKW(pB1,10),PKW(pB1,12),PKW(pB1,14)};
    SBAR(); pv(o,vb0+sl_cur,PAF(0),PAF(1),PAF(2),PAF(3)); }
  #undef PKW
  #undef PAF
  #undef VFR
  #undef PIN
  #undef MX3
  #undef GAPA
  #undef GAPB
  #undef EX
  #undef VRD
  #undef KRD
  #undef STEP
  #undef ENDW
  {auto rr=__builtin_amdgcn_permlane32_swap(__float_as_uint(l_reg),__float_as_uint(l_reg),false,false);l_reg=__uint_as_float(rr[0])+__uint_as_float(rr[1]);}
  if(hi==0)wsf[32+r32]=l_reg;asm volatile("s_waitcnt lgkmcnt(0)":::"memory");
  float rli[16];
  #pragma unroll
  for(int r=0;r<16;++r)rli[r]=__builtin_amdgcn_rcpf(wsf[32+crow(r,hi)]);
  bf16*Ow=Ou+(long)(wid*QBLK)*OP;
  { bf16*stg=(bf16*)(shm+LDS_OST)+wid*2048;
    #pragma unroll
    for(int r=0;r<16;++r){const int orow=crow(r,hi);
      #pragma unroll
      for(int d0=0;d0<2;++d0)stg[orow*64+d0*32+r32]=__float2bfloat16(o[d0][r]*rli[r]);}
    asm volatile("s_waitcnt lgkmcnt(0)":::"memory");
    #pragma unroll
    for(int i=0;i<4;++i){const int row=i*8+(lane>>3),ch=lane&7; const u32x4 v=*(const u32x4*)(stg+row*64+ch*8); ATTN_STORE16(Ow+(long)row*OP+ch*8,v);} }
  asm volatile("s_waitcnt lgkmcnt(0)\n\ts_barrier":::"memory");
  #undef DMA_K
  #undef DMA_V
  #undef CMASK
  #undef START
  #undef RESC
  #undef ROT
}
#undef SBAR
#undef WAIT_BAR
}
#define LAS __attribute__((address_space(3)))
typedef unsigned short bf16;
typedef unsigned v4u __attribute__((ext_vector_type(4)));
typedef unsigned v2u __attribute__((ext_vector_type(2)));
typedef float f32x4 __attribute__((ext_vector_type(4)));
typedef float f32x16 __attribute__((ext_vector_type(16)));
typedef short bf16x8 __attribute__((ext_vector_type(8)));
typedef LAS unsigned char lds_t;
typedef _Float16 h2 __attribute__((ext_vector_type(2)));
constexpr int NWAVES = 8, NTHR = 512;
constexpr int LDS_BYTES = 155648;
constexpr size_t MiB = 1u << 20;
constexpr size_t WS_WIN = 0, WS_WOUT = 18 * MiB, WS_W1 = 26 * MiB, WS_W2 = 58 * MiB;
constexpr size_t WS_MOD = 90 * MiB, WS_ROPE = 91 * MiB, WS_WLRU = 92 * MiB, WS_LCS = 93 * MiB, WS_XC = 96 * MiB, WS_RETC = 104 * MiB, WS_U = 138 * MiB, WS_R = 206 * MiB;
constexpr size_t R_P4 = 0, R_AQ = 68 * MiB, R_KB = 102 * MiB, R_VB = R_KB + (size_t)NB * KVL * 128 * 2, R_LX = 119 * MiB, R_LG = 136 * MiB, R_MIX = 153 * MiB, R_AD = 221 * MiB, R_END = 289 * MiB;
constexpr size_t WS_CTL = WS_R + R_END, CTL_BYTES = 65536;
constexpr size_t WS_LCS4 = WS_CTL + MiB;
constexpr size_t WS_END = WS_CTL + 7 * MiB;
static_assert(R_VB + (size_t)NB * KVL * 128 * 2 <= R_LX, "ws map");

__device__ __forceinline__ unsigned f2bf(float f) { unsigned u = __builtin_bit_cast(unsigned, f); return (u + 0x7fffu + ((u >> 16) & 1u)) >> 16; }
__device__ __forceinline__ unsigned pk2(float lo, float hi) { return f2bf(lo) | (f2bf(hi) << 16); }
__device__ __forceinline__ float bf2f(unsigned short b) { return __builtin_bit_cast(float, (unsigned)b << 16); }
__device__ __forceinline__ float bflo(unsigned w) { return __builtin_bit_cast(float, w << 16); }
__device__ __forceinline__ float bfhi(unsigned w) { return __builtin_bit_cast(float, w & 0xffff0000u); }
__device__ __forceinline__ float wave_sum(float v) {
#pragma unroll
    for (int o = 1; o < 64; o <<= 1) v += __shfl_xor(v, o);
    return v;
}
__device__ __forceinline__ float fsig(float x) { return __builtin_amdgcn_rcpf(1.0f + __expf(-x)); }
__device__ __forceinline__ int crow16(int r, int hi) { return (r & 3) + 8 * (r >> 2) + 4 * hi; }
template <int KSTEPS> __device__ __forceinline__ void mma32(f32x16& acc, const lds_t* A, int lda, const lds_t* B, int ldb, int lane) {
    const lds_t* ap = A + (lane & 31) * lda + (lane >> 5) * 16; const lds_t* bp = B + (lane & 31) * ldb + (lane >> 5) * 16;
#pragma unroll
    for (int k = 0; k < KSTEPS; ++k) acc = __builtin_amdgcn_mfma_f32_32x32x16_bf16(*(const LAS bf16x8*)(ap + 32 * k), *(const LAS bf16x8*)(bp + 32 * k), acc, 0, 0, 0);
}

#define XB_TMO      128
#define XB_XCNT(j)  (256  + 64 * (j))
#define XB_XSUB(j)  (1280 + 64 * (j))
#define XB_XGEN(j)  (2304 + 64 * (j))
#define XB_TOP      3328
#define XB_TOPGEN   3392
#define XCD_BAR_WORDS 3456
#define XB_SPIN_CAP (1u << 18)

__device__ __forceinline__ unsigned xb_ld(unsigned* p)              { return __hip_atomic_load(p, __ATOMIC_RELAXED, __HIP_MEMORY_SCOPE_AGENT); }
__device__ __forceinline__ unsigned xb_add(unsigned* p, unsigned v) { return __hip_atomic_fetch_add(p, v, __ATOMIC_RELAXED, __HIP_MEMORY_SCOPE_AGENT); }
__device__ __forceinline__ unsigned xb_xcc_id() { return (unsigned)__builtin_amdgcn_s_getreg((3 << 11) | 20) & 0xFu; }
#define XB_SPIN(cond, bar) do { unsigned _sp = 0; while (cond) { __builtin_amdgcn_s_sleep(1); \
    if ((++_sp & 255u) == 0u) { if (xb_ld(&(bar)[XB_TMO])) break; if (_sp > XB_SPIN_CAP) { atomicAdd(&(bar)[XB_TMO], 1u); break; } } } } while (0)

struct XcdBarrier {
    unsigned* bar; unsigned x;
    volatile LAS unsigned* st;
};

__device__ __forceinline__ XcdBarrier xcd_barrier_post(unsigned* bar, volatile LAS unsigned* st) {
    XcdBarrier b; b.bar = bar; b.x = xb_xcc_id(); b.st = st;
    if (threadIdx.x == 0) (void)xb_add(&bar[XB_XCNT(b.x)], 1u);
    return b;
}
__device__ __forceinline__ void xcd_barrier_complete(unsigned* bar, unsigned x, unsigned& nloc, unsigned& nx) {
    const unsigned G = gridDim.x * gridDim.y * gridDim.z;
    unsigned sum, cnt, mine, sp = 0u;
    for (;;) {
        sum = 0u; cnt = 0u; mine = 0u;
#pragma unroll
        for (unsigned j = 0; j < 16; ++j) { const unsigned c = xb_ld(&bar[XB_XCNT(j)]); sum += c; cnt += (c > 0u) ? 1u : 0u; mine = (j == x) ? c : mine; }
        if (sum == G) break;
        __builtin_amdgcn_s_sleep(1);
        if ((++sp & 255u) == 0u) { if (xb_ld(&bar[XB_TMO])) break; if (sp > XB_SPIN_CAP) { atomicAdd(&bar[XB_TMO], 1u); break; } }
    }
    nloc = mine > 0u ? mine : 1u; nx = cnt > 0u ? cnt : 1u;
}

__device__ __forceinline__ void xcd_barrier(const XcdBarrier& b) {
    asm volatile("s_waitcnt vmcnt(0)" ::: "memory");
    __syncthreads();
    if (threadIdx.x == 0) {
        unsigned* bar = b.bar;
        __builtin_amdgcn_s_waitcnt(0);
        unsigned nloc = b.st[0], nx = b.st[1];
        if (nloc == 0u) { xcd_barrier_complete(bar, b.x, nloc, nx); b.st[0] = nloc; b.st[1] = nx; }
        const unsigned old = xb_add(&bar[XB_XSUB(b.x)], 1u);
        const unsigned gen = old / nloc;
        if (old + 1u == (gen + 1u) * nloc) {
            __builtin_amdgcn_fence(__ATOMIC_RELEASE, "agent");
            asm volatile("s_waitcnt vmcnt(0)" ::: "memory");
            const unsigned og = xb_add(&bar[XB_TOP], 1u);
            const unsigned tg = og / nx;
            if (og + 1u == (tg + 1u) * nx) xb_add(&bar[XB_TOPGEN], 1u);
            else XB_SPIN(xb_ld(&bar[XB_TOPGEN]) == tg, bar);
            __builtin_amdgcn_fence(__ATOMIC_ACQUIRE, "agent");
            xb_add(&bar[XB_XGEN(b.x)], 1u);
            asm volatile("s_waitcnt vmcnt(0)" ::: "memory");
        } else {
            XB_SPIN(xb_ld(&bar[XB_XGEN(b.x)]) == gen, bar);
            __builtin_amdgcn_fence(__ATOMIC_ACQUIRE, "agent");
            asm volatile("s_waitcnt vmcnt(0)" ::: "memory");
        }
    }
    __syncthreads();
}

struct Args {
    const float *x, *c, *ctx, *c_ctx, *w_ada, *b_ada, *w_in, *ret_decay, *q_gain, *k_gain, *conv_w, *conv_b, *lru_wa, *lru_ba, *lru_wx, *lru_bx, *lru_lam, *w_out, *ln1_g, *ln1_b, *w_ff1, *w_ff2, *ln2_g, *ln2_b;
    float* out; unsigned char* ws;
};

template <bool PERMIN> __device__ __forceinline__ void transpose_item(const float* W, int K, int N, bf16* WT, LAS float* scr, int item, int lane) {
    const int nblk = N / 32, kb = item / nblk, nb = item % nblk, k0 = 64 * kb, n0 = 32 * nb;
#pragma unroll 8
    for (int i = 0; i < 32; ++i) { const int kk = 2 * i + (lane >> 5); scr[kk * 33 + (lane & 31)] = W[(size_t)(k0 + kk) * N + n0 + (lane & 31)]; }
    asm volatile("s_waitcnt lgkmcnt(0)" ::: "memory");
    int r0 = n0;
    if (PERMIN) { const int cl = n0 & 255; r0 = (n0 & ~255) + 128 * ((cl >> 5) & 1) + 32 * (cl >> 6); }
    const int c = lane & 7;
#pragma unroll
    for (int j = 0; j < 4; ++j) { const int n = (lane >> 3) + 8 * j; const LAS float* s = scr + (8 * c) * 33 + n;
        v4u o; o.x = pk2(s[0 * 33], s[1 * 33]); o.y = pk2(s[2 * 33], s[3 * 33]); o.z = pk2(s[4 * 33], s[5 * 33]); o.w = pk2(s[6 * 33], s[7 * 33]);
        *(v4u*)(WT + (size_t)(r0 + n) * K + k0 + 8 * c) = o; }
    asm volatile("s_waitcnt lgkmcnt(0)" ::: "memory");
}

__device__ __forceinline__ void modulate_rows(const Args& a, const float* mod0, bf16* U, int gw, int ngw, int lane) {
    for (int m = gw; m < MT; m += ngw) {
        const bool lat = m < ML; const int bb = lat ? (m >> 12) : 8;
        const float* xr = lat ? a.x + (size_t)m * DM : a.ctx + (size_t)(m - ML) * DM;
        const float* mp = mod0 + (size_t)bb * 6144;
#pragma unroll
        for (int j = 0; j < 4; ++j) { const int col = 4 * (lane + 64 * j); const f32x4 v = *(const f32x4*)(xr + col), sh = *(const f32x4*)(mp + col), sc = *(const f32x4*)(mp + 1024 + col);
            const f32x4 o = v * (sc + 1.0f) + sh; v2u w; w.x = pk2(o[0], o[1]); w.y = pk2(o[2], o[3]); *(v2u*)(U + (size_t)m * DM + col) = w; }
    }
}
template <int NR> __device__ __forceinline__ void ln_lat_body(float* xL, const float* g, const float* b, const float* modp, bf16* U, int m0, int ngw, int lane, float* dummy, const bf16* vin, bf16* xB) {
    {
        f32x4 v[NR][4]; float s[NR], s2[NR];
#pragma unroll
        for (int q = 0; q < NR; ++q)
#pragma unroll
            for (int jj = 0; jj < 2; ++jj) { const size_t o_ = (size_t)(m0 + q * ngw) * DM + 8 * lane + 512 * jj;
                if (vin) { const v4u w = *(const v4u*)(vin + o_); v[q][2 * jj] = (f32x4){bflo(w.x), bfhi(w.x), bflo(w.y), bfhi(w.y)}; v[q][2 * jj + 1] = (f32x4){bflo(w.z), bfhi(w.z), bflo(w.w), bfhi(w.w)}; }
                else { v[q][2 * jj] = *(const f32x4*)(xL + o_); v[q][2 * jj + 1] = *(const f32x4*)(xL + o_ + 4); } }
#pragma unroll
        for (int q = 0; q < NR; ++q) { s[q] = 0.f;
#pragma unroll
            for (int j = 0; j < 4; ++j) s[q] += (v[q][j][0] + v[q][j][1]) + (v[q][j][2] + v[q][j][3]); }
#pragma unroll
        for (int o = 1; o < 64; o <<= 1) {
#pragma unroll
            for (int q = 0; q < NR; ++q) s[q] += __shfl_xor(s[q], o); }
#pragma unroll
        for (int q = 0; q < NR; ++q) { const float mean = s[q] * (1.0f / DM); s2[q] = 0.f;
#pragma unroll
            for (int j = 0; j < 4; ++j) { v[q][j] = v[q][j] - mean; s2[q] += (v[q][j][0] * v[q][j][0] + v[q][j][1] * v[q][j][1]) + (v[q][j][2] * v[q][j][2] + v[q][j][3] * v[q][j][3]); } }
#pragma unroll
        for (int o = 1; o < 64; o <<= 1) {
#pragma unroll
            for (int q = 0; q < NR; ++q) s2[q] += __shfl_xor(s2[q], o); }
#pragma unroll
        for (int jj = 0; jj < 2; ++jj) { const int col = 8 * lane + 512 * jj;
            const f32x4 g0 = *(const f32x4*)(g + col), g1 = *(const f32x4*)(g + col + 4), b0 = *(const f32x4*)(b + col), b1 = *(const f32x4*)(b + col + 4);
#pragma unroll
            for (int q = 0; q < NR; ++q) { const int m = m0 + q * ngw; const float rstd = rsqrtf(s2[q] * (1.0f / DM) + EPSN);
                const f32x4 o0 = v[q][2 * jj] * rstd * g0 + b0, o1 = v[q][2 * jj + 1] * rstd * g1 + b1;
                if (xB) { v4u wx; wx.x = pk2(o0[0], o0[1]); wx.y = pk2(o0[2], o0[3]); wx.z = pk2(o1[0], o1[1]); wx.w = pk2(o1[2], o1[3]); *(v4u*)(xB + (size_t)m * DM + col) = wx; }
                else { float* xo = (dummy ? dummy : xL) + (size_t)m * DM + col; *(f32x4*)xo = o0; *(f32x4*)(xo + 4) = o1; }
                if (modp) { const float* mp = modp + (size_t)(m >> 12) * 6144 + col; const f32x4 u0 = o0 * (*(const f32x4*)(mp + 1024) + 1.0f) + *(const f32x4*)mp, u1 = o1 * (*(const f32x4*)(mp + 1024 + 4) + 1.0f) + *(const f32x4*)(mp + 4);
                    v4u w; w.x = pk2(u0[0], u0[1]); w.y = pk2(u0[2], u0[3]); w.z = pk2(u1[0], u1[1]); w.w = pk2(u1[2], u1[3]); *(v4u*)(U + (size_t)m * DM + col) = w; } } }
    }
}
__device__ __forceinline__ void ln_rows_lat(float* xL, const float* g, const float* b, const float* modp, bf16* U, int gw, int ngw, int lane, float* dummy, const bf16* vin, bf16* xB) {
    int m0 = gw;
    for (; m0 + 3 * ngw < ML; m0 += 4 * ngw) ln_lat_body<4>(xL, g, b, modp, U, m0, ngw, lane, dummy, vin, xB);
    for (; m0 < ML; m0 += ngw) ln_lat_body<1>(xL, g, b, modp, U, m0, ngw, lane, dummy, vin, xB);
}
__device__ __forceinline__ void ln_rows_ctx(float* xC, const float* xCin, const float* g, const float* b, const float* modp, bf16* U, int gw, int ngw, int lane, const float* part, const float* gate8, int nsplit) {
    for (int r = gw; r < MC; r += ngw) {
        f32x4 v[4]; float s = 0.f;
#pragma unroll
        for (int j = 0; j < 4; ++j) { const int col = 4 * (lane + 64 * j); v[j] = *(const f32x4*)(xCin + (size_t)r * DM + col);
            if (part) { const bf16* pp = (const bf16*)part + (size_t)r * DM + col; f32x4 ps = {0.f, 0.f, 0.f, 0.f};
                for (int k = 0; k < nsplit; ++k) { const v2u w = *(const v2u*)(pp + (size_t)k * 2048 * 1024); ps = ps + (f32x4){bflo(w.x), bfhi(w.x), bflo(w.y), bfhi(w.y)}; }
                v[j] = v[j] * ALPHA + *(const f32x4*)(gate8 + col) * ps; }
            s += (v[j][0] + v[j][1]) + (v[j][2] + v[j][3]); }
        const float mean = wave_sum(s) * (1.0f / DM); float s2 = 0.f;
#pragma unroll
        for (int j = 0; j < 4; ++j) { v[j] = v[j] - mean; s2 += (v[j][0] * v[j][0] + v[j][1] * v[j][1]) + (v[j][2] * v[j][2] + v[j][3] * v[j][3]); }
        const float rstd = rsqrtf(wave_sum(s2) * (1.0f / DM) + EPSN);
#pragma unroll
        for (int j = 0; j < 4; ++j) { const int col = 4 * (lane + 64 * j); const f32x4 o = v[j] * rstd * *(const f32x4*)(g + col) + *(const f32x4*)(b + col);
            *(f32x4*)(xC + (size_t)r * DM + col) = o;
            if (modp) { const float* mp = modp + (size_t)8 * 6144; const f32x4 sh = *(const f32x4*)(mp + col), sc = *(const f32x4*)(mp + 1024 + col); const f32x4 uu = o * (sc + 1.0f) + sh;
                v2u w; w.x = pk2(uu[0], uu[1]); w.y = pk2(uu[2], uu[3]); *(v2u*)(U + (size_t)(ML + r) * DM + col) = w; } }
    }
}
__device__ __forceinline__ void ln_rows(float* xL, float* xC, int mrows, const float* g, const float* b, const float* modp, bf16* U, int gw, int ngw, int lane, float* dummy = nullptr, const float* part = nullptr, const float* gate8 = nullptr, const float* xCin = nullptr, const bf16* vin = nullptr, bf16* xB = nullptr, int nsplit = 4) {
    ln_rows_lat(xL, g, b, modp, U, gw, ngw, lane, dummy, vin, xB);
    if (mrows > ML && !dummy) ln_rows_ctx(xC, xCin ? xCin : xC, g, b, modp, U, gw, ngw, lane, part, gate8, nsplit);
}

__device__ __forceinline__ int chunk_row0(int b, int c) { return c < 32 ? b * SEQ + c * 128 : ML + b * CTXL + (c - 32) * 128; }
__device__ __forceinline__ float log_sigmoid(float x) { return fminf(x, 0.f) - log1pf(expf(-fabsf(x))); }
constexpr int RT_LDK = 272;
constexpr int RT_LDD = 144;
__device__ __forceinline__ void ret_contrib_unit(int unit, const bf16* RK, const bf16* RV, const float* decay_l, float* RETC, lds_t* lds, int tid, int lane, int wave) {
    const int c = unit % 34, bh = unit / 34, h = bh & 3, b = bh >> 2; const int m0 = chunk_row0(b, c);
    lds_t* Kft = lds; lds_t* Kbt = lds + 64 * RT_LDK; lds_t* Vt = lds + 128 * RT_LDK;
    const float lgf = log_sigmoid(decay_l[h]), lgb = log_sigmoid(decay_l[4 + h]);
    { const int j = tid >> 2, d0 = (tid & 3) * 16; const float wf = __expf(lgf * (float)(127 - j)), wb = __expf(lgb * (float)j);
        const v4u* kp = (const v4u*)(RK + (size_t)(m0 + j) * 256 + h * 64 + d0); const v4u* vp = (const v4u*)(RV + (size_t)(m0 + j) * 256 + h * 64 + d0);
#pragma unroll
        for (int q = 0; q < 2; ++q) { const v4u kw = kp[q], vw = vp[q];
#pragma unroll
            for (int e = 0; e < 4; ++e) { const unsigned kk = kw[e], vv = vw[e]; const int d = d0 + q * 8 + 2 * e; const float k0 = bflo(kk), k1 = bfhi(kk);
                *(LAS unsigned short*)(Kft + d * RT_LDK + j * 2) = (unsigned short)f2bf(k0 * wf); *(LAS unsigned short*)(Kft + (d + 1) * RT_LDK + j * 2) = (unsigned short)f2bf(k1 * wf);
                *(LAS unsigned short*)(Kbt + d * RT_LDK + j * 2) = (unsigned short)f2bf(k0 * wb); *(LAS unsigned short*)(Kbt + (d + 1) * RT_LDK + j * 2) = (unsigned short)f2bf(k1 * wb);
                *(LAS unsigned short*)(Vt + d * RT_LDK + j * 2) = (unsigned short)(vv & 0xffffu); *(LAS unsigned short*)(Vt + (d + 1) * RT_LDK + j * 2) = (unsigned short)(vv >> 16); } } }
    __syncthreads();
    { const int dir = wave >> 2, dt = (wave >> 1) & 1, vt = wave & 1; f32x16 acc = {};
        mma32<8>(acc, (dir ? Kbt : Kft) + 32 * dt * RT_LDK, RT_LDK, Vt + 32 * vt * RT_LDK, RT_LDK, lane);
        float* dst = RETC + ((size_t)unit * 2 + dir) * 4096 + (32 * vt + (lane & 31));
#pragma unroll
        for (int r = 0; r < 16; ++r) dst[(size_t)(32 * dt + crow16(r, lane >> 5)) * 64] = acc[r]; }
    __syncthreads();
}
__device__ __forceinline__ void ret_prefix_phase(float* RETC, const float* decay_l, int gt, int ngt) {
    for (int i = gt; i < 32 * 2 * 4096; i += ngt) { const int e = i & 4095, dir = (i >> 12) & 1, bh = i >> 13, h = bh & 3;
        const float G = __expf(log_sigmoid(decay_l[dir * 4 + h]) * 128.f); float* base = RETC + (size_t)bh * 34 * 8192 + dir * 4096 + e;
        float cv[34];
#pragma unroll
        for (int x = 0; x < 34; ++x) cv[x] = base[(size_t)x * 8192];
        float s = 0.f;
        if (dir == 0) {
#pragma unroll
            for (int k = 0; k < 34; ++k) { const int x = k < 2 ? 32 + k : k - 2; base[(size_t)x * 8192] = s; s = s * G + cv[x]; } }
        else {
#pragma unroll
            for (int k = 0; k < 34; ++k) { const int x = 33 - k; base[(size_t)x * 8192] = s; s = s * G + cv[x]; } }
    }
}
__device__ __forceinline__ void ret_out_unit(int unit, const bf16* RQ, const bf16* RK, const bf16* RV, const bf16* RG, const float* decay_l, const float* RETC, bf16* MIX, lds_t* lds, int tid, int lane, int wave) {
    const int c = unit % 34, bh = unit / 34, h = bh & 3, b = bh >> 2; const int m0 = chunk_row0(b, c);
    lds_t* Qs = lds; lds_t* Ks = Qs + 128 * RT_LDD; lds_t* Vt = Ks + 128 * RT_LDD; lds_t* Sft = Vt + 64 * RT_LDK; lds_t* Sbt = Sft + 64 * RT_LDD; lds_t* Ws = Sbt + 64 * RT_LDD;
    const float lgf = log_sigmoid(decay_l[h]), lgb = log_sigmoid(decay_l[4 + h]);
    { const float* base = RETC + ((size_t)bh * 34 + c) * 2 * 4096 + tid * 8;
        const f32x4 sf0 = *(const f32x4*)base, sf1 = *(const f32x4*)(base + 4), sb0 = *(const f32x4*)(base + 4096), sb1 = *(const f32x4*)(base + 4096 + 4);
        const int d = tid >> 3, v0 = (tid & 7) * 8;
#pragma unroll
        for (int e = 0; e < 4; ++e) { *(LAS unsigned short*)(Sft + (v0 + e) * RT_LDD + d * 2) = (unsigned short)f2bf(sf0[e]); *(LAS unsigned short*)(Sft + (v0 + 4 + e) * RT_LDD + d * 2) = (unsigned short)f2bf(sf1[e]);
            *(LAS unsigned short*)(Sbt + (v0 + e) * RT_LDD + d * 2) = (unsigned short)f2bf(sb0[e]); *(LAS unsigned short*)(Sbt + (v0 + 4 + e) * RT_LDD + d * 2) = (unsigned short)f2bf(sb1[e]); } }
    { const int j = tid >> 2, d0 = (tid & 3) * 16; const size_t go = (size_t)(m0 + j) * 256 + h * 64 + d0;
        const v4u* qp = (const v4u*)(RQ + go); const v4u* kp = (const v4u*)(RK + go); const v4u* vp = (const v4u*)(RV + go);
#pragma unroll
        for (int q = 0; q < 2; ++q) { *(LAS v4u*)(Qs + j * RT_LDD + (d0 + 8 * q) * 2) = qp[q]; *(LAS v4u*)(Ks + j * RT_LDD + (d0 + 8 * q) * 2) = kp[q]; const v4u vw = vp[q];
#pragma unroll
            for (int e = 0; e < 4; ++e) { const unsigned vv = vw[e]; const int d = d0 + q * 8 + 2 * e;
                *(LAS unsigned short*)(Vt + d * RT_LDK + j * 2) = (unsigned short)(vv & 0xffffu); *(LAS unsigned short*)(Vt + (d + 1) * RT_LDK + j * 2) = (unsigned short)(vv >> 16); } } }
    __syncthreads();
#pragma unroll
    for (int tt = 0; tt < 2; ++tt) { const int tile = wave * 2 + tt, it = tile >> 2, jt = tile & 3; f32x16 acc = {};
        mma32<4>(acc, Qs + 32 * it * RT_LDD, RT_LDD, Ks + 32 * jt * RT_LDD, RT_LDD, lane);
        const int j = 32 * jt + (lane & 31);
#pragma unroll
        for (int r = 0; r < 16; ++r) { const int i = 32 * it + crow16(r, lane >> 5); const float dd = (float)(i - j); const float w = acc[r] * __expf(dd >= 0.f ? lgf * dd : -lgb * dd);
            *(LAS unsigned short*)(Ws + i * RT_LDK + j * 2) = (unsigned short)f2bf(w); } }
    __syncthreads();
    f32x16 o;
    { const int it = wave >> 1, vt = wave & 1; f32x16 a1 = {}, a2 = {}, a3 = {};
        mma32<8>(a1, Ws + 32 * it * RT_LDK, RT_LDK, Vt + 32 * vt * RT_LDK, RT_LDK, lane);
        mma32<4>(a2, Qs + 32 * it * RT_LDD, RT_LDD, Sft + 32 * vt * RT_LDD, RT_LDD, lane);
        mma32<4>(a3, Qs + 32 * it * RT_LDD, RT_LDD, Sbt + 32 * vt * RT_LDD, RT_LDD, lane);
#pragma unroll
        for (int r = 0; r < 16; ++r) { const int i = 32 * it + crow16(r, lane >> 5); o[r] = a1[r] + __expf(lgf * (float)(i + 1)) * a2[r] + __expf(lgb * (float)(128 - i)) * a3[r]; } }
    __syncthreads();
    { const int it = wave >> 1, vt = wave & 1; LAS float* Os = (LAS float*)Ws;
#pragma unroll
        for (int r = 0; r < 16; ++r) Os[(32 * it + crow16(r, lane >> 5)) * 65 + 32 * vt + (lane & 31)] = o[r]; }
    __syncthreads();
    { const int i = tid >> 2, c0 = (tid & 3) * 16; const LAS float* Os = (const LAS float*)Ws + i * 65 + c0; float vals[16]; float ss = 0.f;
#pragma unroll
        for (int e = 0; e < 16; ++e) { vals[e] = Os[e]; ss += vals[e] * vals[e]; }
        ss += __shfl_xor(ss, 1); ss += __shfl_xor(ss, 2);
        const float rs = rsqrtf(ss * (1.0f / 64.0f) + EPSN);
        const v4u* gp = (const v4u*)(RG + (size_t)(m0 + i) * 256 + h * 64 + c0); bf16* dst = MIX + (size_t)(m0 + i) * DM + h * 64 + c0;
#pragma unroll
        for (int q = 0; q < 2; ++q) { const v4u gw = gp[q]; v4u ow;
#pragma unroll
            for (int e = 0; e < 4; ++e) ow[e] = pk2(vals[q * 8 + 2 * e] * rs * bflo(gw[e]), vals[q * 8 + 2 * e + 1] * rs * bfhi(gw[e]));
            *(v4u*)(dst + 8 * q) = ow; } }
    __syncthreads();
}

constexpr int LR_LDX = 528;
__device__ __forceinline__ void lru_pass1_unit(int cu4, const Args& a, int l, const bf16* LX, const bf16* WLRU, h2* AD, float2* LCS4, lds_t* lds, int tid, int lane, int wave) {
    const int cu = cu4 >> 2, rt0 = cu4 & 3;
    const int b = cu < 256 ? cu >> 5 : (cu - 256) >> 1, c = cu < 256 ? cu & 31 : 32 + ((cu - 256) & 1);
    const int m0 = chunk_row0(b, c), ms = c < 32 ? b * SEQ : ML + b * CTXL, me = ms + (c < 32 ? SEQ : CTXL);
    lds_t* XR = lds; LAS h2* ADL = (LAS h2*)(lds + 128 * LR_LDX);
    { const int w8 = (tid & 31) * 8, tr = tid >> 5; float cw[4][8], cb[8];
#pragma unroll
        for (int j = 0; j < 4; ++j)
#pragma unroll
            for (int e = 0; e < 8; ++e) cw[j][e] = a.conv_w[(size_t)l * 1024 + j * 256 + w8 + e];
#pragma unroll
        for (int e = 0; e < 8; ++e) cb[e] = a.conv_b[l * 256 + w8 + e];
        for (int i = 0; i < 2; ++i) { const int t = 32 * rt0 + tr + 16 * i; float acc[8];
#pragma unroll
            for (int e = 0; e < 8; ++e) acc[e] = cb[e];
#pragma unroll
            for (int j = 0; j < 4; ++j) { const int m = m0 + t + j - 2;
                if (m >= ms && m < me) { const v4u xv = *(const v4u*)(LX + (size_t)m * 256 + w8);
#pragma unroll
                    for (int e = 0; e < 4; ++e) { acc[2 * e] += bflo(xv[e]) * cw[j][2 * e]; acc[2 * e + 1] += bfhi(xv[e]) * cw[j][2 * e + 1]; } } }
            v4u ow;
#pragma unroll
            for (int e = 0; e < 4; ++e) ow[e] = pk2(acc[2 * e], acc[2 * e + 1]);
            *(LAS v4u*)(XR + (t & 31) * LR_LDX + w8 * 2) = ow; } }
    __syncthreads();
    const int k = wave & 3, dir = wave >> 2;
    float ba[2], bx[2], lsl[2];
#pragma unroll
    for (int ct = 0; ct < 2; ++ct) { const int ch = 64 * k + 32 * ct + (lane & 31); ba[ct] = a.lru_ba[(l * 2 + dir) * 256 + ch]; bx[ct] = a.lru_bx[(l * 2 + dir) * 256 + ch]; lsl[ct] = 8.0f * log_sigmoid(a.lru_lam[(l * 2 + dir) * 256 + ch]); }
    float At = 1.f, Ht = 0.f;
    for (int rt = rt0; rt < rt0 + 1; ++rt) {
        bf16x8 af[4];
#pragma unroll
        for (int ks = 0; ks < 4; ++ks) af[ks] = *(const LAS bf16x8*)(XR + (lane & 31) * LR_LDX + (64 * k + 16 * ks + 8 * (lane >> 5)) * 2);
#pragma unroll
        for (int ct = 0; ct < 2; ++ct) { f32x16 ga = {}, gx = {};
#pragma unroll
            for (int ks = 0; ks < 4; ++ks) { const bf16* wb = WLRU + (((size_t)(l * 2 + dir) * 2 * 4 + k) * 64 + 32 * ct + (lane & 31)) * 64 + 16 * ks + 8 * (lane >> 5);
                ga = __builtin_amdgcn_mfma_f32_32x32x16_bf16(af[ks], *(const bf16x8*)wb, ga, 0, 0, 0); gx = __builtin_amdgcn_mfma_f32_32x32x16_bf16(af[ks], *(const bf16x8*)(wb + 4 * 4096), gx, 0, 0, 0); }
            const int ch = 64 * k + 32 * ct + (lane & 31);
#pragma unroll
            for (int r = 0; r < 16; ++r) { const int row = crow16(r, lane >> 5);
                const float rg = fsig(ga[r] + ba[ct]), ig = fsig(gx[r] + bx[ct]); const float la = lsl[ct] * rg;
                const float a_ = __expf(la); const float oma = 1.0f - a_, dr = __builtin_amdgcn_sqrtf(oma * (1.0f + a_)) * ig * bf2f(*(const LAS unsigned short*)(XR + row * LR_LDX + ch * 2));
                h2 hv; hv[0] = (_Float16)oma; hv[1] = (_Float16)dr;
                ADL[row * 512 + dir * 256 + ch] = hv; AD[((size_t)(m0 + 32 * rt + row) * 2 + dir) * 256 + ch] = hv; } }
        __syncthreads();
        { const int sd = tid >> 8, sc = tid & 255; float A = 1.f, H = 0.f;
            h2 fr_[32];
#pragma unroll
            for (int r = 0; r < 32; ++r) fr_[r] = ADL[r * 512 + sd * 256 + sc];
            if (sd == 0) {
#pragma unroll
                for (int r = 0; r < 32; ++r) { const float aa = 1.0f - (float)fr_[r][0]; H = aa * H + (float)fr_[r][1]; A *= aa; }
                Ht = A * Ht + H; At = A * At; }
            else {
#pragma unroll
                for (int r = 31; r >= 0; --r) { const float aa = 1.0f - (float)fr_[r][0]; H = aa * H + (float)fr_[r][1]; A *= aa; }
                Ht = At * H + Ht; At = At * A; } }
        __syncthreads();
    }
    LCS4[(((size_t)(b * 34 + c) * 4 + rt0) * 2 + (tid >> 8)) * 256 + (tid & 255)] = make_float2(At, Ht);
}
__device__ __forceinline__ void lru_compose_phase(const float2* LCS4, float2* LCS, int gt, int ngt) {
    for (int i = gt; i < NB * 34 * 2 * 256; i += ngt) { const int ch = i & 255, dir = (i >> 8) & 1, bc = i >> 9; float2 s[4];
#pragma unroll
        for (int rt = 0; rt < 4; ++rt) s[rt] = LCS4[(((size_t)bc * 4 + rt) * 2 + dir) * 256 + ch];
        float A = 1.f, h = 0.f;
#pragma unroll
        for (int k = 0; k < 4; ++k) { const float2 t = s[dir ? 3 - k : k]; h = t.x * h + t.y; A *= t.x; }
        LCS[i] = make_float2(A, h); }
}
__device__ __forceinline__ void lru_pass2_unit(int cu, const h2* AD, const float2* LCS, const bf16* LG, bf16* MIX, lds_t* lds, int tid) {
    const int b = cu < 256 ? cu >> 5 : (cu - 256) >> 1, c = cu < 256 ? cu & 31 : 32 + ((cu - 256) & 1);
    const int m0 = chunk_row0(b, c); const int dir = tid >> 8, ch = tid & 255;
    LAS _Float16* HS = (LAS _Float16*)lds;
    float h = 0.f;
    const float2* cs = LCS + (size_t)b * 34 * 512 + dir * 256 + ch;
    const int n = dir == 0 ? (c < 32 ? c + 2 : c - 32) : 33 - c;
    for (int i0 = 0; i0 < n; i0 += 8) { float2 s[8];
#pragma unroll
        for (int j = 0; j < 8; ++j) { const int ii = (i0 + j < n) ? i0 + j : 0; const int cc = dir == 0 ? (ii < 2 ? 32 + ii : ii - 2) : 33 - ii; s[j] = cs[(size_t)cc * 512]; }
#pragma unroll
        for (int j = 0; j < 8; ++j) if (i0 + j < n) h = s[j].x * h + s[j].y; }
    const h2* ad = AD + ((size_t)m0 * 2 + dir) * 256 + ch;
#pragma unroll 1
    for (int r0 = 0; r0 < 128; r0 += 16) { h2 f[16];
#pragma unroll
        for (int j = 0; j < 16; ++j) { const int r = dir == 0 ? r0 + j : 127 - (r0 + j); f[j] = ad[(size_t)r * 512]; }
#pragma unroll
        for (int j = 0; j < 16; ++j) { const int r = dir == 0 ? r0 + j : 127 - (r0 + j); h = (1.0f - (float)f[j][0]) * h + (float)f[j][1]; HS[r * 512 + dir * 256 + ch] = (_Float16)h; } }
    __syncthreads();
    { typedef _Float16 h8 __attribute__((ext_vector_type(8))); const int c8 = (tid & 31) * 8;
#pragma unroll 4
        for (int i = 0; i < 8; ++i) { const int r = (tid >> 5) + 16 * i; const h8 hf = *(const LAS h8*)(HS + r * 512 + c8), hb = *(const LAS h8*)(HS + r * 512 + 256 + c8);
            const v4u g = *(const v4u*)(LG + (size_t)(m0 + r) * 256 + c8); v4u o;
#pragma unroll
            for (int e = 0; e < 4; ++e) o[e] = pk2(((float)hf[2 * e] + (float)hb[2 * e]) * bflo(g[e]), ((float)hf[2 * e + 1] + (float)hb[2 * e + 1]) * bfhi(g[e]));
            *(v4u*)(MIX + (size_t)(m0 + r) * DM + 768 + c8) = o; } }
    __syncthreads();
}
#ifndef REP_G1N
#define REP_G1N 1
#endif
#ifndef REP_G4E
#define REP_G4E 1
#endif
#ifndef REP_P0
#define REP_P0 1
#endif
#ifndef REP_G4
#define REP_G4 1
#endif
#ifndef REP_G7
#define REP_G7 1
#endif
#ifndef REP_LN
#define REP_LN 1
#endif
#ifndef REP_SYNC
#define REP_SYNC 0
#endif
#ifndef REP_G1
#define REP_G1 1
#endif
#ifndef REP_S2
#define REP_S2 1
#endif
#ifndef REP_ATT
#define REP_ATT 1
#endif
#ifndef REP_R2
#define REP_R2 1
#endif
#ifndef REP_L2
#define REP_L2 1
#endif
#ifndef REP_G6
#define REP_G6 1
#endif
__global__ void __launch_bounds__(NTHR, 2) trunk_fwd(Args a) {
    extern __shared__ __attribute__((aligned(16))) unsigned char lds_raw[];
    cg::grid_group grid = cg::this_grid();
    lds_t* lds = (lds_t*)lds_raw;
    const int tid = threadIdx.x;
    const int G = gridDim.x, bx = blockIdx.x;
    const int vcu = (G % 8 == 0) ? (bx % 8) * (G / 8) + bx / 8 : bx;
    const int ngw = G * NWAVES;
    unsigned char* ws = a.ws;
    volatile LAS unsigned* bst = (volatile LAS unsigned*)(lds + LDS_BYTES - 64);
    if (threadIdx.x == 0) { bst[0] = 0u; bst[1] = 0u; }
    __syncthreads();
    (void)xcd_barrier_post((unsigned*)(ws + WS_CTL), bst);
#define GRID_BAR() do { XcdBarrier b_; b_.bar = (unsigned*)(a.ws + WS_CTL); b_.x = xb_xcc_id(); b_.st = (volatile LAS unsigned*)(lds + LDS_BYTES - 64); xcd_barrier(b_); } while (0)
    bf16* WT_IN = (bf16*)(ws + WS_WIN); bf16* WT_OUT = (bf16*)(ws + WS_WOUT); bf16* WT_1 = (bf16*)(ws + WS_W1); bf16* WT_2 = (bf16*)(ws + WS_W2);
    float* MOD = (float*)(ws + WS_MOD); float* ROPE = (float*)(ws + WS_ROPE); bf16* WLRU = (bf16*)(ws + WS_WLRU); float2* LCS = (float2*)(ws + WS_LCS);
    float* XC = (float*)(ws + WS_XC); float* RETC = (float*)(ws + WS_RETC); bf16* U = (bf16*)(ws + WS_U);
    unsigned char* R = ws + WS_R;
    float2* LCS4 = (float2*)(ws + WS_LCS4);
    bf16* P4 = (bf16*)(R + R_P4); bf16* RQ = P4; bf16* RK = P4 + (size_t)MT * 256; bf16* RV = P4 + (size_t)2 * MT * 256; bf16* RG = P4 + (size_t)3 * MT * 256;
    bf16* AQ = (bf16*)(R + R_AQ); bf16* KB = (bf16*)(R + R_KB); bf16* VB = (bf16*)(R + R_VB); bf16* LX = (bf16*)(R + R_LX); bf16* LG = (bf16*)(R + R_LG);
    bf16* MIX = (bf16*)(R + R_MIX); h2* AD = (h2*)(R + R_AD); bf16* H = (bf16*)R;

#define IDS() int tid_ = threadIdx.x; asm volatile("" : "+v"(tid_)); const int lane_ = tid_ & 63, wave_ = __builtin_amdgcn_readfirstlane(tid_ >> 6); const int gw_ = vcu * NWAVES + wave_; (void)lane_; (void)gw_
    for (int rep_ = 0; rep_ < REP_P0; ++rep_)
    {
        IDS(); const int tid = tid_, lane = lane_, wave = wave_, gw = gw_;
        LAS float* sS = (LAS float*)lds;
        LAS float* part = (LAS float*)(lds + 9 * 1024 * 4);
        for (int i = tid; i < 9 * 1024; i += NTHR) { const float v = i < 8192 ? a.c[i] : a.c_ctx[i - 8192]; sS[i] = v / (1.0f + expf(-v)); }
        __syncthreads();
        for (int unit = bx; unit < DEPTH * 48; unit += G) { const int l = unit / 48, n = (unit % 48) * 128 + 2 * lane;
            const float* wp = a.w_ada + ((size_t)l * 1024 + wave * 128) * 6144 + n; float acc0[9], acc1[9];
#pragma unroll
            for (int q = 0; q < 9; ++q) { acc0[q] = 0.f; acc1[q] = 0.f; }
#pragma unroll 1
            for (int k0 = 0; k0 < 128; k0 += 8) { float2 wv[8];
#pragma unroll
                for (int k = 0; k < 8; ++k) wv[k] = *(const float2*)(wp + (size_t)(k0 + k) * 6144);
#pragma unroll
                for (int k = 0; k < 8; ++k)
#pragma unroll
                    for (int q = 0; q < 9; ++q) { const float sv = sS[q * 1024 + wave * 128 + k0 + k]; acc0[q] += sv * wv[k].x; acc1[q] += sv * wv[k].y; } }
#pragma unroll
            for (int q = 0; q < 9; ++q) { part[(wave * 9 + q) * 128 + 2 * lane] = acc0[q]; part[(wave * 9 + q) * 128 + 2 * lane + 1] = acc1[q]; }
            __syncthreads();
            for (int i = tid; i < 9 * 128; i += NTHR) { float s = 0.f;
#pragma unroll
                for (int w = 0; w < 8; ++w) s += part[w * 1152 + i];
                const int q = i >> 7, nn = (unit % 48) * 128 + (i & 127); MOD[((size_t)l * 9 + q) * 6144 + nn] = s + a.b_ada[(size_t)l * 6144 + nn]; }
            __syncthreads(); }
        __syncthreads();
        LAS float* scr = (LAS float*)(lds + wave * 16384);
        constexpr int I_IN = 16 * 72, I_OUT = 16 * 32, I_1 = 16 * 128, I_2 = 64 * 32, I_L = I_IN + I_OUT + I_1 + I_2;
        for (int it = gw; it < DEPTH * I_L; it += ngw) { const int l = it / I_L; int r = it % I_L;
            if (r < I_IN) { transpose_item<true>(a.w_in + (size_t)l * DM * DIN, DM, DIN, WT_IN + (size_t)l * DIN * DM, scr, r, lane); continue; } r -= I_IN;
            if (r < I_OUT) { transpose_item<true>(a.w_out + (size_t)l * DM * DM, DM, DM, WT_OUT + (size_t)l * DM * DM, scr, r, lane); continue; } r -= I_OUT;
            if (r < I_1) { transpose_item<true>(a.w_ff1 + (size_t)l * DM * DFF, DM, DFF, WT_1 + (size_t)l * DFF * DM, scr, r, lane); continue; } r -= I_1;
            transpose_item<true>(a.w_ff2 + (size_t)l * DFF * DM, DFF, DM, WT_2 + (size_t)l * DM * DFF, scr, r, lane); }
        const int gt = bx * NTHR + tid, ngt = G * NTHR;
        for (int i = gt; i < SEQ * 32; i += ngt) { const int t = i >> 5, d = i & 31; const float inv = powf(10000.0f, -(float)(d & 15) / 16.0f); const float ang = (float)(d < 16 ? (t >> 6) : (t & 63)) * inv;
            ROPE[2 * i] = cosf(ang); ROPE[2 * i + 1] = sinf(ang); }
        for (int i = gt; i < DEPTH * 2 * 2 * 4 * 4096; i += ngt) { const int cin = i & 63, dout = (i >> 6) & 63, k = (i >> 12) & 3, ty = (i >> 14) & 1, ld = i >> 15;
            const float* src = ty ? a.lru_wx : a.lru_wa; WLRU[i] = (bf16)f2bf(src[(((size_t)ld * 4 + k) * 64 + cin) * 64 + dout]); }
        __syncthreads();
    }
    grid.sync();
    { IDS(); modulate_rows(a, MOD, U, gw_, ngw, lane_); }
    GRID_BAR();

    for (int l = 0; l < DEPTH; ++l) {
        const bool need_ctx = l < DEPTH - 1; const int mrows = need_ctx ? MT : ML;
        const float* modl = MOD + (size_t)l * 9 * 6144;
#ifndef SKIP_G1
        for (int rep_ = 1; rep_ < REP_G1N; ++rep_) { pg8::Gemm g{U, WT_IN + (size_t)l * DIN * DM, MT, DIN, DM}; pg8::StaticOrder S; S.init(MT, DIN, G, bx); pg8::EpiNull E{XC}; pg8::gemm_phase<pg8::EpiNull, pg8::StaticOrder, true, true>(lds, g, S, E); }
        for (int rep_ = 0; rep_ < REP_G1; ++rep_)
        {   pg8::Gemm g{U, WT_IN + (size_t)l * DIN * DM, MT, DIN, DM}; pg8::StaticOrder S; S.init(MT, DIN, G, bx);
            pg8::EpiIn E{P4, AQ, KB, VB, LX, LG, a.q_gain + l * 64, a.k_gain + l * 64, ROPE};
            pg8::gemm_phase<pg8::EpiIn, pg8::StaticOrder, true, true>(lds, g, S, E); }
#endif
        GRID_BAR();
        for (int rep_ = 0; rep_ < REP_SYNC; ++rep_) GRID_BAR();
#ifndef SKIP_R1
        for (int rep_ = 0; rep_ < REP_S2; ++rep_) {
        { IDS();
            if (G == 256) { if (bx < 64) { for (int k = 0; k < 2; ++k) ret_contrib_unit(2 * bx + k, RK, RV, a.ret_decay + l * 8, RETC, lds, tid_, lane_, wave_); }
                            else for (int u = 128 + (bx - 64); u < 32 * 34; u += 192) ret_contrib_unit(u, RK, RV, a.ret_decay + l * 8, RETC, lds, tid_, lane_, wave_); }
            else for (int u = (bx + G - 64) % G; u < 32 * 34; u += G) ret_contrib_unit(u, RK, RV, a.ret_decay + l * 8, RETC, lds, tid_, lane_, wave_); }
#endif
#ifndef SKIP_L1
        { IDS(); for (int u = bx; u < 272 * 4; u += G) lru_pass1_unit(u, a, l, LX, WLRU, AD, LCS4, lds, tid_, lane_, wave_); }
#endif
        }
        GRID_BAR();
        { IDS(); ret_prefix_phase(RETC, a.ret_decay + l * 8, bx * NTHR + tid_, G * NTHR); lru_compose_phase(LCS4, LCS, bx * NTHR + tid_, G * NTHR); }
        GRID_BAR();
#ifndef SKIP_ATT
        for (int rep_ = 0; rep_ < REP_ATT; ++rep_)
        {   const int nlat = NB * 8 * 16, natt = nlat + (need_ctx ? NB * 8 : 0);
            for (int u = vcu; u < natt; u += G) {
                if (u < nlat) { const int qb = u & 15, h = (u >> 4) & 3, kvh = (u >> 6) & 1, b = u >> 7; const int hq = kvh * 4 + h;
                    const size_t row0 = (size_t)b * SEQ + qb * 256;
                    attn_body::attn_unit<8>((const attn_body::bf16*)(AQ + row0 * 512 + hq * 64), (const attn_body::bf16*)(KB + (size_t)b * KVL * 128 + kvh * 64), (const attn_body::bf16*)(VB + (size_t)b * KVL * 128 + kvh * 64),
                                            (attn_body::bf16*)(MIX + row0 * DM + 256 + hq * 64), KVL / 64, (char*)lds_raw);
                } else { const int j = u - nlat, hq = j & 7, b = j >> 3, kvh = hq >> 2; const size_t row0 = (size_t)ML + b * CTXL;
                    attn_body::attn_unit<8>((const attn_body::bf16*)(AQ + row0 * 512 + hq * 64), (const attn_body::bf16*)(KB + ((size_t)b * KVL + SEQ) * 128 + kvh * 64), (const attn_body::bf16*)(VB + ((size_t)b * KVL + SEQ) * 128 + kvh * 64),
                                            (attn_body::bf16*)(MIX + row0 * DM + 256 + hq * 64), CTXL / 64, (char*)lds_raw); } }
            asm volatile("s_waitcnt vmcnt(0) lgkmcnt(0)" ::: "memory"); __syncthreads(); }
#endif
#ifndef SKIP_R2
        for (int rep_ = 0; rep_ < REP_R2; ++rep_)
            { IDS(); for (int u = (vcu + G - 64) % G; u < 32 * 34; u += G) { if (!need_ctx && (u % 34) >= 32) continue; ret_out_unit(u, RQ, RK, RV, RG, a.ret_decay + l * 8, RETC, MIX, lds, tid_, lane_, wave_); } }
#endif
#ifndef SKIP_L2
        for (int rep_ = 0; rep_ < REP_L2; ++rep_)
            { IDS(); for (int u = (vcu + G - 128) % G; u < 272; u += G) { if (!need_ctx && u >= 256) continue; lru_pass2_unit(u, AD, LCS, LG, MIX, lds, tid_); } }
#endif
        GRID_BAR();
#ifndef SKIP_G4
        for (int rep_ = 1; rep_ < REP_G4; ++rep_) { pg8::Gemm g{MIX, WT_OUT + (size_t)l * DM * DM, mrows, DM, DM}; pg8::StaticOrder S; S.init(mrows, DM, G, bx); pg8::EpiNull E{XC}; pg8::gemm_phase<pg8::EpiNull, pg8::StaticOrder, true, true>(lds, g, S, E); }
        for (int rep_ = 1; rep_ < REP_G4E; ++rep_) { pg8::Gemm g{MIX, WT_OUT + (size_t)l * DM * DM, mrows, DM, DM}; pg8::StaticOrder S; S.init(mrows, DM, G, bx); pg8::EpiRes E{l == 0 ? a.x : a.out, l == 0 ? a.ctx : XC, (float*)R, (float*)R + (size_t)ML * DM, modl + 2 * 1024, RETC, nullptr, nullptr}; pg8::gemm_phase<pg8::EpiRes, pg8::StaticOrder, true, true>(lds, g, S, E); }
        {   pg8::Gemm g{MIX, WT_OUT + (size_t)l * DM * DM, mrows, DM, DM};
            pg8::EpiRes E{a.x, l == 0 ? a.ctx : XC, a.out, XC, modl + 2 * 1024, RETC, l ? (const bf16*)a.out : nullptr, U};
            if (need_ctx) { pg8::SplitOrder S; S.init(DM, G, bx, 2); pg8::gemm_phase<pg8::EpiRes, pg8::SplitOrder, true, true>(lds, g, S, E); }
            else { pg8::StaticOrder S; S.init(mrows, DM, G, bx); pg8::gemm_phase<pg8::EpiRes, pg8::StaticOrder, true, true>(lds, g, S, E); } }
#endif
        GRID_BAR();
        for (int rep_ = 1; rep_ < REP_LN; ++rep_) { IDS(); ln_rows(a.out, XC, mrows, a.ln1_g + l * DM, a.ln1_b + l * DM, modl + 3 * 1024, (bf16*)AD, gw_, ngw, lane_, (float*)H); }
        { IDS(); ln_rows(a.out, XC, mrows, a.ln1_g + l * DM, a.ln1_b + l * DM, modl + 3 * 1024, U, gw_, ngw, lane_, nullptr, need_ctx ? RETC : nullptr, modl + 2 * 1024 + 8 * 6144, l == 0 ? a.ctx : nullptr, U, (bf16*)a.out); }
        GRID_BAR();
#ifndef SKIP_G6
        for (int rep_ = 0; rep_ < REP_G6; ++rep_)
        {   pg8::Gemm g{U, WT_1 + (size_t)l * DFF * DM, mrows, DFF, DM}; pg8::StaticOrder S; S.init(mrows, DFF, G, bx);
            pg8::EpiFF1 E{H};
            pg8::gemm_phase<pg8::EpiFF1, pg8::StaticOrder, true, true>(lds, g, S, E); }
#endif
        GRID_BAR();
#ifndef SKIP_G4
        for (int rep_ = 1; rep_ < REP_G7; ++rep_) { pg8::Gemm g{H, WT_2 + (size_t)l * DM * DFF, mrows, DM, DFF}; pg8::StaticOrder S; S.init(mrows, DM, G, bx); pg8::EpiNull E{XC}; pg8::gemm_phase<pg8::EpiNull, pg8::StaticOrder, true, true>(lds, g, S, E); }
        {   pg8::Gemm g{H, WT_2 + (size_t)l * DM * DFF, mrows, DM, DFF};
            pg8::EpiRes E{a.out, XC, a.out, XC, modl + 5 * 1024, RETC, (const bf16*)a.out, U};
            if (need_ctx) { pg8::SplitOrder S; S.init(DM, G, bx, 3); pg8::gemm_phase<pg8::EpiRes, pg8::SplitOrder, true, true>(lds, g, S, E); }
            else { pg8::StaticOrder S; S.init(mrows, DM, G, bx); pg8::gemm_phase<pg8::EpiRes, pg8::StaticOrder, true, true>(lds, g, S, E); } }
#endif
        GRID_BAR();
        { IDS(); ln_rows(a.out, XC, mrows, a.ln2_g + l * DM, a.ln2_b + l * DM, need_ctx ? modl + 9 * 6144 : nullptr, U, gw_, ngw, lane_, nullptr, need_ctx ? RETC : nullptr, modl + 5 * 1024 + 8 * 6144, nullptr, U, need_ctx ? (bf16*)a.out : nullptr, 8); }
        if (need_ctx) GRID_BAR();
    }
}

extern "C" void kernel_launch(void* const* d_in, const int* in_sizes, int n_in, void* d_out, int out_size, void* d_ws, size_t ws_size, hipStream_t stream) {
    static int grid = 0;
    if (grid == 0) {
        if (n_in != 24 || in_sizes[0] != ML * DM || out_size != ML * DM || ws_size < WS_END) { fprintf(stderr, "kernel_launch: unexpected shapes (n_in %d, in0 %d, out %d, ws %zu < %zu)\n", n_in, n_in > 0 ? in_sizes[0] : -1, out_size, ws_size, (size_t)WS_END); grid = -1; return; }
        int dev = 0, cus = 0, per_cu = 0;
        (void)hipGetDevice(&dev); (void)hipDeviceGetAttribute(&cus, hipDeviceAttributeMultiprocessorCount, dev);
        if (hipFuncSetAttribute((const void*)trunk_fwd, hipFuncAttributeMaxDynamicSharedMemorySize, LDS_BYTES) != hipSuccess) { fprintf(stderr, "kernel_launch: hipFuncSetAttribute failed\n"); grid = -1; return; }
        if (hipOccupancyMaxActiveBlocksPerMultiprocessor(&per_cu, (const void*)trunk_fwd, NTHR, LDS_BYTES) != hipSuccess || per_cu < 1) { fprintf(stderr, "kernel_launch: occupancy query says %d\n", per_cu); per_cu = 1; }
        (void)hipGetLastError();
        grid = cus * 1;
        if (grid <= 0) grid = 256;
    }
    if (grid < 0) return;
    Args a{};
    const float** f = (const float**)&a;
    for (int i = 0; i < 24; ++i) f[i] = (const float*)d_in[i];
    a.out = (float*)d_out; a.ws = (unsigned char*)d_ws;
    (void)hipMemsetAsync((unsigned char*)d_ws + WS_CTL, 0, CTL_BYTES, stream);
    void* args[] = {&a};
    hipError_t e = hipLaunchCooperativeKernel((const void*)trunk_fwd, dim3(grid), dim3(NTHR), args, LDS_BYTES, stream);
    if (e != hipSuccess) fprintf(stderr, "kernel_launch: cooperative launch failed: %s (grid %d)\n", hipGetErrorString(e), grid);
}
```
